# Optimizing an MI355X kernel written in HIP

```python
import jax
import jax.numpy as jnp
from jax import lax
import numpy as np

D_MODEL = 1024
BATCH = 4
SEQ = 8192
DEPTH = 2

N_GROUPS = 4
GROUP_WIDTH = D_MODEL // N_GROUPS
D_MIX = N_GROUPS * GROUP_WIDTH
HEAD_DIM = 64
CHUNK = 64
EPS = 1e-6
MASK_VALUE = -1e30
MIN_POS = 1e-30

HA = GROUP_WIDTH // HEAD_DIM
DK_A = HEAD_DIM
DV_A = HEAD_DIM
HB = GROUP_WIDTH // HEAD_DIM
DK_B = HEAD_DIM // 2
DV_B = HEAD_DIM
GLA_GATE_RANK = 16
GLA_GATE_NORMALIZER = 16.0
HC = GROUP_WIDTH // HEAD_DIM
MLA_Q_RANK = 256
MLA_KV_RANK = 128
MLA_NOPE = 64
MLA_ROPE = 32
MLA_V = HEAD_DIM
ROPE_THETA = 10000.0
Q_BLOCK = 128
HD = GROUP_WIDTH // HEAD_DIM
DK_D = HEAD_DIM
DV_D = HEAD_DIM
GDN_CONV = 4
D_FF = 2816
FFN_CONV = 3

IN_SPLITS = (
    HA * DK_A, HA * DK_A, HA * DV_A, HA * DV_A,
    HB * DK_B, HB * DK_B, HB * DV_B, GLA_GATE_RANK, HB * DV_B,
    MLA_Q_RANK, MLA_KV_RANK, MLA_ROPE,
    HD * DK_D, HD * DK_D, HD * DV_D, HD, HD, HD * DV_D,
)
D_IN = sum(IN_SPLITS)

kernel_name = 'hybrid_parallel_head_groups_block'


def rms_norm(x, g):
    xf = x.astype(jnp.float32)
    y = xf * lax.rsqrt(jnp.mean(xf * xf, axis=-1, keepdims=True) + EPS)
    return (y * g).astype(x.dtype)


def l2_norm(x):
    xf = x.astype(jnp.float32)
    return xf * lax.rsqrt(jnp.sum(xf * xf, axis=-1, keepdims=True) + EPS)


def heads(t, h, d):
    return t.reshape(t.shape[:-1] + (h, d))


def split_columns(z):
    out = []
    start = 0
    for w in IN_SPLITS:
        out.append(z[..., start:start + w])
        start += w
    return out


def causal_dwconv(x, w):
    k, c = w.shape
    return lax.conv_general_dilated(
        x, w[:, None, :].astype(x.dtype), window_strides=(1,), padding=[(k - 1, 0)],
        dimension_numbers=('NWC', 'WIO', 'NWC'), feature_group_count=c)


def rope_tables(s):
    inv = ROPE_THETA ** (-jnp.arange(0, MLA_ROPE, 2, dtype=jnp.float32) / MLA_ROPE)
    ang = jnp.arange(s, dtype=jnp.float32)[:, None] * inv[None, :]
    return jnp.cos(ang), jnp.sin(ang)


def apply_rope(x, cos, sin):
    xf = x.astype(jnp.float32)
    x1, x2 = xf[..., :MLA_ROPE // 2], xf[..., MLA_ROPE // 2:]
    return jnp.concatenate([x1 * cos - x2 * sin, x2 * cos + x1 * sin], axis=-1).astype(x.dtype)


def chunk_gla(q, k, v, log_f):
    bsz, s, h, dk = q.shape
    dv = v.shape[-1]
    n = s // CHUNK

    def to_chunks(t):
        return t.astype(jnp.float32).reshape(bsz, n, CHUNK, h, t.shape[-1]).transpose(1, 0, 3, 2, 4)

    qc, kc, vc, gc = to_chunks(q), to_chunks(k), to_chunks(v), to_chunks(log_f)
    bc = jnp.cumsum(gc, axis=3)
    causal = jnp.tril(jnp.ones((CHUNK, CHUNK), bool))[:, :, None]

    def step(state, inp):
        q_, k_, v_, b_ = inp
        diff = b_[:, :, :, None, :] - b_[:, :, None, :, :]
        decay = jnp.where(causal, jnp.exp(jnp.where(causal, diff, 0.0)), 0.0)
        attn = jnp.einsum('bhid,bhjd,bhijd->bhij', q_, k_, decay)
        b_last = b_[:, :, -1, :]
        o = (jnp.einsum('bhij,bhjv->bhiv', attn, v_)
             + jnp.einsum('bhid,bhdv->bhiv', q_ * jnp.exp(b_), state))
        state = (jnp.exp(b_last)[..., None] * state
                 + jnp.einsum('bhjd,bhjv->bhdv', k_ * jnp.exp(b_last[:, :, None, :] - b_), v_))
        return state, o

    s0 = jnp.zeros((bsz, h, dk, dv), jnp.float32)
    _, o = lax.scan(step, s0, (qc, kc, vc, bc))
    return o.transpose(1, 0, 3, 2, 4).reshape(bsz, s, h, dv)


def chunk_gated_delta(q, k, v, beta, log_g):
    bsz, s, h, dk = q.shape
    dv = v.shape[-1]
    n = s // CHUNK

    def to_chunks(t):
        t = t.astype(jnp.float32).reshape((bsz, n, CHUNK, h) + t.shape[3:])
        return jnp.moveaxis(t, (1, 3), (0, 2))

    qc, kc, vc = to_chunks(q), to_chunks(k), to_chunks(v)
    bt, gc = to_chunks(beta), to_chunks(log_g)
    b = jnp.cumsum(gc, axis=-1)
    incl = jnp.tril(jnp.ones((CHUNK, CHUNK), bool))
    strict = jnp.tril(jnp.ones((CHUNK, CHUNK), bool), -1)
    diff = b[..., :, None] - b[..., None, :]
    lmask = jnp.where(incl, jnp.exp(jnp.where(incl, diff, 0.0)), 0.0)
    kb = kc * bt[..., None]
    m = jnp.where(strict, jnp.einsum('nbhid,nbhjd->nbhij', kb, kc) * lmask, 0.0)
    eye = jnp.eye(CHUNK, dtype=jnp.float32)
    rhs = jnp.concatenate([vc * bt[..., None], kb * jnp.exp(b)[..., None]], axis=-1)
    sol = lax.linalg.triangular_solve(m + eye, rhs, left_side=True, lower=True, unit_diagonal=True)
    u, w = sol[..., :dv], sol[..., dv:]
    a_qk = jnp.einsum('nbhid,nbhjd->nbhij', qc, kc) * lmask

    def step(state, inp):
        q_, k_, u_, w_, a_, b_ = inp
        v_new = u_ - jnp.einsum('bhcd,bhdv->bhcv', w_, state)
        o = (jnp.einsum('bhcd,bhdv->bhcv', q_ * jnp.exp(b_)[..., None], state)
             + jnp.einsum('bhij,bhjv->bhiv', a_, v_new))
        b_last = b_[..., -1:]
        state = (jnp.exp(b_last)[..., None] * state
                 + jnp.einsum('bhcd,bhcv->bhdv', k_ * jnp.exp(b_last - b_)[..., None], v_new))
        return state, o

    s0 = jnp.zeros((bsz, h, dk, dv), jnp.float32)
    _, o = lax.scan(step, s0, (qc, kc, u, w, a_qk, b))
    return jnp.moveaxis(o, (0, 2), (1, 3)).reshape(bsz, s, h, dv)


def mla_attention(q_nope, q_rope, k_nope, k_rope, v):
    bsz, s, h, _ = q_nope.shape
    nb = s // Q_BLOCK
    scale = (MLA_NOPE + MLA_ROPE) ** -0.5
    key_pos = jnp.arange(s)

    def blocks(t):
        return jnp.moveaxis(t.reshape((bsz, nb, Q_BLOCK) + t.shape[2:]), 1, 0)

    def attend(args):
        qn, qr, blk = args
        sc = (jnp.einsum('bqhd,bkhd->bhqk', qn, k_nope)
              + jnp.einsum('bqhd,bkd->bhqk', qr, k_rope)).astype(jnp.float32) * scale
        q_pos = blk * Q_BLOCK + jnp.arange(Q_BLOCK)
        mask = key_pos[None, :] <= q_pos[:, None]
        p = jax.nn.softmax(jnp.where(mask, sc, MASK_VALUE), axis=-1)
        return jnp.einsum('bhqk,bkhv->bqhv', p.astype(v.dtype), v)

    o = lax.map(attend, (blocks(q_nope), blocks(q_rope), jnp.arange(nb)))
    return jnp.moveaxis(o, 0, 1).reshape(bsz, s, h, v.shape[-1])


def hgrn_lower_bounds(lb_logits):
    p = jax.nn.softmax(lb_logits.astype(jnp.float32), axis=0)
    return jnp.cumsum(p, axis=0) - p[0]


def hgrn2_mixer(q, f_logit, i, g, lb, norm_g):
    dtype = q.dtype
    zf = f_logit.astype(jnp.float32)
    f = lb + (1.0 - lb) * jax.nn.sigmoid(zf)
    log_f = jnp.log(jnp.maximum(f, MIN_POS))
    k = (1.0 - lb) * jax.nn.sigmoid(-zf)
    qh = heads(jax.nn.silu(q), HA, DK_A) * DK_A ** -0.5
    o = chunk_gla(qh, heads(k, HA, DK_A), heads(i, HA, DV_A), heads(log_f, HA, DK_A))
    o = rms_norm(o, norm_g) * jax.nn.sigmoid(heads(g, HA, DV_A).astype(jnp.float32))
    return o.reshape(o.shape[:2] + (HA * DV_A,)).astype(dtype)


def gla_mixer(q, k, v, gate_code, g, w_gk2, b_gk, norm_g):
    dtype = q.dtype
    log_gk = jax.nn.log_sigmoid((gate_code @ w_gk2 + b_gk).astype(jnp.float32)) / GLA_GATE_NORMALIZER
    o = chunk_gla(heads(q, HB, DK_B) * DK_B ** -0.5, heads(k, HB, DK_B), heads(v, HB, DV_B),
                  heads(log_gk, HB, DK_B))
    o = rms_norm(o, norm_g) * jax.nn.silu(heads(g, HB, DV_B).astype(jnp.float32))
    return o.reshape(o.shape[:2] + (HB * DV_B,)).astype(dtype)


def mla_mixer(c_q, c_kv, k_rope, q_norm_g, w_uq, kv_norm_g, w_ukv, cos, sin):
    dtype = c_q.dtype
    q = heads(rms_norm(c_q, q_norm_g) @ w_uq, HC, MLA_NOPE + MLA_ROPE)
    kv = heads(rms_norm(c_kv, kv_norm_g) @ w_ukv, HC, MLA_NOPE + MLA_V)
    q_nope = q[..., :MLA_NOPE]
    q_rope = apply_rope(q[..., MLA_NOPE:], cos[:, None, :], sin[:, None, :])
    k_nope, v = kv[..., :MLA_NOPE], kv[..., MLA_NOPE:]
    k_rope = apply_rope(k_rope, cos, sin)
    o = mla_attention(q_nope, q_rope, k_nope, k_rope, v)
    return o.reshape(o.shape[:2] + (HC * MLA_V,)).astype(dtype)


def gdn_mixer(q, k, v, beta_logit, a, z, conv_w, a_log, dt_bias, norm_g):
    dtype = q.dtype
    qkv = jax.nn.silu(causal_dwconv(jnp.concatenate([q, k, v], axis=-1), conv_w))
    qd = l2_norm(heads(qkv[..., :HD * DK_D], HD, DK_D)) * DK_D ** -0.5
    kd = l2_norm(heads(qkv[..., HD * DK_D:2 * HD * DK_D], HD, DK_D))
    vd = heads(qkv[..., 2 * HD * DK_D:], HD, DV_D)
    beta = jax.nn.sigmoid(beta_logit.astype(jnp.float32))
    log_g = -jnp.exp(a_log.astype(jnp.float32)) * jax.nn.softplus(a.astype(jnp.float32) + dt_bias)
    o = chunk_gated_delta(qd, kd, vd, beta, log_g)
    o = rms_norm(o, norm_g) * jax.nn.silu(heads(z, HD, DV_D).astype(jnp.float32))
    return o.reshape(o.shape[:2] + (HD * DV_D,)).astype(dtype)


def conv_glu_ffn(h, w_gate, w_up, conv_w, w_down):
    gate = causal_dwconv(h @ w_gate, conv_w)
    return (jax.nn.gelu(gate, approximate=True) * (h @ w_up)) @ w_down


def setup_inputs(seed: int = 0) -> dict:
    key = jax.random.key(seed)
    ks = jax.random.split(key, 26)

    def nrm(k, shape, scale):
        return jax.random.normal(k, shape, jnp.float32) * scale

    def gain(k, shape):
        return 1.0 + 0.1 * jax.random.normal(k, shape, jnp.float32)

    dt = jnp.exp(jax.random.uniform(ks[19], (DEPTH, HD), jnp.float32,
                                    jnp.log(1e-3), jnp.log(1e-1)))
    return {
        'x': jax.random.normal(ks[0], (BATCH, SEQ, D_MODEL), jnp.float32),
        'w_in': nrm(ks[1], (DEPTH, D_MODEL, D_IN), D_MODEL ** -0.5),
        'w_out': nrm(ks[2], (DEPTH, D_MIX, D_MODEL), D_MIX ** -0.5),
        'pre_mix_g': gain(ks[3], (DEPTH, D_MODEL)),
        'post_mix_g': gain(ks[4], (DEPTH, D_MODEL)),
        'pre_ffn_g': gain(ks[5], (DEPTH, D_MODEL)),
        'post_ffn_g': gain(ks[6], (DEPTH, D_MODEL)),
        'hgrn_lb_logits': nrm(ks[7], (DEPTH, HA * DK_A), 1.0),
        'hgrn_norm_g': gain(ks[8], (DEPTH, DV_A)),
        'gla_w_gk2': nrm(ks[9], (DEPTH, GLA_GATE_RANK, HB * DK_B), GLA_GATE_RANK ** -0.5),
        'gla_b_gk': nrm(ks[10], (DEPTH, HB * DK_B), 0.1),
        'gla_norm_g': gain(ks[11], (DEPTH, DV_B)),
        'mla_q_norm_g': gain(ks[12], (DEPTH, MLA_Q_RANK)),
        'mla_w_uq': nrm(ks[13], (DEPTH, MLA_Q_RANK, HC * (MLA_NOPE + MLA_ROPE)), MLA_Q_RANK ** -0.5),
        'mla_kv_norm_g': gain(ks[14], (DEPTH, MLA_KV_RANK)),
        'mla_w_ukv': nrm(ks[15], (DEPTH, MLA_KV_RANK, HC * (MLA_NOPE + MLA_V)), MLA_KV_RANK ** -0.5),
        'gdn_conv_w': nrm(ks[16], (DEPTH, GDN_CONV, HD * (2 * DK_D + DV_D)), GDN_CONV ** -0.5),
        'gdn_a_log': jnp.log(jax.random.uniform(ks[17], (DEPTH, HD), jnp.float32, 1.0, 16.0)),
        'gdn_dt_bias': dt + jnp.log(-jnp.expm1(-dt)),
        'gdn_norm_g': gain(ks[18], (DEPTH, DV_D)),
        'ffn_w_gate': nrm(ks[20], (DEPTH, D_MODEL, D_FF), D_MODEL ** -0.5),
        'ffn_w_up': nrm(ks[21], (DEPTH, D_MODEL, D_FF), D_MODEL ** -0.5),
        'ffn_conv_w': nrm(ks[22], (DEPTH, FFN_CONV, D_FF), FFN_CONV ** -0.5),
        'ffn_w_down': nrm(ks[23], (DEPTH, D_FF, D_MODEL), D_FF ** -0.5),
    }


def reference(x, w_in, w_out, pre_mix_g, post_mix_g, pre_ffn_g, post_ffn_g,
              hgrn_lb_logits, hgrn_norm_g, gla_w_gk2, gla_b_gk, gla_norm_g,
              mla_q_norm_g, mla_w_uq, mla_kv_norm_g, mla_w_ukv,
              gdn_conv_w, gdn_a_log, gdn_dt_bias, gdn_norm_g,
              ffn_w_gate, ffn_w_up, ffn_conv_w, ffn_w_down):
    s = x.shape[1]
    cos, sin = rope_tables(s)
    lower_bounds = hgrn_lower_bounds(hgrn_lb_logits)
    for l in range(DEPTH):
        h = rms_norm(x, pre_mix_g[l])
        z = h @ w_in[l]
        (a_q, a_f, a_i, a_g,
         b_q, b_k, b_v, b_code, b_g,
         c_q, c_kv, c_kr,
         d_q, d_k, d_v, d_beta, d_a, d_z) = split_columns(z)
        o_a = hgrn2_mixer(a_q, a_f, a_i, a_g, lower_bounds[l], hgrn_norm_g[l])
        o_b = gla_mixer(b_q, b_k, b_v, b_code, b_g, gla_w_gk2[l], gla_b_gk[l], gla_norm_g[l])
        o_c = mla_mixer(c_q, c_kv, c_kr, mla_q_norm_g[l], mla_w_uq[l], mla_kv_norm_g[l], mla_w_ukv[l], cos, sin)
        o_d = gdn_mixer(d_q, d_k, d_v, d_beta, d_a, d_z, gdn_conv_w[l], gdn_a_log[l], gdn_dt_bias[l], gdn_norm_g[l])
        mix = jnp.concatenate([o_a, o_b, o_c, o_d], axis=-1).astype(h.dtype) @ w_out[l]
        x = x + rms_norm(mix, post_mix_g[l])
        h = rms_norm(x, pre_ffn_g[l])
        y = conv_glu_ffn(h, ffn_w_gate[l], ffn_w_up[l], ffn_conv_w[l], ffn_w_down[l])
        x = x + rms_norm(y, post_ffn_g[l])
    return x
```

```cpp
#include <hip/hip_runtime.h>
#include <hip/hip_cooperative_groups.h>
#include <cstdio>
#include <cstdint>
namespace cg = cooperative_groups;

#define DI __device__ __forceinline__
typedef unsigned short bf16;
typedef __attribute__((ext_vector_type(8))) short bf16x8;
typedef __attribute__((ext_vector_type(4))) short bf16x4;
typedef __attribute__((ext_vector_type(16))) float f32x16;
typedef __attribute__((ext_vector_type(4))) float f32x4;
typedef __attribute__((ext_vector_type(4))) unsigned u32x4;
typedef __attribute__((ext_vector_type(2))) unsigned u32x2;

constexpr int T_ = 32768, S_ = 8192, D_ = 1024, ZLD = 3328, FF = 2816, DIN = 3256;
constexpr float EPS = 1e-6f;
constexpr int ZA_Q = 0, ZA_F = 256, ZA_I = 512, ZA_G = 768, ZB_Q = 1024, ZB_K = 1152, ZB_V = 1280, ZB_G = 1536, ZC_Q = 1792, ZC_KV = 2048,
              ZD_Q = 2176, ZD_K = 2432, ZD_V = 2688, ZD_Z = 2944, ZC_KR = 3200, ZB_CODE = 3232, ZD_BETA = 3248, ZD_A = 3252;
constexpr size_t WIN_E = (size_t)ZLD * 1024, WOUT_E = 1024 * 1024, WGU_E = (size_t)2 * FF * 1024, WDN_E = (size_t)1024 * FF, WUQ_E = 384 * 256, WUKV_E = 512 * 128;
constexpr size_t WO_IN = 0, WO_OUT = WO_IN + WIN_E, WO_GU = WO_OUT + WOUT_E, WO_DN = WO_GU + WGU_E, WO_UQ = WO_DN + WDN_E, WO_UKV = WO_UQ + WUQ_E, WL_E = WO_UKV + WUKV_E;
constexpr size_t OFF_W = 0;
constexpr size_t OFF_CTL = OFF_W + 2 * WL_E * 2;
constexpr size_t OFF_RS = OFF_CTL + 8192;
constexpr size_t OFF_GA = OFF_RS + (size_t)T_ * 4;
constexpr size_t OFF_GB = OFF_GA + (size_t)2048 * 64 * 4;
constexpr size_t OFF_AR = OFF_GB + (size_t)2048 * 32 * 4;
constexpr size_t AR_Z = 0, AR_Y = 0, AR_GATE = 0, AR_UP = (size_t)T_ * FF * 2;
constexpr size_t AR_SCAN = (size_t)T_ * ZLD * 2;
constexpr size_t AR_UTA = AR_SCAN, AR_UTB = AR_UTA + (size_t)2048 * 64 * 64 * 2, AR_ACD = AR_UTB + (size_t)2048 * 64 * 32 * 2, AR_BTD = AR_ACD + (size_t)2048 * 4096 * 4,
                 AR_QEFF = AR_BTD + (size_t)2048 * 4096 * 2, AR_OLOC = AR_QEFF + (size_t)2048 * 4096 * 2, AR_MLA = AR_OLOC + (size_t)2048 * 4096 * 2;
constexpr size_t AR_Q = AR_MLA, AR_K = AR_Q + (size_t)T_ * 4 * 96 * 2, AR_VT = AR_K + (size_t)T_ * 4 * 96 * 2, AR_MIX = AR_VT + (size_t)T_ * 4 * 64 * 2;
constexpr size_t AR_END = AR_MIX + (size_t)T_ * 1024 * 2;
constexpr size_t WS_END = OFF_AR + AR_END;
static_assert(WS_END <= (size_t)512 * 1024 * 1024, "workspace too large");
static_assert(AR_UP + (size_t)T_ * FF * 2 <= AR_MIX, "gate/up overlaps xb");

constexpr size_t BC_OFF = (size_t)T_ * 1024 * 2, BC_B_OFF = (size_t)2048 * 64 * 64 * 4;
static_assert(BC_OFF + BC_B_OFF + (size_t)2048 * 64 * 32 * 4 <= (size_t)T_ * 1024 * 4, "decay tables exceed the output buffer");
constexpr int LDS_HALF = 73728, LDS_BYTES = 2 * LDS_HALF;
#ifndef PROBE_DUP
#define PROBE_DUP 0
#endif

struct Params {
  const float* x; const float* w_in; const float* w_out; const float* pre_mix_g; const float* post_mix_g; const float* pre_ffn_g; const float* post_ffn_g;
  const float* hgrn_lb; const float* hgrn_ng; const float* gla_w2; const float* gla_b; const float* gla_ng;
  const float* mla_qg; const float* mla_wuq; const float* mla_kvg; const float* mla_wukv;
  const float* gdn_conv; const float* gdn_alog; const float* gdn_dtb; const float* gdn_ng;
  const float* ffn_wg; const float* ffn_wu; const float* ffn_conv; const float* ffn_wd;
  float* out; unsigned char* ws;
};

typedef __bf16 bf16v2_t __attribute__((ext_vector_type(2)));
typedef float f32v2_t __attribute__((ext_vector_type(2)));
DI unsigned pk_bf16(float lo, float hi) { f32v2_t v = {lo, hi}; bf16v2_t b = __builtin_convertvector(v, bf16v2_t); return __builtin_bit_cast(unsigned, b); }
DI float bf2f(bf16 v) { return __uint_as_float(((unsigned)v) << 16); }
DI bf16 f2bf(float x) { return (bf16)(pk_bf16(x, 0.f) & 0xffffu); }
DI float bflo(unsigned u) { return __uint_as_float(u << 16); }
DI float bfhi(unsigned u) { return __uint_as_float(u & 0xffff0000u); }
DI float sigmoidf_(float x) { return 1.f / (1.f + __expf(-x)); }
DI float siluf_(float x) { return x * sigmoidf_(x); }
DI float softplusf_(float x) { return fmaxf(x, 0.f) + __logf(1.f + __expf(-fabsf(x))); }
DI float wave_sum(float v) {
#pragma unroll
  for (int o = 1; o < 64; o <<= 1) v += __shfl_xor(v, o);
  return v;
}
#define MFMA32(a, b, c) __builtin_amdgcn_mfma_f32_32x32x16_bf16((a), (b), (c), 0, 0, 0)

DI f32x16 mm32(const unsigned char* A, int lda, const unsigned char* B, int ldb, int ks, f32x16 acc, int r, int h) {
  const unsigned char* pa = A + r * lda + h * 16;
  const unsigned char* pb = B + r * ldb + h * 16;
  for (int kk = 0; kk < ks; ++kk) {
    bf16x8 a = *(const bf16x8*)(pa + kk * 32);
    bf16x8 b = *(const bf16x8*)(pb + kk * 32);
    acc = MFMA32(a, b, acc);
  }
  return acc;
}
DI f32x16 zero16() { f32x16 z; for (int i = 0; i < 16; ++i) z[i] = 0.f; return z; }

DI int win_srccol(int n) {
  if (n < 1536) return n;
  if (n < 1792) return 1552 + (n - 1536);
  if (n < 2048) return 1808 + (n - 1792);
  if (n < 2176) return 2064 + (n - 2048);
  if (n < 2432) return 2224 + (n - 2176);
  if (n < 2688) return 2480 + (n - 2432);
  if (n < 2944) return 2736 + (n - 2688);
  if (n < 3200) return 3000 + (n - 2944);
  if (n < 3232) return 2192 + (n - 3200);
  if (n < 3248) return 1536 + (n - 3232);
  if (n < 3252) return 2992 + (n - 3248);
  if (n < 3256) return 2996 + (n - 3252);
  return -1;
}
DI int gu_rowmap(int c, int mode) { return mode == 0 ? c : ((c >> 7) * 256 + (c & 127) + (mode == 2 ? 128 : 0)); }
DI void transpose_tile(const float* __restrict__ src, int ldsrc, int K, bool perm, const float* __restrict__ gain, bf16* __restrict__ dst, int n0, int k0, unsigned char* lds, int tid, int rowmode = 0) {
  bf16* t = (bf16*)lds;
  const int nl = tid & 63, kq = tid >> 6;
  const int sc = perm ? win_srccol(n0 + nl) : (n0 + nl);
  float tv[16];
#pragma unroll
  for (int i = 0; i < 16; ++i) {
    const int k = k0 + kq + 4 * i;
    float v = 0.f;
    if (sc >= 0) { v = src[(size_t)k * ldsrc + sc]; if (gain) v *= gain[k]; }
    tv[i] = v;
  }
#pragma unroll
  for (int i = 0; i < 16; ++i) t[nl * 72 + kq + 4 * i] = f2bf(tv[i]);
  __syncthreads();
  const int r = tid >> 2, c = (tid & 3) * 16;
  u32x4 a = *(const u32x4*)(t + r * 72 + c), b = *(const u32x4*)(t + r * 72 + c + 8);
  bf16* o = dst + (size_t)gu_rowmap(n0 + r, rowmode) * K + k0 + c;
  *(u32x4*)o = a; *(u32x4*)(o + 8) = b;
  __syncthreads();
}

DI void frag_tile(const float* __restrict__ src, int ldsrc, bool isq, const float* __restrict__ gain, bf16* __restrict__ dst, int n0, int k0, int tid) {
  const int n = n0 + (tid & 63), kq = tid >> 6;
#pragma unroll
  for (int gi = 0; gi < 2; ++gi) {
    const int kg = k0 + (kq * 2 + gi) * 8;
    float v[8];
#pragma unroll
    for (int j = 0; j < 8; ++j) v[j] = src[(size_t)(kg + j) * ldsrc + n] * gain[kg + j];
    const int kk = kg >> 4, hh = (kg >> 3) & 1, r = n & 31;
    size_t off;
    if (isq) { const int hd = n / 96, nl = n % 96; off = ((size_t)(((hd * 16 + kk) * 3 + (nl >> 5)) * 64 + hh * 32 + r)) * 8; }
    else { const int hd = n >> 7, nl = n & 127; off = ((size_t)((((hd * 2 + (nl >> 6)) * 8 + kk) * 2 + ((nl >> 5) & 1)) * 64 + hh * 32 + r)) * 8; }
    u32x4 w; w.x = pk_bf16(v[0], v[1]); w.y = pk_bf16(v[2], v[3]); w.z = pk_bf16(v[4], v[5]); w.w = pk_bf16(v[6], v[7]);
    *(u32x4*)(dst + off) = w;
  }
  __syncthreads();
  __syncthreads();
}
DI void phase0(const Params& p, unsigned char* lds, int tid, int half) {
  bf16* W = (bf16*)(p.ws + OFF_W);
  constexpr int NT_L = 832 + 256 + 704 + 704 + 704 + 24 + 16;
  for (int pi = blockIdx.x; pi < NT_L; pi += gridDim.x) {
    const int it = 2 * pi + half;
    const int l = it / NT_L; int r = it % NT_L;
    bf16* Wl = W + (size_t)l * WL_E;
    if (r < 832) { transpose_tile(p.w_in + (size_t)l * 1024 * DIN, DIN, 1024, true, p.pre_mix_g + l * 1024, Wl + WO_IN, (r / 16) * 64, (r % 16) * 64, lds, tid); continue; } r -= 832;
    if (r < 256) { transpose_tile(p.w_out + (size_t)l * 1024 * 1024, 1024, 1024, false, nullptr, Wl + WO_OUT, (r / 16) * 64, (r % 16) * 64, lds, tid); continue; } r -= 256;
    if (r < 704) { transpose_tile(p.ffn_wg + (size_t)l * 1024 * FF, FF, 1024, false, p.pre_ffn_g + l * 1024, Wl + WO_GU, (r / 16) * 64, (r % 16) * 64, lds, tid, 1); continue; } r -= 704;
    if (r < 704) { transpose_tile(p.ffn_wu + (size_t)l * 1024 * FF, FF, 1024, false, p.pre_ffn_g + l * 1024, Wl + WO_GU, (r / 16) * 64, (r % 16) * 64, lds, tid, 2); continue; } r -= 704;
    if (r < 704) { transpose_tile(p.ffn_wd + (size_t)l * FF * 1024, 1024, FF, false, nullptr, Wl + WO_DN, (r / 44) * 64, (r % 44) * 64, lds, tid); continue; } r -= 704;
    if (r < 24) { frag_tile(p.mla_wuq + (size_t)l * 256 * 384, 384, true, p.mla_qg + l * 256, Wl + WO_UQ, (r / 4) * 64, (r % 4) * 64, tid); continue; } r -= 24;
    frag_tile(p.mla_wukv + (size_t)l * 128 * 512, 512, false, p.mla_kvg + l * 128, Wl + WO_UKV, (r / 2) * 64, (r % 2) * 64, tid);
  }
}

DI void resid_phase(const float* __restrict__ xin, const bf16* __restrict__ xinb, const bf16* __restrict__ y, const float* __restrict__ g, float* __restrict__ xout, bf16* __restrict__ xb, float* __restrict__ rs, int tid, int vb, int nvb) {
  const int lane = tid & 63, wv = tid >> 6;
  const int stride = nvb * 4;
  for (int row0 = vb * 4 + wv; row0 < T_; row0 += 2 * stride) {
    f32x4 v[2][4]; u32x2 yu[2][4];
#pragma unroll
    for (int q = 0; q < 2; ++q) {
      const int row = min(row0 + q * stride, T_ - 1);
      if (xin) {
#pragma unroll
        for (int j = 0; j < 4; ++j) v[q][j] = *(const f32x4*)(xin + (size_t)row * 1024 + lane * 4 + 256 * j);
      } else {
#pragma unroll
        for (int j = 0; j < 4; ++j) { const u32x2 u = *(const u32x2*)(xinb + (size_t)row * 1024 + lane * 4 + 256 * j); v[q][j] = (f32x4){bflo(u.x), bfhi(u.x), bflo(u.y), bfhi(u.y)}; }
      }
      if (y) {
#pragma unroll
        for (int j = 0; j < 4; ++j) yu[q][j] = *(const u32x2*)(y + (size_t)row * 1024 + lane * 4 + 256 * j);
      }
    }
#pragma unroll
    for (int q = 0; q < 2; ++q) {
      const int row = row0 + q * stride;
      if (y) {
        f32x4 yv[4]; float ss = 0.f;
#pragma unroll
        for (int j = 0; j < 4; ++j) {
          yv[j] = (f32x4){bflo(yu[q][j].x), bfhi(yu[q][j].x), bflo(yu[q][j].y), bfhi(yu[q][j].y)};
          ss += yv[j].x * yv[j].x + yv[j].y * yv[j].y + yv[j].z * yv[j].z + yv[j].w * yv[j].w;
        }
        const float ry = rsqrtf(wave_sum(ss) * (1.f / 1024.f) + EPS);
#pragma unroll
        for (int j = 0; j < 4; ++j) { f32x4 gg = *(const f32x4*)(g + lane * 4 + 256 * j); v[q][j] = v[q][j] + yv[j] * ry * gg; }
      }
      float sx = 0.f;
#pragma unroll
      for (int j = 0; j < 4; ++j) sx += v[q][j].x * v[q][j].x + v[q][j].y * v[q][j].y + v[q][j].z * v[q][j].z + v[q][j].w * v[q][j].w;
      sx = wave_sum(sx);
      if (row < T_) {
#pragma unroll
        for (int j = 0; j < 4; ++j) {
          if (xout) *(f32x4*)(xout + (size_t)row * 1024 + lane * 4 + 256 * j) = v[q][j];
          if (xb) {
            u32x2 o; o.x = pk_bf16(v[q][j].x, v[q][j].y); o.y = pk_bf16(v[q][j].z, v[q][j].w);
            *(u32x2*)(xb + (size_t)row * 1024 + lane * 4 + 256 * j) = o;
          }
        }
        if (xb && lane == 0) rs[row] = rsqrtf(sx * (1.f / 1024.f) + EPS);
      }
    }
  }
}

DI float gelu_tanh(float x) {
  const float u = 0.7978845608028654f * (x + 0.044715f * x * x * x);
  const float e = __expf(2.f * u);
  const float th = 1.f - 2.f / (e + 1.f);
  return 0.5f * x * (1.f + th);
}
struct EpiStore {
  bf16* out0; bf16* out1; int split; int ldc; const float* rs; const float* cw;
  DI void store4(int m, int n, f32x4 v) const {
    bf16* o = out0; if (n >= split) { o = out1; n -= split; }
    u32x2 w; w.x = pk_bf16(v.x, v.y); w.y = pk_bf16(v.z, v.w);
    *(u32x2*)(o + (size_t)m * ldc + n) = w;
  }
};

#define GL_LAS __attribute__((address_space(3)))
DI int g8_lds_byte(int r, int c) { const int st = (r >> 4) * 2 + (c >> 5), rr = r & 15, cc = c & 31, ob = rr * 64 + cc * 2; return st * 1024 + (ob ^ (((ob >> 9) & 1) << 5)); }
DI void g8_stage_rc(int b, int& R, int& C) { const int st = b / 1024, sb = b % 1024, swz = sb ^ (((sb >> 9) & 1) << 5); R = (st >> 1) * 16 + swz / 64; C = (st & 1) * 32 + (swz % 64) / 2; }
template <bool ACT>
DI void gemm_phase(const bf16* __restrict__ A, int lda, const bf16* __restrict__ Bt, int ldb, int K, int MT, int NT, const EpiStore& epi, unsigned char* lds, int tid) {
  constexpr int HTB = 128 * 64 * 2;
  const int nt_k = K / 64;
  const int xcd = blockIdx.x & 7, jb = blockIdx.x >> 3, nbx = (gridDim.x + 7 - xcd) >> 3;
  const int band = MT / 8, per_x = band * NT;
  for (int lt = jb; lt < per_x; lt += nbx) {
    const int mg = lt / (8 * NT), rem = lt % (8 * NT), gs = min(8, band - 8 * mg);
    const int mt = xcd * band + mg * 8 + rem % gs, nt = rem / gs, n0 = nt * 256;
    int m0 = mt * 256, seq0 = 0;
    if (ACT) { const int bs = mt / 34, ti = mt % 34; if (ti == 33) continue; seq0 = bs * S_; m0 = seq0 + 254 * ti - 2; }
    __syncthreads();
    asm volatile("" : "+v"(tid));
    const int wid = tid >> 6, lane = tid & 63, wr = wid >> 2, wc = wid & 3, fr = lane & 15, fq = lane >> 4;
    const int obs = (fr * 64 + fq * 16) ^ ((((fr * 64 + fq * 16) >> 9) & 1) << 5);
    const int a_rd = obs + wr * 8192, b_rd = obs + wc * 4096;
#define SA8(b, h) (lds + ((b) * 2 + (h)) * HTB)
#define SB8(b, h) (lds + (4 + (b) * 2 + (h)) * HTB)
    unsigned aofs[2][2], bofs[2];
#pragma unroll
    for (int i = 0; i < 2; ++i) {
      int sr_, sc_; g8_stage_rc(tid * 16 + i * 8192, sr_, sc_);
      bofs[i] = ((unsigned)(n0 + sr_) * (unsigned)ldb + (unsigned)sc_) * 2u;
#pragma unroll
      for (int hf = 0; hf < 2; ++hf) {
        int row = m0 + sr_ + (ACT ? hf * 128 : 0); if (ACT) row = min(max(row, seq0), seq0 + S_ - 1);
        aofs[hf][i] = ((unsigned)row * (unsigned)lda + (unsigned)sc_) * 2u;
      }
    }
#define STAGE_A(P, half_, kt) do { const unsigned char* ub_ = (const unsigned char*)A + (size_t)(kt) * 128 + (ACT ? (size_t)0 : (size_t)(half_) * 256 * (size_t)lda); _Pragma("unroll") for (int _i = 0; _i < 2; ++_i) \
      __builtin_amdgcn_global_load_lds((const unsigned*)(ub_ + aofs[half_][_i]), (GL_LAS unsigned*)((P) + tid * 16 + _i * 8192), 16, 0, 0); } while (0)
#define STAGE_B(P, half_, kt) do { const unsigned char* ub_ = (const unsigned char*)Bt + (size_t)(kt) * 128 + (size_t)(half_) * 256 * (size_t)ldb; _Pragma("unroll") for (int _i = 0; _i < 2; ++_i) \
      __builtin_amdgcn_global_load_lds((const unsigned*)(ub_ + bofs[_i]), (GL_LAS unsigned*)((P) + tid * 16 + _i * 8192), 16, 0, 0); } while (0)
#define LDA8(dst, b, h) _Pragma("unroll") for (int m = 0; m < 4; ++m) _Pragma("unroll") for (int k = 0; k < 2; ++k) \
      dst[m][k] = *(const bf16x8*)(SA8(b, h) + a_rd + m * 2048 + k * 1024)
#define LDB8(dst, b, h) _Pragma("unroll") for (int n = 0; n < 2; ++n) _Pragma("unroll") for (int k = 0; k < 2; ++k) \
      dst[n][k] = *(const bf16x8*)(SB8(b, h) + b_rd + n * 2048 + k * 1024)
#define MMA8(ai, bj, At_, Bt_) do { __builtin_amdgcn_s_setprio(1); \
      _Pragma("unroll") for (int m = 0; m < 4; ++m) _Pragma("unroll") for (int n = 0; n < 2; ++n) _Pragma("unroll") for (int k = 0; k < 2; ++k) \
        acc[ai][bj][m][n] = __builtin_amdgcn_mfma_f32_16x16x32_bf16(Bt_[n][k], At_[m][k], acc[ai][bj][m][n], 0, 0, 0); \
      __builtin_amdgcn_s_setprio(0); } while (0)
#define WAIT_V(n) asm volatile("s_waitcnt vmcnt(" #n ")" ::: "memory")
#define WAIT_L(n) asm volatile("s_waitcnt lgkmcnt(" #n ")" ::: "memory")
#define BAR8 __builtin_amdgcn_s_barrier()
#define SCHED8 __builtin_amdgcn_sched_barrier(0)
    f32x4 acc[2][2][4][2];
#pragma unroll
    for (int i0 = 0; i0 < 2; ++i0)
#pragma unroll
      for (int i1 = 0; i1 < 2; ++i1)
#pragma unroll
        for (int i2 = 0; i2 < 4; ++i2)
#pragma unroll
          for (int i3 = 0; i3 < 2; ++i3) acc[i0][i1][i2][i3] = (f32x4){0.f, 0.f, 0.f, 0.f};
    bf16x8 At[4][2], B0[2][2], B1[2][2];
    WAIT_V(0);
    STAGE_B(SB8(0, 0), 0, 0); STAGE_A(SA8(0, 0), 0, 0);
    STAGE_B(SB8(0, 1), 1, 0); STAGE_A(SA8(0, 1), 1, 0);
    if (wr == 1) BAR8;
    WAIT_V(4); BAR8;
    STAGE_B(SB8(1, 0), 0, 1); STAGE_A(SA8(1, 0), 0, 1); STAGE_B(SB8(1, 1), 1, 1);
    WAIT_V(6); BAR8;
    for (int t = 0; t < nt_k - 2; t += 2) {
      LDB8(B0, 0, 0); SCHED8; LDA8(At, 0, 0); STAGE_A(SA8(1, 1), 1, t + 1);
      WAIT_L(8); BAR8; WAIT_L(0); MMA8(0, 0, At, B0); BAR8; SCHED8;
      LDB8(B1, 0, 1); STAGE_B(SB8(0, 0), 0, t + 2);
      BAR8; WAIT_L(0); MMA8(0, 1, At, B1); BAR8;
      LDA8(At, 0, 1); STAGE_A(SA8(0, 0), 0, t + 2);
      BAR8; WAIT_L(0); MMA8(1, 0, At, B0); BAR8; SCHED8;
      STAGE_B(SB8(0, 1), 1, t + 2);
      WAIT_V(6); BAR8; MMA8(1, 1, At, B1); BAR8;
      LDB8(B0, 1, 0); SCHED8; LDA8(At, 1, 0); STAGE_A(SA8(0, 1), 1, t + 2);
      WAIT_L(8); BAR8; WAIT_L(0); MMA8(0, 0, At, B0); BAR8; SCHED8;
      LDB8(B1, 1, 1); STAGE_B(SB8(1, 0), 0, t + 3);
      BAR8; WAIT_L(0); MMA8(0, 1, At, B1); BAR8;
      LDA8(At, 1, 1); STAGE_A(SA8(1, 0), 0, t + 3);
      BAR8; WAIT_L(0); MMA8(1, 0, At, B0); BAR8; SCHED8;
      STAGE_B(SB8(1, 1), 1, t + 3);
      WAIT_V(6); BAR8; MMA8(1, 1, At, B1); BAR8;
    }
    { LDB8(B0, 0, 0); LDA8(At, 0, 0); STAGE_A(SA8(1, 1), 1, nt_k - 1);
      BAR8; WAIT_L(0); MMA8(0, 0, At, B0); BAR8;
      LDB8(B1, 0, 1); BAR8; WAIT_L(0); MMA8(0, 1, At, B1); BAR8;
      LDA8(At, 0, 1); WAIT_V(4); BAR8; WAIT_L(0); MMA8(1, 0, At, B0); MMA8(1, 1, At, B1); BAR8; }
    { LDB8(B0, 1, 0); LDA8(At, 1, 0); WAIT_V(2); BAR8; WAIT_L(0); MMA8(0, 0, At, B0); BAR8;
      LDB8(B1, 1, 1); WAIT_V(0); BAR8; WAIT_L(0); MMA8(0, 1, At, B1); BAR8;
      LDA8(At, 1, 1); BAR8; WAIT_L(0); MMA8(1, 0, At, B0); MMA8(1, 1, At, B1); BAR8; }
    if (wr == 0) BAR8;
    __syncthreads();
    int tid_e = tid; asm volatile("" : "+v"(tid_e));
    const int e_wid = tid_e >> 6, e_lane = tid_e & 63, e_wr = e_wid >> 2, e_wc = e_wid & 3, e_fr = e_lane & 15, e_fq = e_lane >> 4;
    if (!ACT) {
#pragma unroll
      for (int ai = 0; ai < 2; ++ai)
#pragma unroll
        for (int m = 0; m < 4; ++m) {
          const int ml = ai * 128 + e_wr * 64 + m * 16 + e_fr;
          const float sc = epi.rs ? epi.rs[m0 + ml] : 1.f;
#pragma unroll
          for (int bj = 0; bj < 2; ++bj)
#pragma unroll
            for (int n = 0; n < 2; ++n) {
              const f32x4 v = acc[ai][bj][m][n] * sc;
              u32x2 w2; w2.x = pk_bf16(v[0], v[1]); w2.y = pk_bf16(v[2], v[3]);
              *(u32x2*)(lds + ml * 520 + (bj * 128 + e_wc * 32 + n * 16 + e_fq * 4) * 2) = w2;
            }
        }
      __syncthreads();
#pragma unroll 2
      for (int k = 0; k < 16; ++k) {
        const int id = tid_e + 512 * k, row = id >> 5, ch = id & 31;
        const u32x2 lo = *(const u32x2*)(lds + row * 520 + ch * 16), hi = *(const u32x2*)(lds + row * 520 + ch * 16 + 8);
        *(u32x4*)(epi.out0 + (size_t)(m0 + row) * epi.ldc + n0 + ch * 8) = (u32x4){lo.x, lo.y, hi.x, hi.y};
      }
    } else {
      float* G = (float*)lds;
#pragma unroll
      for (int ai = 0; ai < 2; ++ai)
#pragma unroll
        for (int m = 0; m < 4; ++m) {
          const int ml = ai * 128 + e_wr * 64 + m * 16 + e_fr;
          const float sc = epi.rs[min(max(m0 + ml, seq0), seq0 + S_ - 1)];
#pragma unroll
          for (int n = 0; n < 2; ++n) {
            acc[ai][0][m][n] = acc[ai][0][m][n] * sc; acc[ai][1][m][n] = acc[ai][1][m][n] * sc;
#pragma unroll
            for (int j = 0; j < 4; ++j) G[(e_wc * 32 + n * 16 + e_fq * 4 + j) * 256 + ml] = acc[ai][0][m][n][j];
          }
        }
      __syncthreads();
#pragma unroll
      for (int n = 0; n < 2; ++n) {
        const int chl = e_wc * 32 + n * 16 + e_fq * 4, c = nt * 128 + chl;
        const f32x4 w0 = *(const f32x4*)(epi.cw + c), w1 = *(const f32x4*)(epi.cw + FF + c), w2 = *(const f32x4*)(epi.cw + 2 * FF + c);
#pragma unroll
        for (int ai = 0; ai < 2; ++ai)
#pragma unroll
          for (int m = 0; m < 4; ++m) {
            const int ml = ai * 128 + e_wr * 64 + m * 16 + e_fr, t = m0 + ml, sq = t - seq0;
            const int m1 = max(ml - 1, 0), m2 = max(ml - 2, 0);
            float o[4];
#pragma unroll
            for (int j = 0; j < 4; ++j) {
              const float g0 = acc[ai][0][m][n][j];
              const float g1 = (sq >= 1) ? G[(chl + j) * 256 + m1] : 0.f;
              const float g2 = (sq >= 2) ? G[(chl + j) * 256 + m2] : 0.f;
              const float cv = w0[j] * g2 + w1[j] * g1 + w2[j] * g0;
              o[j] = gelu_tanh(cv) * acc[ai][1][m][n][j];
            }
            if (ml >= 2 && sq < S_) {
              u32x2 wv2; wv2.x = pk_bf16(o[0], o[1]); wv2.y = pk_bf16(o[2], o[3]);
              *(u32x2*)(epi.out0 + (size_t)t * FF + c) = wv2;
            }
          }
      }
    }
  }
  __syncthreads();
}

DI void ffn_act_phase(const bf16* __restrict__ gate, bf16* __restrict__ up, const float* __restrict__ cw, int tid) {
  constexpr int CG = FF / 8;
  const int total = (T_ / 16) * CG;
  for (int it = blockIdx.x * 256 + tid; it < total; it += gridDim.x * 256) {
    const int tb = it / CG, cgp = it % CG, t0 = tb * 16, c0 = cgp * 8;
    float w0[8], w1[8], w2[8], g1[8], g2[8];
#pragma unroll
    for (int i = 0; i < 8; ++i) { w0[i] = cw[c0 + i]; w1[i] = cw[FF + c0 + i]; w2[i] = cw[2 * FF + c0 + i]; g1[i] = 0.f; g2[i] = 0.f; }
    if ((t0 & (S_ - 1)) != 0) {
      u32x4 a = *(const u32x4*)(gate + (size_t)(t0 - 2) * FF + c0), b = *(const u32x4*)(gate + (size_t)(t0 - 1) * FF + c0);
#pragma unroll
      for (int i = 0; i < 4; ++i) { g2[2 * i] = bflo(a[i]); g2[2 * i + 1] = bfhi(a[i]); g1[2 * i] = bflo(b[i]); g1[2 * i + 1] = bfhi(b[i]); }
    }
#pragma unroll 4
    for (int t = t0; t < t0 + 16; ++t) {
      u32x4 a = *(const u32x4*)(gate + (size_t)t * FF + c0), u = *(const u32x4*)(up + (size_t)t * FF + c0);
      float g0[8], uu[8], o[8];
#pragma unroll
      for (int i = 0; i < 4; ++i) { g0[2 * i] = bflo(a[i]); g0[2 * i + 1] = bfhi(a[i]); uu[2 * i] = bflo(u[i]); uu[2 * i + 1] = bfhi(u[i]); }
#pragma unroll
      for (int i = 0; i < 8; ++i) { const float c = w0[i] * g2[i] + w1[i] * g1[i] + w2[i] * g0[i]; o[i] = gelu_tanh(c) * uu[i]; g2[i] = g1[i]; g1[i] = g0[i]; }
      u32x4 w; w.x = pk_bf16(o[0], o[1]); w.y = pk_bf16(o[2], o[3]); w.z = pk_bf16(o[4], o[5]); w.w = pk_bf16(o[6], o[7]);
      *(u32x4*)(up + (size_t)t * FF + c0) = w;
    }
  }
}

template <int DK, bool ISA>
DI float gla_lb(const Params& p, int l, int h, int d) {
  if (!ISA || l == 0) return 0.f;
  const float l0 = p.hgrn_lb[h * 64 + d], l1 = p.hgrn_lb[256 + h * 64 + d];
  return 1.f / (1.f + __expf(l0 - l1));
}
template <int DK, bool ISA>
DI void gla_bc(const Params& p, int l, const bf16* __restrict__ z, int t0, int h, float* bcl, int tid) {
  constexpr int NP = 256 / DK, TPP = 64 / NP;
  const int d = tid % DK, part = tid / DK;
  float run = 0.f;
  if (ISA) {
    const float lbv = gla_lb<DK, ISA>(p, l, h, d);
#pragma unroll
    for (int jj = 0; jj < TPP; ++jj) {
      const int j = part * TPP + jj;
      const float zf = bf2f(z[(size_t)(t0 + j) * ZLD + ZA_F + h * 64 + d]);
      const float f = lbv + (1.f - lbv) * sigmoidf_(zf);
      run += __logf(fmaxf(f, 1e-30f));
      bcl[j * DK + d] = run;
    }
  } else {
    float w[16];
#pragma unroll
    for (int rr = 0; rr < 16; ++rr) w[rr] = p.gla_w2[(size_t)l * 16 * 128 + rr * 128 + h * 32 + d];
    const float bias = p.gla_b[l * 128 + h * 32 + d];
#pragma unroll
    for (int jj = 0; jj < TPP; ++jj) {
      const int j = part * TPP + jj;
      const u32x4* cp = (const u32x4*)(z + (size_t)(t0 + j) * ZLD + ZB_CODE);
      u32x4 c0 = cp[0], c1 = cp[1];
      float u = bias;
#pragma unroll
      for (int i = 0; i < 4; ++i) { u += bflo(c0[i]) * w[2 * i] + bfhi(c0[i]) * w[2 * i + 1]; u += bflo(c1[i]) * w[8 + 2 * i] + bfhi(c1[i]) * w[8 + 2 * i + 1]; }
      run += -softplusf_(-u) * (1.f / 16.f);
      bcl[j * DK + d] = run;
    }
  }
  __syncthreads();
  float off = 0.f;
  for (int pp = 0; pp < part; ++pp) off += bcl[(pp * TPP + TPP - 1) * DK + d];
  __syncthreads();
#pragma unroll
  for (int jj = 0; jj < TPP; ++jj) bcl[(part * TPP + jj) * DK + d] += off;
  __syncthreads();
}
template <int DK, bool ISA>
DI float gla_kval(const bf16* __restrict__ z, int t, int h, int d, float lbv) {
  if (ISA) { const float zf = bf2f(z[(size_t)t * ZLD + ZA_F + h * 64 + d]); return (1.f - lbv) * sigmoidf_(-zf); }
  return bf2f(z[(size_t)t * ZLD + ZB_K + h * 32 + d]);
}
template <int DK, bool ISA>
DI float gla_qval(const bf16* __restrict__ z, int t, int h, int d) {
  if (ISA) { const float zq = bf2f(z[(size_t)t * ZLD + ZA_Q + h * 64 + d]); return siluf_(zq) * 0.125f; }
  return bf2f(z[(size_t)t * ZLD + ZB_Q + h * 32 + d]) * 0.17677669529663687f;
}

template <int DK, bool ISA>
DI void gla_local_item(const Params& p, int l, int ci, unsigned char* lds, int tid) {
  const bf16* z = (const bf16*)(p.ws + OFF_AR + AR_Z);
  bf16* UT = (bf16*)(p.ws + OFF_AR + (ISA ? AR_UTA : AR_UTB));
  float* G = (float*)(p.ws + (ISA ? OFF_GA : OFF_GB));
  const int h = ci & 3, t0 = (ci >> 2) * 64;
  float* bcl = (float*)lds;
  bf16* kT = (bf16*)(lds + 16384);
  bf16* vT = (bf16*)(lds + 16384 + 9216);
  bf16 vpre[16];
  {
    const int e = tid & 63, p4 = tid >> 6;
    const int vcol = (ISA ? ZA_I : ZB_V) + h * 64 + e;
#pragma unroll
    for (int jj = 0; jj < 16; ++jj) vpre[jj] = z[(size_t)(t0 + p4 * 16 + jj) * ZLD + vcol];
  }
  gla_bc<DK, ISA>(p, l, z, t0, h, bcl, tid);
  {
    float* bcg = (float*)((unsigned char*)p.out + BC_OFF + (ISA ? 0 : BC_B_OFF)) + (size_t)ci * 64 * DK;
#pragma unroll
    for (int k = 0; k < (64 * DK) / 1024; ++k) *(f32x4*)(bcg + (tid + 256 * k) * 4) = *(const f32x4*)(bcl + (tid + 256 * k) * 4);
  }
  constexpr int NP = 256 / DK, TPP = 64 / NP;
  {
    const int d = tid % DK, part = tid / DK;
    const float lbv = gla_lb<DK, ISA>(p, l, h, d);
    const float bl = bcl[63 * DK + d];
#pragma unroll
    for (int jj = 0; jj < TPP; ++jj) {
      const int j = part * TPP + jj;
      const float kv = gla_kval<DK, ISA>(z, t0 + j, h, d, lbv);
      kT[d * 72 + j] = f2bf(kv * __expf(bl - bcl[j * DK + d]));
    }
    if (part == 0) G[(size_t)ci * DK + d] = __expf(bl);
    const int e = tid & 63, p4 = tid >> 6;
#pragma unroll
    for (int jj = 0; jj < 16; ++jj) { const int j = p4 * 16 + jj; vT[e * 72 + j] = vpre[jj]; }
  }
  __syncthreads();
  const int lane = tid & 63, wv = tid >> 6, wm = wv & 1, wn = wv >> 1, r = lane & 31, hh = lane >> 5;
  if (wm * 32 < DK) {
    f32x16 acc = mm32((const unsigned char*)(kT + wm * 32 * 72), 144, (const unsigned char*)(vT + wn * 32 * 72), 144, 4, zero16(), r, hh);
    const int e = wn * 32 + r;
#pragma unroll
    for (int g = 0; g < 4; ++g) {
      const int d = wm * 32 + 8 * g + 4 * hh;
      u32x2 w; w.x = pk_bf16(acc[4 * g], acc[4 * g + 1]); w.y = pk_bf16(acc[4 * g + 2], acc[4 * g + 3]);
      *(u32x2*)(UT + ((size_t)ci * 64 + e) * DK + d) = w;
    }
  }
  __syncthreads();
}

template <int DK>
DI void gla_scan_item(bf16* __restrict__ UT, const float* __restrict__ G, int b, int h, int slice, int tid) {
  constexpr int GPR = DK / 4, RPS = 256 / GPR;
  const int e = slice * RPS + tid / GPR, d4 = (tid % GPR) * 4;
  f32x4 st = (f32x4){0.f, 0.f, 0.f, 0.f};
  for (int c0 = 0; c0 < 128; c0 += 8) {
    u32x2 u[8]; f32x4 gg[8];
#pragma unroll
    for (int i = 0; i < 8; ++i) {
      const size_t ci = ((size_t)(b * 128 + c0 + i) * 4 + h);
      u[i] = *(const u32x2*)(UT + (ci * 64 + e) * DK + d4);
      gg[i] = *(const f32x4*)(G + ci * DK + d4);
    }
#pragma unroll
    for (int i = 0; i < 8; ++i) {
      const size_t ci = ((size_t)(b * 128 + c0 + i) * 4 + h);
      u32x2 w; w.x = pk_bf16(st.x, st.y); w.y = pk_bf16(st.z, st.w);
      *(u32x2*)(UT + (ci * 64 + e) * DK + d4) = w;
      st = gg[i] * st + (f32x4){bflo(u[i].x), bfhi(u[i].x), bflo(u[i].y), bfhi(u[i].y)};
    }
  }
}

template <bool SIG>
DI void norm_gate_store(const float* obuf, bool has_add, u32x4 a0, u32x4 a1, const float* __restrict__ ng, u32x4 g0, u32x4 g1, bf16* __restrict__ mixo, int tid) {
  const int i = tid >> 2, e0 = (tid & 3) * 16;
  float o[16]; float ss = 0.f;
#pragma unroll
  for (int k = 0; k < 16; ++k) o[k] = obuf[i * 68 + e0 + k];
  if (has_add) {
#pragma unroll
    for (int k = 0; k < 4; ++k) { o[2 * k] += bflo(a0[k]); o[2 * k + 1] += bfhi(a0[k]); o[8 + 2 * k] += bflo(a1[k]); o[8 + 2 * k + 1] += bfhi(a1[k]); }
  }
#pragma unroll
  for (int k = 0; k < 16; ++k) ss += o[k] * o[k];
  ss += __shfl_xor(ss, 1); ss += __shfl_xor(ss, 2);
  const float rsv = rsqrtf(ss * (1.f / 64.f) + EPS);
  float gt[16];
#pragma unroll
  for (int k = 0; k < 4; ++k) { gt[2 * k] = bflo(g0[k]); gt[2 * k + 1] = bfhi(g0[k]); gt[8 + 2 * k] = bflo(g1[k]); gt[8 + 2 * k + 1] = bfhi(g1[k]); }
  unsigned w[8];
#pragma unroll
  for (int k = 0; k < 8; ++k) {
    float a = o[2 * k] * rsv * ng[e0 + 2 * k], b = o[2 * k + 1] * rsv * ng[e0 + 2 * k + 1];
    a *= SIG ? sigmoidf_(gt[2 * k]) : siluf_(gt[2 * k]);
    b *= SIG ? sigmoidf_(gt[2 * k + 1]) : siluf_(gt[2 * k + 1]);
    w[k] = pk_bf16(a, b);
  }
  u32x4* op = (u32x4*)(mixo + (size_t)i * 1024 + e0);
  op[0] = (u32x4){w[0], w[1], w[2], w[3]}; op[1] = (u32x4){w[4], w[5], w[6], w[7]};
}

template <int DK, bool ISA>
DI void gla_out_item(const Params& p, int l, int ci, unsigned char* lds, int tid) {
  const bf16* z = (const bf16*)(p.ws + OFF_AR + AR_Z);
  const bf16* ST = (const bf16*)(p.ws + OFF_AR + (ISA ? AR_UTA : AR_UTB));
  bf16* mix = (bf16*)(p.ws + OFF_AR + AR_MIX);
  const int h = ci & 3, t0 = (ci >> 2) * 64;
  constexpr int LDK = (DK + 8) * 2;
  float* bcl = (float*)lds;
  float* obuf = (float*)lds;
  unsigned char* qh = lds + 17408;
  unsigned char* kt = qh + 9216;
  unsigned char* qc = kt + 9216;
  unsigned char* vT = qc + 9216;
  unsigned char* stl = vT + 9216;
  unsigned char* attn = stl + 9216;
  const u32x4* gpre = (const u32x4*)(z + (size_t)(t0 + (tid >> 2)) * ZLD + (ISA ? ZA_G : ZB_G) + h * 64 + (tid & 3) * 16);
  const u32x4 gq0 = gpre[0], gq1 = gpre[1];
  bf16 vpre[16];
  {
    const int e = tid & 63, p4 = tid >> 6;
    const int vcol = (ISA ? ZA_I : ZB_V) + h * 64 + e;
#pragma unroll
    for (int jj = 0; jj < 16; ++jj) vpre[jj] = z[(size_t)(t0 + p4 * 16 + jj) * ZLD + vcol];
  }
  constexpr int NPq = 256 / DK, TPPq = 64 / NPq;
  bf16 qpre[TPPq], kpre[TPPq];
  {
    const int d = tid % DK, part = tid / DK;
#pragma unroll
    for (int jj = 0; jj < TPPq; ++jj) {
      const size_t t = (size_t)(t0 + part * TPPq + jj);
      qpre[jj] = z[t * ZLD + (ISA ? ZA_Q + h * 64 : ZB_Q + h * 32) + d];
      kpre[jj] = ISA ? (bf16)0 : z[t * ZLD + ZB_K + h * 32 + d];
    }
  }
  constexpr int CPR0 = DK / 8, NST = (64 * CPR0) / 256;
  u32x4 stpre[NST];
#pragma unroll
  for (int k = 0; k < NST; ++k) { const int id = tid + 256 * k; stpre[k] = *(const u32x4*)(ST + ((size_t)ci * 64 + id / CPR0) * DK + (id % CPR0) * 8); }
  {
    const float* bcg = (const float*)((const unsigned char*)p.out + BC_OFF + (ISA ? 0 : BC_B_OFF)) + (size_t)ci * 64 * DK;
#pragma unroll
    for (int k = 0; k < (64 * DK) / 1024; ++k) *(f32x4*)(bcl + (tid + 256 * k) * 4) = *(const f32x4*)(bcg + (tid + 256 * k) * 4);
    __syncthreads();
  }
  constexpr int NP = 256 / DK, TPP = 64 / NP;
  {
    const int d = tid % DK, part = tid / DK;
    const float lbv = gla_lb<DK, ISA>(p, l, h, d);
    const float bref = bcl[31 * DK + d];
#pragma unroll
    for (int jj = 0; jj < TPP; ++jj) {
      const int j = part * TPP + jj;
      const float kv = ISA ? gla_kval<DK, ISA>(z, t0 + j, h, d, lbv) : bf2f(kpre[jj]);
      const float qv = ISA ? siluf_(bf2f(qpre[jj])) * 0.125f : bf2f(qpre[jj]) * 0.17677669529663687f;
      const float bc = bcl[j * DK + d];
      const float dq = fminf(fmaxf(bc - bref, -80.f), 80.f);
      ((bf16*)qh)[j * (DK + 8) + d] = f2bf(qv * __expf(dq));
      ((bf16*)kt)[j * (DK + 8) + d] = f2bf(kv * __expf(-dq));
      ((bf16*)qc)[j * (DK + 8) + d] = f2bf(qv * __expf(bc));
    }
    const int e = tid & 63, p4 = tid >> 6;
#pragma unroll
    for (int jj = 0; jj < 16; ++jj) { const int j = p4 * 16 + jj; ((bf16*)vT)[e * 72 + j] = vpre[jj]; }
#pragma unroll
    for (int k = 0; k < NST; ++k) { const int id = tid + 256 * k; *(u32x4*)(stl + (id / CPR0) * LDK + (id % CPR0) * 16) = stpre[k]; }
  }
  __syncthreads();
  const int lane = tid & 63, wv = tid >> 6, wm = wv & 1, wn = wv >> 1, r = lane & 31, hh = lane >> 5;
  {
    f32x16 acc = mm32(qh + wm * 32 * LDK, LDK, kt + wn * 32 * LDK, LDK, DK / 16, zero16(), r, hh);
    const int jc = wn * 32 + r;
#pragma unroll
    for (int g = 0; g < 4; ++g)
#pragma unroll
      for (int k = 0; k < 4; ++k) {
        const int i = wm * 32 + 8 * g + 4 * hh + k;
        const float v = (jc <= i) ? acc[4 * g + k] : 0.f;
        ((bf16*)attn)[i * 72 + jc] = f2bf(v);
      }
  }
  __syncthreads();
  {
    f32x16 acc = mm32(attn + wm * 32 * 144, 144, vT + wn * 32 * 144, 144, 4, zero16(), r, hh);
    acc = mm32(qc + wm * 32 * LDK, LDK, stl + wn * 32 * LDK, LDK, DK / 16, acc, r, hh);
    const int e = wn * 32 + r;
#pragma unroll
    for (int g = 0; g < 4; ++g)
#pragma unroll
      for (int k = 0; k < 4; ++k) obuf[(wm * 32 + 8 * g + 4 * hh + k) * 68 + e] = acc[4 * g + k];
  }
  __syncthreads();
  norm_gate_store<ISA>(obuf, false, gq0, gq0, (ISA ? p.hgrn_ng : p.gla_ng) + l * 64, gq0, gq1, mix + (size_t)t0 * 1024 + (ISA ? 0 : 256) + h * 64, tid);
  __syncthreads();
}

DI void gdn_local_item(const Params& p, int l, int ci, unsigned char* lds, int tid) {
  const bf16* z = (const bf16*)(p.ws + OFF_AR + AR_Z);
  float* Ac = (float*)(p.ws + OFF_AR + AR_ACD) + (size_t)ci * 4096;
  bf16* BT = (bf16*)(p.ws + OFF_AR + AR_BTD) + (size_t)ci * 4096;
  bf16* Qeff = (bf16*)(p.ws + OFF_AR + AR_QEFF) + (size_t)ci * 4096;
  bf16* Oloc = (bf16*)(p.ws + OFF_AR + AR_OLOC) + (size_t)ci * 4096;
  const int h = ci & 3, t0 = (ci >> 2) * 64, s0 = t0 & (S_ - 1);
  float* Mf = (float*)lds;
  bf16* WT = (bf16*)lds;
  bf16* UT = (bf16*)(lds + 9216);
  float* X = (float*)(lds + 16384);
  bf16* qn = (bf16*)(lds + 16384);
  bf16* kn = qn + 64 * 72;
  bf16* vb = kn + 64 * 72;
  bf16* kbm = (bf16*)(lds + 49152);
  bf16* aqk = kbm;
  bf16* KtT = kbm + 64 * 72;
  float* sm = (float*)(lds + 49152 + 2 * 9216);
  float* betas = sm; float* bcum = sm + 64;
  const int lane = tid & 63, wv = tid >> 6;
  if (wv == 0) {
    const int t = t0 + lane;
    const float be = sigmoidf_(bf2f(z[(size_t)t * ZLD + ZD_BETA + h]));
    float lg = -__expf(p.gdn_alog[l * 4 + h]) * softplusf_(bf2f(z[(size_t)t * ZLD + ZD_A + h]) + p.gdn_dtb[l * 4 + h]);
#pragma unroll
    for (int o = 1; o < 64; o <<= 1) { const float n = __shfl_up(lg, o); if (lane >= o) lg += n; }
    betas[lane] = be; bcum[lane] = lg;
  }
  __syncthreads();
  {
    const int d = lane, j0 = wv * 16;
    const float* cw = p.gdn_conv + (size_t)l * 4 * 768;
    float qv[16], kv[16];
#pragma unroll
    for (int which = 0; which < 3; ++which) {
      const int cc = which * 256 + h * 64 + d;
      const int zc = (which == 0 ? ZD_Q : (which == 1 ? ZD_K : ZD_V)) + h * 64 + d;
      const float c0 = cw[cc], c1 = cw[768 + cc], c2 = cw[2 * 768 + cc], c3 = cw[3 * 768 + cc];
      float x0 = 0.f, x1 = 0.f, x2 = 0.f;
      if (s0 + j0 >= 3) { x0 = bf2f(z[(size_t)(t0 + j0 - 3) * ZLD + zc]); x1 = bf2f(z[(size_t)(t0 + j0 - 2) * ZLD + zc]); x2 = bf2f(z[(size_t)(t0 + j0 - 1) * ZLD + zc]); }
#pragma unroll
      for (int jj = 0; jj < 16; ++jj) {
        const float x3 = bf2f(z[(size_t)(t0 + j0 + jj) * ZLD + zc]);
        const float o = siluf_(c0 * x0 + c1 * x1 + c2 * x2 + c3 * x3);
        x0 = x1; x1 = x2; x2 = x3;
        if (which == 0) qv[jj] = o; else if (which == 1) kv[jj] = o; else vb[(j0 + jj) * 72 + d] = f2bf(o);
      }
    }
    const float bl = bcum[63];
#pragma unroll
    for (int jj = 0; jj < 16; ++jj) {
      const int j = j0 + jj;
      const float rq = rsqrtf(wave_sum(qv[jj] * qv[jj]) + EPS) * 0.125f;
      const float rk = rsqrtf(wave_sum(kv[jj] * kv[jj]) + EPS);
      const float qq = qv[jj] * rq, kk = kv[jj] * rk;
      qn[j * 72 + d] = f2bf(qq); kn[j * 72 + d] = f2bf(kk); kbm[j * 72 + d] = f2bf(kk * betas[j]);
      Qeff[j * 64 + d] = f2bf(qq * __expf(bcum[j]));
      KtT[d * 72 + j] = f2bf(kk * __expf(bl - bcum[j]));
    }
  }
  __syncthreads();
  const int wm = wv & 1, wn = wv >> 1, r = lane & 31, hh = lane >> 5;
  {
    f32x16 acc = mm32((const unsigned char*)(kbm + wm * 32 * 72), 144, (const unsigned char*)(kn + wn * 32 * 72), 144, 4, zero16(), r, hh);
    f32x16 acc2 = mm32((const unsigned char*)(qn + wm * 32 * 72), 144, (const unsigned char*)(kn + wn * 32 * 72), 144, 4, zero16(), r, hh);
    const int jc = wn * 32 + r; const float bj = bcum[jc];
    __syncthreads();
#pragma unroll
    for (int g = 0; g < 4; ++g)
#pragma unroll
      for (int k = 0; k < 4; ++k) {
        const int i = wm * 32 + 8 * g + 4 * hh + k;
        const float dec = (jc <= i) ? __expf(bcum[i] - bj) : 0.f;
        Mf[i * 64 + jc] = (jc < i) ? acc[4 * g + k] * dec : 0.f;
        aqk[i * 72 + jc] = f2bf(acc2[4 * g + k] * dec);
      }
  }
  __syncthreads();
  {
    const int c = tid & 127, j0 = (tid >> 7) * 32;
    const bf16* srcp = (c < 64) ? vb : kn;
    float xr[32];
#pragma unroll
    for (int j = 0; j < 32; ++j) { const float f = (c < 64) ? betas[j0 + j] : betas[j0 + j] * __expf(bcum[j0 + j]); xr[j] = bf2f(srcp[(j0 + j) * 72 + (c & 63)]) * f; }
    __syncthreads();
#pragma unroll
    for (int j = 0; j < 32; ++j) X[(j0 + j) * 128 + c] = xr[j];
  }
  __syncthreads();
  {
    const int g4 = lane >> 4, c16 = lane & 15;
#pragma unroll
    for (int I = 0; I < 4; ++I) {
      if (I > 0) {
        f32x4 acc0 = (f32x4){0.f, 0.f, 0.f, 0.f}, acc1 = acc0;
#pragma unroll
        for (int J = 0; J < I; ++J) {
#pragma unroll
          for (int kk = 0; kk < 4; ++kk) {
            const float av = Mf[(16 * I + c16) * 64 + 16 * J + 4 * kk + g4];
            const float b0 = X[(16 * J + 4 * kk + g4) * 128 + (2 * wv) * 16 + c16];
            const float b1 = X[(16 * J + 4 * kk + g4) * 128 + (2 * wv + 1) * 16 + c16];
            acc0 = __builtin_amdgcn_mfma_f32_16x16x4f32(av, b0, acc0, 0, 0, 0);
            acc1 = __builtin_amdgcn_mfma_f32_16x16x4f32(av, b1, acc1, 0, 0, 0);
          }
        }
#pragma unroll
        for (int r4 = 0; r4 < 4; ++r4) {
          X[(16 * I + 4 * g4 + r4) * 128 + (2 * wv) * 16 + c16] -= acc0[r4];
          X[(16 * I + 4 * g4 + r4) * 128 + (2 * wv + 1) * 16 + c16] -= acc1[r4];
        }
        __syncthreads();
      }
      if (tid < 128) {
        float x[16];
#pragma unroll
        for (int r4 = 0; r4 < 16; ++r4) x[r4] = X[(16 * I + r4) * 128 + tid];
#pragma unroll
        for (int r4 = 1; r4 < 16; ++r4) {
          const float* mr = Mf + (16 * I + r4) * 64 + 16 * I;
          float a0 = x[r4];
#pragma unroll
          for (int qb = 0; qb < (r4 + 3) / 4; ++qb) {
            const f32x4 m4 = *(const f32x4*)(mr + 4 * qb);
#pragma unroll
            for (int qq = 0; qq < 4; ++qq) if (4 * qb + qq < r4) a0 -= m4[qq] * x[4 * qb + qq];
          }
          x[r4] = a0;
        }
#pragma unroll
        for (int r4 = 0; r4 < 16; ++r4) X[(16 * I + r4) * 128 + tid] = x[r4];
      }
      __syncthreads();
    }
  }
  {
    float xr[64];
    const int c = tid & 127;
    if (tid < 128) {
#pragma unroll
      for (int j = 0; j < 64; ++j) xr[j] = X[j * 128 + c];
    }
    __syncthreads();
    if (tid < 128) {
      bf16* dst = (tid < 64 ? UT : WT) + (tid & 63) * 72;
#pragma unroll
      for (int j = 0; j < 64; j += 8) {
        u32x4 w; w.x = pk_bf16(xr[j], xr[j + 1]); w.y = pk_bf16(xr[j + 2], xr[j + 3]); w.z = pk_bf16(xr[j + 4], xr[j + 5]); w.w = pk_bf16(xr[j + 6], xr[j + 7]);
        *(u32x4*)(dst + j) = w;
      }
    }
  }
  __syncthreads();
  {
    const float bl = bcum[63];
    f32x16 a1 = mm32((const unsigned char*)(WT + wm * 32 * 72), 144, (const unsigned char*)(aqk + wn * 32 * 72), 144, 4, zero16(), r, hh);
    f32x16 a2 = mm32((const unsigned char*)(UT + wm * 32 * 72), 144, (const unsigned char*)(aqk + wn * 32 * 72), 144, 4, zero16(), r, hh);
    f32x16 a3 = mm32((const unsigned char*)(WT + wm * 32 * 72), 144, (const unsigned char*)(KtT + wn * 32 * 72), 144, 4, zero16(), r, hh);
    f32x16 a4 = mm32((const unsigned char*)(KtT + wm * 32 * 72), 144, (const unsigned char*)(UT + wn * 32 * 72), 144, 4, zero16(), r, hh);
    const int cidx = wn * 32 + r;
    const float ebl = __expf(bl);
#pragma unroll
    for (int g = 0; g < 4; ++g) {
      const int rb = wm * 32 + 8 * g + 4 * hh;
      const u32x2 qraw = *(const u32x2*)(Qeff + cidx * 64 + rb);
      u32x2 w;
      w.x = pk_bf16(bflo(qraw.x) - a1[4 * g], bfhi(qraw.x) - a1[4 * g + 1]);
      w.y = pk_bf16(bflo(qraw.y) - a1[4 * g + 2], bfhi(qraw.y) - a1[4 * g + 3]);
      *(u32x2*)(Qeff + cidx * 64 + rb) = w;
      w.x = pk_bf16(a2[4 * g], a2[4 * g + 1]); w.y = pk_bf16(a2[4 * g + 2], a2[4 * g + 3]);
      *(u32x2*)(Oloc + cidx * 64 + rb) = w;
      f32x4 av;
#pragma unroll
      for (int k = 0; k < 4; ++k) av[k] = ((rb + k) == cidx ? ebl : 0.f) - a3[4 * g + k];
      *(f32x4*)(Ac + cidx * 64 + rb) = av;
      w.x = pk_bf16(a4[4 * g], a4[4 * g + 1]); w.y = pk_bf16(a4[4 * g + 2], a4[4 * g + 3]);
      *(u32x2*)(BT + cidx * 64 + rb) = w;
    }
  }
  __syncthreads();
}

DI void gdn_scan_item(const Params& p, int b, int h, int es, unsigned char* lds, int tid) {
  const float* AcB = (const float*)(p.ws + OFF_AR + AR_ACD);
  bf16* BTB = (bf16*)(p.ws + OFF_AR + AR_BTD);
  const int lane = tid & 63, w = tid >> 6, g = lane >> 4, c16 = lane & 15;
  float* stl = (float*)lds;
  for (int i = tid; i < 2 * 16 * 68; i += 256) stl[i] = 0.f;
  __syncthreads();
  f32x4 cur = (f32x4){0.f, 0.f, 0.f, 0.f};
  f32x4 bq[4][4]; bf16 bt[4][4];
  const size_t ci0 = ((size_t)(b * 128) * 4 + h);
  const float* apb = AcB + ci0 * 4096 + (16 * w + c16) * 64 + 16 * g;
  bf16* btb = BTB + ci0 * 4096 + (es * 16 + 4 * g) * 64 + 16 * w + c16;
#pragma unroll
  for (int s4 = 0; s4 < 4; ++s4) {
#pragma unroll
    for (int k = 0; k < 4; ++k) bq[s4][k] = *(const f32x4*)(apb + (size_t)s4 * 4 * 4096 + 4 * k);
#pragma unroll
    for (int k = 0; k < 4; ++k) bt[s4][k] = btb[(size_t)s4 * 4 * 4096 + k * 64];
  }
  for (int c0 = 0; c0 < 128; c0 += 4) {
    const bool pf = (c0 + 4 < 128);
#pragma unroll
    for (int s4 = 0; s4 < 4; ++s4) {
      const int c = c0 + s4;
      const size_t co = (size_t)c * 4 * 4096;
#pragma unroll
      for (int k = 0; k < 4; ++k) btb[co + k * 64] = f2bf(cur[k]);
      const float* sc = stl + (s4 & 1) * 16 * 68;
      f32x4 aq[4];
#pragma unroll
      for (int k = 0; k < 4; ++k) aq[k] = *(const f32x4*)(sc + c16 * 68 + 16 * g + 4 * k);
      f32x4 acc[4];
      acc[0] = (f32x4){bf2f(bt[s4][0]), bf2f(bt[s4][1]), bf2f(bt[s4][2]), bf2f(bt[s4][3])};
      acc[1] = (f32x4){0.f, 0.f, 0.f, 0.f}; acc[2] = acc[1]; acc[3] = acc[1];
#pragma unroll
      for (int q = 0; q < 4; ++q)
#pragma unroll
        for (int k = 0; k < 4; ++k) acc[k] = __builtin_amdgcn_mfma_f32_16x16x4f32(aq[k][q], bq[s4][k][q], acc[k], 0, 0, 0);
      cur = (acc[0] + acc[1]) + (acc[2] + acc[3]);
      if (pf) {
#pragma unroll
        for (int k = 0; k < 4; ++k) bq[s4][k] = *(const f32x4*)(apb + co + (size_t)4 * 4 * 4096 + 4 * k);
#pragma unroll
        for (int k = 0; k < 4; ++k) bt[s4][k] = btb[co + (size_t)4 * 4 * 4096 + k * 64];
      }
      float* sn = stl + ((s4 + 1) & 1) * 16 * 68;
#pragma unroll
      for (int k = 0; k < 4; ++k) sn[(4 * g + k) * 68 + 16 * w + c16] = cur[k];
      __syncthreads();
    }
  }
}

DI void gdn_out_item(const Params& p, int l, int ci, unsigned char* lds, int tid) {
  const bf16* z = (const bf16*)(p.ws + OFF_AR + AR_Z);
  const bf16* ST = (const bf16*)(p.ws + OFF_AR + AR_BTD) + (size_t)ci * 4096;
  const bf16* Qeff = (const bf16*)(p.ws + OFF_AR + AR_QEFF) + (size_t)ci * 4096;
  const bf16* Oloc = (const bf16*)(p.ws + OFF_AR + AR_OLOC) + (size_t)ci * 4096;
  bf16* mix = (bf16*)(p.ws + OFF_AR + AR_MIX);
  const int h = ci & 3, t0 = (ci >> 2) * 64;
  float* obuf = (float*)lds;
  unsigned char* ql = lds + 17408;
  unsigned char* sl = ql + 9216;
  const u32x4* gpre = (const u32x4*)(z + (size_t)(t0 + (tid >> 2)) * ZLD + ZD_Z + h * 64 + (tid & 3) * 16);
  const u32x4 gq0 = gpre[0], gq1 = gpre[1];
  const u32x4* apre = (const u32x4*)(Oloc + (tid >> 2) * 64 + (tid & 3) * 16);
  const u32x4 aq0 = apre[0], aq1 = apre[1];
#pragma unroll
  for (int id = tid; id < 512; id += 256) {
    const int rr = id >> 3, ch = id & 7;
    *(u32x4*)(ql + rr * 144 + ch * 16) = *(const u32x4*)(Qeff + rr * 64 + ch * 8);
    *(u32x4*)(sl + rr * 144 + ch * 16) = *(const u32x4*)(ST + rr * 64 + ch * 8);
  }
  __syncthreads();
  const int lane = tid & 63, wv = tid >> 6, wm = wv & 1, wn = wv >> 1, r = lane & 31, hh = lane >> 5;
  {
    f32x16 acc = mm32(ql + wm * 32 * 144, 144, sl + wn * 32 * 144, 144, 4, zero16(), r, hh);
    const int e = wn * 32 + r;
#pragma unroll
    for (int g = 0; g < 4; ++g)
#pragma unroll
      for (int k = 0; k < 4; ++k) obuf[(wm * 32 + 8 * g + 4 * hh + k) * 68 + e] = acc[4 * g + k];
  }
  __syncthreads();
  norm_gate_store<false>(obuf, true, aq0, aq1, p.gdn_ng + l * 64, gq0, gq1, mix + (size_t)t0 * 1024 + 768 + h * 64, tid);
  __syncthreads();
}

DI void mla_proj_item(const Params& p, int l, int tile, unsigned char* lds, int tid) {
  const bf16* z = (const bf16*)(p.ws + OFF_AR + AR_Z);
  const bf16* Wl = (const bf16*)(p.ws + OFF_W) + (size_t)l * WL_E;
  const bf16* Wuq = Wl + WO_UQ;
  const bf16* Wukv = Wl + WO_UKV;
  bf16* Qg = (bf16*)(p.ws + OFF_AR + AR_Q);
  bf16* Kg = (bf16*)(p.ws + OFF_AR + AR_K);
  bf16* Vt = (bf16*)(p.ws + OFF_AR + AR_VT);
  const int t0 = tile * 64, b = t0 / S_, s0 = t0 % S_;
  unsigned char* Aq = lds;
  unsigned char* Akv = lds + 33792;
  float* rsq = (float*)(lds + 33792 + 17408);
  float* rskv = rsq + 64;
#pragma unroll
  for (int id = tid; id < 64 * 32; id += 256) { const int rr = id >> 5, ch = id & 31; *(u32x4*)(Aq + rr * 528 + ch * 16) = *(const u32x4*)(z + (size_t)(t0 + rr) * ZLD + ZC_Q + ch * 8); }
#pragma unroll
  for (int id = tid; id < 64 * 16; id += 256) { const int rr = id >> 4, ch = id & 15; *(u32x4*)(Akv + rr * 272 + ch * 16) = *(const u32x4*)(z + (size_t)(t0 + rr) * ZLD + ZC_KV + ch * 8); }
  __syncthreads();
  {
    const int rr = tid >> 2, qd = tid & 3;
    float s1 = 0.f, s2 = 0.f;
#pragma unroll
    for (int k = 0; k < 8; ++k) { const u32x4 u = *(const u32x4*)(Aq + rr * 528 + qd * 128 + k * 16);
#pragma unroll
      for (int i = 0; i < 4; ++i) { const float a = bflo(u[i]), b = bfhi(u[i]); s1 += a * a + b * b; } }
#pragma unroll
    for (int k = 0; k < 4; ++k) { const u32x4 u = *(const u32x4*)(Akv + rr * 272 + qd * 64 + k * 16);
#pragma unroll
      for (int i = 0; i < 4; ++i) { const float a = bflo(u[i]), b = bfhi(u[i]); s2 += a * a + b * b; } }
    s1 += __shfl_xor(s1, 1); s1 += __shfl_xor(s1, 2); s2 += __shfl_xor(s2, 1); s2 += __shfl_xor(s2, 2);
    if (qd == 0) { rsq[rr] = rsqrtf(s1 * (1.f / 256.f) + EPS); rskv[rr] = rsqrtf(s2 * (1.f / 128.f) + EPS); }
#pragma unroll
    for (int id = tid; id < 1024; id += 256) {
      const int m = id >> 4, i = id & 15;
      const float inv = __builtin_amdgcn_exp2f(-(float)i * (13.287712379549449f / 16.f));
      const float ang = (float)(s0 + m) * inv;
      const double rev = (double)ang * 0.15915494309189535;
      const float fr = (float)(rev - floor(rev));
      const float sn = __builtin_amdgcn_sinf(fr), cs = __builtin_amdgcn_cosf(fr);
      const float x1 = bf2f(z[(size_t)(t0 + m) * ZLD + ZC_KR + i]), x2 = bf2f(z[(size_t)(t0 + m) * ZLD + ZC_KR + 16 + i]);
      const bf16 o1 = f2bf(x1 * cs - x2 * sn), o2 = f2bf(x2 * cs + x1 * sn);
#pragma unroll
      for (int hd = 0; hd < 4; ++hd) { bf16* kp = Kg + ((size_t)(b * 4 + hd) * S_ + s0 + m) * 96; kp[64 + i] = o1; kp[80 + i] = o2; }
    }
  }
  __syncthreads();
  const int lane = tid & 63, hd = tid >> 6, r = lane & 31, hh = lane >> 5;
  const float QS = 0.10206207261596575f * 1.4426950408889634f;
  {
    f32x16 acc[3][2];
#pragma unroll
    for (int i = 0; i < 3; ++i) { acc[i][0] = zero16(); acc[i][1] = zero16(); }
#pragma unroll 4
    for (int kk = 0; kk < 16; ++kk) {
      bf16x8 af[2], bw[3];
#pragma unroll
      for (int mi = 0; mi < 2; ++mi) af[mi] = *(const bf16x8*)(Aq + (mi * 32 + r) * 528 + kk * 32 + hh * 16);
#pragma unroll
      for (int ni = 0; ni < 3; ++ni) bw[ni] = *(const bf16x8*)(Wuq + ((size_t)(((hd * 16 + kk) * 3 + ni) * 64 + lane)) * 8);
#pragma unroll
      for (int ni = 0; ni < 3; ++ni)
#pragma unroll
        for (int mi = 0; mi < 2; ++mi) acc[ni][mi] = MFMA32(bw[ni], af[mi], acc[ni][mi]);
    }
#pragma unroll
    for (int mi = 0; mi < 2; ++mi) {
      const int m = mi * 32 + r;
      const float sc = rsq[m] * QS;
      bf16* qp = Qg + ((size_t)(b * 4 + hd) * S_ + s0 + m) * 96;
#pragma unroll
      for (int ni = 0; ni < 2; ++ni)
#pragma unroll
        for (int g = 0; g < 4; ++g) {
          u32x2 w; w.x = pk_bf16(acc[ni][mi][4 * g] * sc, acc[ni][mi][4 * g + 1] * sc); w.y = pk_bf16(acc[ni][mi][4 * g + 2] * sc, acc[ni][mi][4 * g + 3] * sc);
          *(u32x2*)(qp + ni * 32 + 8 * g + 4 * hh) = w;
        }
#pragma unroll
      for (int g = 0; g < 2; ++g) {
        float o1[4], o2[4];
#pragma unroll
        for (int k = 0; k < 4; ++k) {
          const int i = 8 * g + 4 * hh + k;
          const float inv = __builtin_amdgcn_exp2f(-(float)i * (13.287712379549449f / 16.f));
          const float ang = (float)(s0 + m) * inv;
          const double rev = (double)ang * 0.15915494309189535;
          const float fr = (float)(rev - floor(rev));
          const float sn = __builtin_amdgcn_sinf(fr), cs = __builtin_amdgcn_cosf(fr);
          const float x1 = acc[2][mi][4 * g + k] * sc, x2 = acc[2][mi][4 * (g + 2) + k] * sc;
          o1[k] = x1 * cs - x2 * sn; o2[k] = x2 * cs + x1 * sn;
        }
        u32x2 w; w.x = pk_bf16(o1[0], o1[1]); w.y = pk_bf16(o1[2], o1[3]);
        *(u32x2*)(qp + 64 + 8 * g + 4 * hh) = w;
        w.x = pk_bf16(o2[0], o2[1]); w.y = pk_bf16(o2[2], o2[3]);
        *(u32x2*)(qp + 80 + 8 * g + 4 * hh) = w;
      }
    }
  }
  {
    f32x16 acc[2][2];
#pragma unroll
    for (int i = 0; i < 2; ++i) { acc[i][0] = zero16(); acc[i][1] = zero16(); }
#pragma unroll
    for (int kk = 0; kk < 8; ++kk) {
      bf16x8 af[2], bw[2];
#pragma unroll
      for (int mi = 0; mi < 2; ++mi) af[mi] = *(const bf16x8*)(Akv + (mi * 32 + r) * 272 + kk * 32 + hh * 16);
#pragma unroll
      for (int ni = 0; ni < 2; ++ni) bw[ni] = *(const bf16x8*)(Wukv + ((size_t)((((hd * 2 + 0) * 8 + kk) * 2 + ni) * 64 + lane)) * 8);
#pragma unroll
      for (int ni = 0; ni < 2; ++ni)
#pragma unroll
        for (int mi = 0; mi < 2; ++mi) acc[ni][mi] = MFMA32(bw[ni], af[mi], acc[ni][mi]);
    }
#pragma unroll
    for (int mi = 0; mi < 2; ++mi) {
      const int m = mi * 32 + r;
      const float sc = rskv[m];
      bf16* kp = Kg + ((size_t)(b * 4 + hd) * S_ + s0 + m) * 96;
#pragma unroll
      for (int ni = 0; ni < 2; ++ni)
#pragma unroll
        for (int g = 0; g < 4; ++g) {
          u32x2 w; w.x = pk_bf16(acc[ni][mi][4 * g] * sc, acc[ni][mi][4 * g + 1] * sc); w.y = pk_bf16(acc[ni][mi][4 * g + 2] * sc, acc[ni][mi][4 * g + 3] * sc);
          *(u32x2*)(kp + ni * 32 + 8 * g + 4 * hh) = w;
        }
    }
  }
  {
    f32x16 acc[2][2];
#pragma unroll
    for (int i = 0; i < 2; ++i) { acc[i][0] = zero16(); acc[i][1] = zero16(); }
#pragma unroll
    for (int kk = 0; kk < 8; ++kk) {
      bf16x8 af[2], bw[2];
#pragma unroll
      for (int mi = 0; mi < 2; ++mi) af[mi] = *(const bf16x8*)(Akv + (mi * 32 + r) * 272 + kk * 32 + hh * 16);
#pragma unroll
      for (int ni = 0; ni < 2; ++ni) bw[ni] = *(const bf16x8*)(Wukv + ((size_t)((((hd * 2 + 1) * 8 + kk) * 2 + ni) * 64 + lane)) * 8);
#pragma unroll
      for (int mi = 0; mi < 2; ++mi)
#pragma unroll
        for (int ni = 0; ni < 2; ++ni) acc[mi][ni] = MFMA32(af[mi], bw[ni], acc[mi][ni]);
    }
#pragma unroll
    for (int ni = 0; ni < 2; ++ni) {
      bf16* vp = Vt + ((size_t)(b * 4 + hd) * 64 + ni * 32 + r) * S_ + s0;
#pragma unroll
      for (int mi = 0; mi < 2; ++mi)
#pragma unroll
        for (int g = 0; g < 4; ++g) {
          const int m = mi * 32 + 8 * g + 4 * hh;
          u32x2 w; w.x = pk_bf16(acc[mi][ni][4 * g] * rskv[m], acc[mi][ni][4 * g + 1] * rskv[m + 1]); w.y = pk_bf16(acc[mi][ni][4 * g + 2] * rskv[m + 2], acc[mi][ni][4 * g + 3] * rskv[m + 3]);
          *(u32x2*)(vp + m) = w;
        }
    }
  }
  __syncthreads();
}

DI void attn_item(const Params& p, int bh, int qb, unsigned char* lds, int tid) {
  const bf16* Qg = (const bf16*)(p.ws + OFF_AR + AR_Q) + (size_t)bh * S_ * 96;
  const bf16* Kg = (const bf16*)(p.ws + OFF_AR + AR_K) + (size_t)bh * S_ * 96;
  const bf16* Vt = (const bf16*)(p.ws + OFF_AR + AR_VT) + (size_t)bh * 64 * S_;
  bf16* mix = (bf16*)(p.ws + OFF_AR + AR_MIX);
  const int lane = tid & 63, w = tid >> 6, r = lane & 31, hh = lane >> 5;
  const int q0 = qb * 128, qrow = q0 + 32 * w + r;
  const int ntiles = 2 * qb + 2;
  constexpr int STG = 64 * 208 + 64 * 144;
  bf16x8 qf[6];
#pragma unroll
  for (int kk = 0; kk < 6; ++kk) qf[kk] = *(const bf16x8*)(Qg + (size_t)qrow * 96 + kk * 16 + hh * 8);
  f32x16 ot[2] = {zero16(), zero16()};
  float mrun = -1e30f, lrun = 0.f;
  u32x4 rk[3], rv[2];
  int krow[3], kch[3];
#pragma unroll
  for (int i = 0; i < 3; ++i) { const int id = tid + 256 * i; krow[i] = id / 12; kch[i] = id % 12; }
  const int vrow0 = tid >> 3, vch = tid & 7;
#pragma unroll
  for (int i = 0; i < 3; ++i) rk[i] = *(const u32x4*)(Kg + (size_t)krow[i] * 96 + kch[i] * 8);
#pragma unroll
  for (int i = 0; i < 2; ++i) rv[i] = *(const u32x4*)(Vt + (size_t)(vrow0 + 32 * i) * S_ + vch * 8);
  __syncthreads();
#pragma unroll
  for (int i = 0; i < 3; ++i) *(u32x4*)(lds + krow[i] * 208 + kch[i] * 16) = rk[i];
#pragma unroll
  for (int i = 0; i < 2; ++i) *(u32x4*)(lds + 13312 + (vrow0 + 32 * i) * 144 + vch * 16) = rv[i];
  __syncthreads();
  for (int kt = 0; kt < ntiles; ++kt) {
    const unsigned char* Ks = lds + (kt & 1) * STG;
    const unsigned char* Vs = Ks + 13312;
    if (kt + 1 < ntiles) {
#pragma unroll
      for (int i = 0; i < 3; ++i) rk[i] = *(const u32x4*)(Kg + (size_t)((kt + 1) * 64 + krow[i]) * 96 + kch[i] * 8);
#pragma unroll
      for (int i = 0; i < 2; ++i) rv[i] = *(const u32x4*)(Vt + (size_t)(vrow0 + 32 * i) * S_ + (kt + 1) * 64 + vch * 8);
    }
    if (kt * 64 <= q0 + 32 * w + 31) {
      f32x16 st[2];
#pragma unroll
      for (int k2 = 0; k2 < 2; ++k2) {
        st[k2] = zero16();
#pragma unroll
        for (int kk = 0; kk < 6; ++kk) {
          bf16x8 kf = *(const bf16x8*)(Ks + (k2 * 32 + r) * 208 + kk * 32 + hh * 16);
          st[k2] = MFMA32(kf, qf[kk], st[k2]);
        }
      }
      if (kt * 64 + 63 > q0 + 32 * w) {
#pragma unroll
        for (int k2 = 0; k2 < 2; ++k2)
#pragma unroll
          for (int g = 0; g < 4; ++g)
#pragma unroll
            for (int k = 0; k < 4; ++k) {
              const int key = kt * 64 + k2 * 32 + 8 * g + 4 * hh + k;
              if (key > qrow) st[k2][4 * g + k] = -1e30f;
            }
      }
      float mt = st[0][0];
#pragma unroll
      for (int k2 = 0; k2 < 2; ++k2)
#pragma unroll
        for (int i = 0; i < 16; ++i) mt = fmaxf(mt, st[k2][i]);
      mt = fmaxf(mt, __shfl_xor(mt, 32));
      const float mnew = fmaxf(mrun, mt);
      const float alpha = __builtin_amdgcn_exp2f(mrun - mnew);
      mrun = mnew;
      float ls = 0.f;
#pragma unroll
      for (int k2 = 0; k2 < 2; ++k2)
#pragma unroll
        for (int i = 0; i < 16; ++i) { const float pv = __builtin_amdgcn_exp2f(st[k2][i] - mnew); st[k2][i] = pv; ls += pv; }
      lrun = lrun * alpha + ls;
      if (__any(alpha != 1.f)) {
#pragma unroll
        for (int dt = 0; dt < 2; ++dt)
#pragma unroll
          for (int i = 0; i < 16; ++i) ot[dt][i] *= alpha;
      }
#pragma unroll
      for (int k2 = 0; k2 < 2; ++k2)
#pragma unroll
        for (int s = 0; s < 2; ++s) {
          u32x4 pw;
          pw.x = pk_bf16(st[k2][8 * s], st[k2][8 * s + 1]); pw.y = pk_bf16(st[k2][8 * s + 2], st[k2][8 * s + 3]);
          pw.z = pk_bf16(st[k2][8 * s + 4], st[k2][8 * s + 5]); pw.w = pk_bf16(st[k2][8 * s + 6], st[k2][8 * s + 7]);
          const bf16x8 pf = __builtin_bit_cast(bf16x8, pw);
#pragma unroll
          for (int dt = 0; dt < 2; ++dt) {
            const unsigned char* vp = Vs + (dt * 32 + r) * 144 + (k2 * 32 + s * 16 + 4 * hh) * 2;
            u32x2 v0 = *(const u32x2*)vp, v1 = *(const u32x2*)(vp + 16);
            u32x4 vw = (u32x4){v0.x, v0.y, v1.x, v1.y};
            ot[dt] = MFMA32(__builtin_bit_cast(bf16x8, vw), pf, ot[dt]);
          }
        }
    }
    if (kt + 1 < ntiles) {
      unsigned char* Kw = lds + ((kt + 1) & 1) * STG;
#pragma unroll
      for (int i = 0; i < 3; ++i) *(u32x4*)(Kw + krow[i] * 208 + kch[i] * 16) = rk[i];
#pragma unroll
      for (int i = 0; i < 2; ++i) *(u32x4*)(Kw + 13312 + (vrow0 + 32 * i) * 144 + vch * 16) = rv[i];
    }
    __syncthreads();
  }
  const float lt = lrun + __shfl_xor(lrun, 32);
  const float inv = 1.f / lt;
  const int b = bh >> 2, hd = bh & 3;
  bf16* op = mix + ((size_t)b * S_ + qrow) * 1024 + 512 + hd * 64;
#pragma unroll
  for (int dt = 0; dt < 2; ++dt)
#pragma unroll
    for (int g = 0; g < 4; ++g) {
      u32x2 wv; wv.x = pk_bf16(ot[dt][4 * g] * inv, ot[dt][4 * g + 1] * inv); wv.y = pk_bf16(ot[dt][4 * g + 2] * inv, ot[dt][4 * g + 3] * inv);
      *(u32x2*)(op + dt * 32 + 8 * g + 4 * hh) = wv;
    }
}

DI void grid_bar(unsigned* flags, unsigned k) {
  asm volatile("s_waitcnt vmcnt(0) lgkmcnt(0)" ::: "memory");
  __syncthreads();
  if (threadIdx.x == 0) { __threadfence(); __hip_atomic_store(flags + blockIdx.x, k, __ATOMIC_RELAXED, __HIP_MEMORY_SCOPE_AGENT); }
  const unsigned nb = gridDim.x;
  for (;;) {
    int ok = 1;
    for (unsigned i = threadIdx.x; i < nb; i += blockDim.x) ok &= (__hip_atomic_load(flags + i, __ATOMIC_RELAXED, __HIP_MEMORY_SCOPE_AGENT) >= k) ? 1 : 0;
    if (__syncthreads_and(ok)) break;
    __builtin_amdgcn_s_sleep(1);
  }
  if (threadIdx.x == 0) __threadfence();
  __syncthreads();
}
__global__ void __launch_bounds__(512, 2) fwd_megakernel(Params p0) {
  extern __shared__ __attribute__((aligned(16))) unsigned char lds_all[];
  __shared__ int s_item;
  cg::grid_group grid = cg::this_grid();
  unsigned nbar = 0;
  const int nvb = gridDim.x * 2;
#define GBAR() do { nbar += 1; grid_bar((unsigned*)(p0.ws + OFF_CTL) + 256, nbar); } while (0)
#define PH_BEGIN() Params q = p0; { unsigned long long w_ = (unsigned long long)q.ws; asm volatile("" : "+s"(w_)); q.ws = (unsigned char*)w_; } int tid5 = threadIdx.x; asm volatile("" : "+v"(tid5)); const int tid = tid5 & 255, half = tid5 >> 8, vb = blockIdx.x * 2 + half; unsigned char* lds = lds_all + half * LDS_HALF; (void)vb; (void)lds; \
  unsigned char* ws = q.ws; bf16* W = (bf16*)(ws + OFF_W); float* rs = (float*)(ws + OFF_RS); bf16* zb = (bf16*)(ws + OFF_AR + AR_Z); bf16* yb = (bf16*)(ws + OFF_AR + AR_Y); \
  bf16* up = (bf16*)(ws + OFF_AR + AR_UP); bf16* mix = (bf16*)(ws + OFF_AR + AR_MIX); bf16* xb = mix; unsigned* ctl = (unsigned*)(ws + OFF_CTL); \
  const bf16* Wl = W + (size_t)l * WL_E; (void)rs; (void)zb; (void)yb; (void)up; (void)mix; (void)xb; (void)ctl; (void)Wl; (void)tid; (void)tid5;
  { const int l = 0; PH_BEGIN(); phase0(q, lds, tid, half); }
  { const int l = 0; PH_BEGIN(); resid_phase(q.x, nullptr, nullptr, nullptr, nullptr, xb, rs, tid, vb, nvb); }
  if (p0.ws == nullptr) grid.sync();
  GBAR();

  for (int l = 0; l < 2; ++l) {
    { PH_BEGIN(); EpiStore e{zb, zb, 1 << 30, ZLD, rs, nullptr}; gemm_phase<false>(l == 0 ? xb : (const bf16*)q.out, 1024, Wl + WO_IN, 1024, 1024, 128, 13, e, lds_all, tid5); }
    GBAR();
    for (int pi = blockIdx.x; pi < (2048 * 3 + 512) / 2; pi += gridDim.x) {
      PH_BEGIN();
      const int it = 2 * pi + half;
      if (it < 2048) gdn_local_item(q, l, it, lds, tid);
      else if (it < 4096) gla_local_item<64, true>(q, l, it - 2048, lds, tid);
      else if (it < 6144) gla_local_item<32, false>(q, l, it - 4096, lds, tid);
      else mla_proj_item(q, l, it - 6144, lds, tid);
    }
    GBAR();
    for (;;) {
      PH_BEGIN();
      if (tid5 == 0) s_item = (int)atomicAdd(&ctl[l], 1u);
      __syncthreads();
      const int pit = s_item;
      __syncthreads();
      if (pit >= 80 + 512) break;
      if (pit < 32) { const int it = 2 * pit + half; gdn_scan_item(q, it >> 4, (it >> 2) & 3, it & 3, lds, tid); }
      else if (pit < 64) { const int j = 2 * (pit - 32) + half; gla_scan_item<64>((bf16*)(ws + OFF_AR + AR_UTA), (const float*)(ws + OFF_GA), j >> 4, (j >> 2) & 3, j & 3, tid); }
      else if (pit < 80) { const int j = 2 * (pit - 64) + half; gla_scan_item<32>((bf16*)(ws + OFF_AR + AR_UTB), (const float*)(ws + OFF_GB), j >> 3, (j >> 1) & 3, j & 1, tid); }
      else { const int a = pit - 80; attn_item(q, 2 * (a & 7) + half, 63 - (a >> 3), lds, tid); }
    }
    GBAR();
    for (int pi = blockIdx.x; pi < 2048 * 3 / 2; pi += gridDim.x) {
      PH_BEGIN();
      const int it = 2 * pi + half;
      if (it < 2048) gdn_out_item(q, l, it, lds, tid);
      else if (it < 4096) gla_out_item<64, true>(q, l, it - 2048, lds, tid);
      else gla_out_item<32, false>(q, l, it - 4096, lds, tid);
    }
    GBAR();
    { PH_BEGIN(); EpiStore e{yb, yb, 1 << 30, 1024, nullptr, nullptr}; gemm_phase<false>(mix, 1024, Wl + WO_OUT, 1024, 1024, 128, 4, e, lds_all, tid5); }
    GBAR();
    { PH_BEGIN(); resid_phase(l == 0 ? q.x : nullptr, (const bf16*)q.out, yb, q.post_mix_g + l * 1024, nullptr, xb, rs, tid, vb, nvb); }
    GBAR();
    { PH_BEGIN(); EpiStore e{up, up, 1 << 30, FF, rs, q.ffn_conv + (size_t)l * 3 * FF}; gemm_phase<true>(xb, 1024, Wl + WO_GU, 1024, 1024, 136, 22, e, lds_all, tid5); }
    GBAR();
    { PH_BEGIN(); EpiStore e{yb, yb, 1 << 30, 1024, nullptr, nullptr}; gemm_phase<false>(up, FF, Wl + WO_DN, FF, FF, 128, 4, e, lds_all, tid5); }
    GBAR();
    { PH_BEGIN(); resid_phase(nullptr, xb, yb, q.post_ffn_g + l * 1024, l == 1 ? q.out : nullptr, l == 1 ? nullptr : (bf16*)q.out, rs, tid, vb, nvb); }
    GBAR();
  }
}

extern "C" void kernel_launch(void* const* d_in, const int* in_sizes, int n_in, void* d_out, int out_size, void* d_ws, size_t ws_size, hipStream_t stream) {
  static int grid_blocks = 0;
  if (!grid_blocks) {
    int dev = 0, cus = 0, per_cu = 0;
    hipGetDevice(&dev);
    hipDeviceGetAttribute(&cus, hipDeviceAttributeMultiprocessorCount, dev);
    hipFuncSetAttribute((const void*)fwd_megakernel, hipFuncAttributeMaxDynamicSharedMemorySize, LDS_BYTES);
    hipOccupancyMaxActiveBlocksPerMultiprocessor(&per_cu, (const void*)fwd_megakernel, 512, LDS_BYTES);
    if (per_cu < 1) per_cu = 1;
    if (per_cu > 1) per_cu = 1;
    grid_blocks = cus * per_cu;
    if (ws_size < WS_END) fprintf(stderr, "kernel_launch: workspace too small: %zu < %zu\n", ws_size, (size_t)WS_END);
  }
  Params p{};
  const float** pp = (const float**)&p;
  for (int i = 0; i < 24; ++i) pp[i] = (const float*)d_in[i];
  p.out = (float*)d_out; p.ws = (unsigned char*)d_ws;
  hipMemsetAsync((unsigned char*)d_ws + OFF_CTL, 0, 8192, stream);
  void* args[] = {&p};
  hipError_t e = hipLaunchCooperativeKernel((const void*)fwd_megakernel, dim3(grid_blocks), dim3(512), args, LDS_BYTES, stream);
  if (e != hipSuccess) fprintf(stderr, "cooperative launch failed: %s (grid %d)\n", hipGetErrorString(e), grid_blocks);
}
```

```cpp
#include <hip/hip_runtime.h>
#include <hip/hip_cooperative_groups.h>
#include <cstdio>
#include <cstdint>
namespace cg = cooperative_groups;

#define DI __device__ __forceinline__
typedef unsigned short bf16;
typedef __attribute__((ext_vector_type(8))) short bf16x8;
typedef __attribute__((ext_vector_type(4))) short bf16x4;
typedef __attribute__((ext_vector_type(16))) float f32x16;
typedef __attribute__((ext_vector_type(4))) float f32x4;
typedef __attribute__((ext_vector_type(4))) unsigned u32x4;
typedef __attribute__((ext_vector_type(2))) unsigned u32x2;

constexpr int T_ = 32768, S_ = 8192, D_ = 1024, ZLD = 3328, FF = 2816, DIN = 3256;
constexpr float EPS = 1e-6f;
constexpr int ZA_Q = 0, ZA_F = 256, ZA_I = 512, ZA_G = 768, ZB_Q = 1024, ZB_K = 1152, ZB_V = 1280, ZB_G = 1536, ZC_Q = 1792, ZC_KV = 2048,
              ZD_Q = 2176, ZD_K = 2432, ZD_V = 2688, ZD_Z = 2944, ZC_KR = 3200, ZB_CODE = 3232, ZD_BETA = 3248, ZD_A = 3252;
constexpr size_t WIN_E = (size_t)ZLD * 1024, WOUT_E = 1024 * 1024, WGU_E = (size_t)2 * FF * 1024, WDN_E = (size_t)1024 * FF, WUQ_E = 384 * 256, WUKV_E = 512 * 128;
constexpr size_t WO_IN = 0, WO_OUT = WO_IN + WIN_E, WO_GU = WO_OUT + WOUT_E, WO_DN = WO_GU + WGU_E, WO_UQ = WO_DN + WDN_E, WO_UKV = WO_UQ + WUQ_E, WL_E = WO_UKV + WUKV_E;
constexpr size_t OFF_W = 0;
constexpr size_t OFF_CTL = OFF_W + 2 * WL_E * 2;
constexpr size_t OFF_RS = OFF_CTL + 8192;
constexpr size_t OFF_GA = OFF_RS + (size_t)T_ * 4;
constexpr size_t OFF_GB = OFF_GA + (size_t)2048 * 64 * 4;
constexpr size_t OFF_AR = OFF_GB + (size_t)2048 * 32 * 4;
constexpr size_t AR_Z = 0, AR_Y = 0, AR_GATE = 0, AR_UP = (size_t)T_ * FF * 2;
constexpr size_t AR_SCAN = (size_t)T_ * ZLD * 2;
constexpr size_t AR_UTA = AR_SCAN, AR_UTB = AR_UTA + (size_t)2048 * 64 * 64 * 2, AR_ACD = AR_UTB + (size_t)2048 * 64 * 32 * 2, AR_BTD = AR_ACD + (size_t)2048 * 4096 * 4,
                 AR_QEFF = AR_BTD + (size_t)2048 * 4096 * 2, AR_OLOC = AR_QEFF + (size_t)2048 * 4096 * 2, AR_MLA = AR_OLOC + (size_t)2048 * 4096 * 2;
constexpr size_t AR_Q = AR_MLA, AR_K = AR_Q + (size_t)T_ * 4 * 96 * 2, AR_VT = AR_K + (size_t)T_ * 4 * 96 * 2, AR_MIX = AR_VT + (size_t)T_ * 4 * 64 * 2;
constexpr size_t AR_END = AR_MIX + (size_t)T_ * 1024 * 2;
constexpr size_t WS_END = OFF_AR + AR_END;
static_assert(WS_END <= (size_t)512 * 1024 * 1024, "workspace too large");
static_assert(AR_UP + (size_t)T_ * FF * 2 <= AR_MIX, "gate/up overlaps xb");

constexpr size_t BC_OFF = (size_t)T_ * 1024 * 2, BC_B_OFF = (size_t)2048 * 64 * 64 * 4;
static_assert(BC_OFF + BC_B_OFF + (size_t)2048 * 64 * 32 * 4 <= (size_t)T_ * 1024 * 4, "decay tables exceed the output buffer");
constexpr int LDS_HALF = 73728, LDS_BYTES = 2 * LDS_HALF;
#ifndef PROBE_DUP
#define PROBE_DUP 0
#endif

struct Params {
  const float* x; const float* w_in; const float* w_out; const float* pre_mix_g; const float* post_mix_g; const float* pre_ffn_g; const float* post_ffn_g;
  const float* hgrn_lb; const float* hgrn_ng; const float* gla_w2; const float* gla_b; const float* gla_ng;
  const float* mla_qg; const float* mla_wuq; const float* mla_kvg; const float* mla_wukv;
  const float* gdn_conv; const float* gdn_alog; const float* gdn_dtb; const float* gdn_ng;
  const float* ffn_wg; const float* ffn_wu; const float* ffn_conv; const float* ffn_wd;
  float* out; unsigned char* ws;
};

typedef __bf16 bf16v2_t __attribute__((ext_vector_type(2)));
typedef float f32v2_t __attribute__((ext_vector_type(2)));
DI unsigned pk_bf16(float lo, float hi) { f32v2_t v = {lo, hi}; bf16v2_t b = __builtin_convertvector(v, bf16v2_t); return __builtin_bit_cast(unsigned, b); }
DI float bf2f(bf16 v) { return __uint_as_float(((unsigned)v) << 16); }
DI bf16 f2bf(float x) { return (bf16)(pk_bf16(x, 0.f) & 0xffffu); }
DI float bflo(unsigned u) { return __uint_as_float(u << 16); }
DI float bfhi(unsigned u) { return __uint_as_float(u & 0xffff0000u); }
DI float sigmoidf_(float x) { return 1.f / (1.f + __expf(-x)); }
DI float siluf_(float x) { return x * sigmoidf_(x); }
DI float softplusf_(float x) { return fmaxf(x, 0.f) + __logf(1.f + __expf(-fabsf(x))); }
DI float wave_sum(float v) {
#pragma unroll
  for (int o = 1; o < 64; o <<= 1) v += __shfl_xor(v, o);
  return v;
}
#define MFMA32(a, b, c) __builtin_amdgcn_mfma_f32_32x32x16_bf16((a), (b), (c), 0, 0, 0)

DI f32x16 mm32(const unsigned char* A, int lda, const unsigned char* B, int ldb, int ks, f32x16 acc, int r, int h) {
  const unsigned char* pa = A + r * lda + h * 16;
  const unsigned char* pb = B + r * ldb + h * 16;
  for (int kk = 0; kk < ks; ++kk) {
    bf16x8 a = *(const bf16x8*)(pa + kk * 32);
    bf16x8 b = *(const bf16x8*)(pb + kk * 32);
    acc = MFMA32(a, b, acc);
  }
  return acc;
}
DI f32x16 zero16() { f32x16 z; for (int i = 0; i < 16; ++i) z[i] = 0.f; return z; }

DI int win_srccol(int n) {
  if (n < 1536) return n;
  if (n < 1792) return 1552 + (n - 1536);
  if (n < 2048) return 1808 + (n - 1792);
  if (n < 2176) return 2064 + (n - 2048);
  if (n < 2432) return 2224 + (n - 2176);
  if (n < 2688) return 2480 + (n - 2432);
  if (n < 2944) return 2736 + (n - 2688);
  if (n < 3200) return 3000 + (n - 2944);
  if (n < 3232) return 2192 + (n - 3200);
  if (n < 3248) return 1536 + (n - 3232);
  if (n < 3252) return 2992 + (n - 3248);
  if (n < 3256) return 2996 + (n - 3252);
  return -1;
}
DI int gu_rowmap(int c, int mode) { return mode == 0 ? c : ((c >> 7) * 256 + (c & 127) + (mode == 2 ? 128 : 0)); }
DI void transpose_tile(const float* __restrict__ src, int ldsrc, int K, bool perm, const float* __restrict__ gain, bf16* __restrict__ dst, int n0, int k0, unsigned char* lds, int tid, int rowmode = 0) {
  bf16* t = (bf16*)lds;
  const int nl = tid & 63, kq = tid >> 6;
  const int sc = perm ? win_srccol(n0 + nl) : (n0 + nl);
  float tv[16];
#pragma unroll
  for (int i = 0; i < 16; ++i) {
    const int k = k0 + kq + 4 * i;
    float v = 0.f;
    if (sc >= 0) { v = src[(size_t)k * ldsrc + sc]; if (gain) v *= gain[k]; }
    tv[i] = v;
  }
#pragma unroll
  for (int i = 0; i < 16; ++i) t[nl * 72 + kq + 4 * i] = f2bf(tv[i]);
  __syncthreads();
  const int r = tid >> 2, c = (tid & 3) * 16;
  u32x4 a = *(const u32x4*)(t + r * 72 + c), b = *(const u32x4*)(t + r * 72 + c + 8);
  bf16* o = dst + (size_t)gu_rowmap(n0 + r, rowmode) * K + k0 + c;
  *(u32x4*)o = a; *(u32x4*)(o + 8) = b;
  __syncthreads();
}

DI void frag_tile(const float* __restrict__ src, int ldsrc, bool isq, const float* __restrict__ gain, bf16* __restrict__ dst, int n0, int k0, int tid) {
  const int n = n0 + (tid & 63), kq = tid >> 6;
#pragma unroll
  for (int gi = 0; gi < 2; ++gi) {
    const int kg = k0 + (kq * 2 + gi) * 8;
    float v[8];
#pragma unroll
    for (int j = 0; j < 8; ++j) v[j] = src[(size_t)(kg + j) * ldsrc + n] * gain[kg + j];
    const int kk = kg >> 4, hh = (kg >> 3) & 1, r = n & 31;
    size_t off;
    if (isq) { const int hd = n / 96, nl = n % 96; off = ((size_t)(((hd * 16 + kk) * 3 + (nl >> 5)) * 64 + hh * 32 + r)) * 8; }
    else { const int hd = n >> 7, nl = n & 127; off = ((size_t)((((hd * 2 + (nl >> 6)) * 8 + kk) * 2 + ((nl >> 5) & 1)) * 64 + hh * 32 + r)) * 8; }
    u32x4 w; w.x = pk_bf16(v[0], v[1]); w.y = pk_bf16(v[2], v[3]); w.z = pk_bf16(v[4], v[5]); w.w = pk_bf16(v[6], v[7]);
    *(u32x4*)(dst + off) = w;
  }
  __syncthreads();
  __syncthreads();
}
DI void phase0(const Params& p, unsigned char* lds, int tid, int half) {
  bf16* W = (bf16*)(p.ws + OFF_W);
  constexpr int NT_L = 832 + 256 + 704 + 704 + 704 + 24 + 16;
  for (int pi = blockIdx.x; pi < NT_L; pi += gridDim.x) {
    const int it = 2 * pi + half;
    const int l = it / NT_L; int r = it % NT_L;
    bf16* Wl = W + (size_t)l * WL_E;
    if (r < 832) { transpose_tile(p.w_in + (size_t)l * 1024 * DIN, DIN, 1024, true, p.pre_mix_g + l * 1024, Wl + WO_IN, (r / 16) * 64, (r % 16) * 64, lds, tid); continue; } r -= 832;
    if (r < 256) { transpose_tile(p.w_out + (size_t)l * 1024 * 1024, 1024, 1024, false, nullptr, Wl + WO_OUT, (r / 16) * 64, (r % 16) * 64, lds, tid); continue; } r -= 256;
    if (r < 704) { transpose_tile(p.ffn_wg + (size_t)l * 1024 * FF, FF, 1024, false, p.pre_ffn_g + l * 1024, Wl + WO_GU, (r / 16) * 64, (r % 16) * 64, lds, tid, 1); continue; } r -= 704;
    if (r < 704) { transpose_tile(p.ffn_wu + (size_t)l * 1024 * FF, FF, 1024, false, p.pre_ffn_g + l * 1024, Wl + WO_GU, (r / 16) * 64, (r % 16) * 64, lds, tid, 2); continue; } r -= 704;
    if (r < 704) { transpose_tile(p.ffn_wd + (size_t)l * FF * 1024, 1024, FF, false, nullptr, Wl + WO_DN, (r / 44) * 64, (r % 44) * 64, lds, tid); continue; } r -= 704;
    if (r < 24) { frag_tile(p.mla_wuq + (size_t)l * 256 * 384, 384, true, p.mla_qg + l * 256, Wl + WO_UQ, (r / 4) * 64, (r % 4) * 64, tid); continue; } r -= 24;
    frag_tile(p.mla_wukv + (size_t)l * 128 * 512, 512, false, p.mla_kvg + l * 128, Wl + WO_UKV, (r / 2) * 64, (r % 2) * 64, tid);
  }
}

DI void resid_phase(const float* __restrict__ xin, const bf16* __restrict__ xinb, const bf16* __restrict__ y, const float* __restrict__ g, float* __restrict__ xout, bf16* __restrict__ xb, float* __restrict__ rs, int tid, int vb, int nvb) {
  const int lane = tid & 63, wv = tid >> 6;
  const int stride = nvb * 4;
  for (int row0 = vb * 4 + wv; row0 < T_; row0 += 2 * stride) {
    f32x4 v[2][4]; u32x2 yu[2][4];
#pragma unroll
    for (int q = 0; q < 2; ++q) {
      const int row = min(row0 + q * stride, T_ - 1);
      if (xin) {
#pragma unroll
        for (int j = 0; j < 4; ++j) v[q][j] = *(const f32x4*)(xin + (size_t)row * 1024 + lane * 4 + 256 * j);
      } else {
#pragma unroll
        for (int j = 0; j < 4; ++j) { const u32x2 u = *(const u32x2*)(xinb + (size_t)row * 1024 + lane * 4 + 256 * j); v[q][j] = (f32x4){bflo(u.x), bfhi(u.x), bflo(u.y), bfhi(u.y)}; }
      }
      if (y) {
#pragma unroll
        for (int j = 0; j < 4; ++j) yu[q][j] = *(const u32x2*)(y + (size_t)row * 1024 + lane * 4 + 256 * j);
      }
    }
#pragma unroll
    for (int q = 0; q < 2; ++q) {
      const int row = row0 + q * stride;
      if (y) {
        f32x4 yv[4]; float ss = 0.f;
#pragma unroll
        for (int j = 0; j < 4; ++j) {
          yv[j] = (f32x4){bflo(yu[q][j].x), bfhi(yu[q][j].x), bflo(yu[q][j].y), bfhi(yu[q][j].y)};
          ss += yv[j].x * yv[j].x + yv[j].y * yv[j].y + yv[j].z * yv[j].z + yv[j].w * yv[j].w;
        }
        const float ry = rsqrtf(wave_sum(ss) * (1.f / 1024.f) + EPS);
#pragma unroll
        for (int j = 0; j < 4; ++j) { f32x4 gg = *(const f32x4*)(g + lane * 4 + 256 * j); v[q][j] = v[q][j] + yv[j] * ry * gg; }
      }
      float sx = 0.f;
#pragma unroll
      for (int j = 0; j < 4; ++j) sx += v[q][j].x * v[q][j].x + v[q][j].y * v[q][j].y + v[q][j].z * v[q][j].z + v[q][j].w * v[q][j].w;
      sx = wave_sum(sx);
      if (row < T_) {
#pragma unroll
        for (int j = 0; j < 4; ++j) {
          if (xout) *(f32x4*)(xout + (size_t)row * 1024 + lane * 4 + 256 * j) = v[q][j];
          if (xb) {
            u32x2 o; o.x = pk_bf16(v[q][j].x, v[q][j].y); o.y = pk_bf16(v[q][j].z, v[q][j].w);
            *(u32x2*)(xb + (size_t)row * 1024 + lane * 4 + 256 * j) = o;
          }
        }
        if (xb && lane == 0) rs[row] = rsqrtf(sx * (1.f / 1024.f) + EPS);
      }
    }
  }
}

DI float gelu_tanh(float x) {
  const float u = 0.7978845608028654f * (x + 0.044715f * x * x * x);
  const float e = __expf(2.f * u);
  const float th = 1.f - 2.f / (e + 1.f);
  return 0.5f * x * (1.f + th);
}
struct EpiStore {
  bf16* out0; bf16* out1; int split; int ldc; const float* rs; const float* cw;
  DI void store4(int m, int n, f32x4 v) const {
    bf16* o = out0; if (n >= split) { o = out1; n -= split; }
    u32x2 w; w.x = pk_bf16(v.x, v.y); w.y = pk_bf16(v.z, v.w);
    *(u32x2*)(o + (size_t)m * ldc + n) = w;
  }
};

#define GL_LAS __attribute__((address_space(3)))
DI int g8_lds_byte(int r, int c) { const int st = (r >> 4) * 2 + (c >> 5), rr = r & 15, cc = c & 31, ob = rr * 64 + cc * 2; return st * 1024 + (ob ^ (((ob >> 9) & 1) << 5)); }
DI void g8_stage_rc(int b, int& R, int& C) { const int st = b / 1024, sb = b % 1024, swz = sb ^ (((sb >> 9) & 1) << 5); R = (st >> 1) * 16 + swz / 64; C = (st & 1) * 32 + (swz % 64) / 2; }
template <bool ACT>
DI void gemm_phase(const bf16* __restrict__ A, int lda, const bf16* __restrict__ Bt, int ldb, int K, int MT, int NT, const EpiStore& epi, unsigned char* lds, int tid) {
  constexpr int HTB = 128 * 64 * 2;
  const int nt_k = K / 64;
  const int xcd = blockIdx.x & 7, jb = blockIdx.x >> 3, nbx = (gridDim.x + 7 - xcd) >> 3;
  const int band = MT / 8, per_x = band * NT;
  for (int lt = jb; lt < per_x; lt += nbx) {
    const int mg = lt / (8 * NT), rem = lt % (8 * NT), gs = min(8, band - 8 * mg);
    const int mt = xcd * band + mg * 8 + rem % gs, nt = rem / gs, n0 = nt * 256;
    int m0 = mt * 256, seq0 = 0;
    if (ACT) { const int bs = mt / 34, ti = mt % 34; if (ti == 33) continue; seq0 = bs * S_; m0 = seq0 + 254 * ti - 2; }
    __syncthreads();
    asm volatile("" : "+v"(tid));
    const int wid = tid >> 6, lane = tid & 63, wr = wid >> 2, wc = wid & 3, fr = lane & 15, fq = lane >> 4;
    const int obs = (fr * 64 + fq * 16) ^ ((((fr * 64 + fq * 16) >> 9) & 1) << 5);
    const int a_rd = obs + wr * 8192, b_rd = obs + wc * 4096;
#define SA8(b, h) (lds + ((b) * 2 + (h)) * HTB)
#define SB8(b, h) (lds + (4 + (b) * 2 + (h)) * HTB)
    unsigned aofs[2][2], bofs[2];
#pragma unroll
    for (int i = 0; i < 2; ++i) {
      int sr_, sc_; g8_stage_rc(tid * 16 + i * 8192, sr_, sc_);
      bofs[i] = ((unsigned)(n0 + sr_) * (unsigned)ldb + (unsigned)sc_) * 2u;
#pragma unroll
      for (int hf = 0; hf < 2; ++hf) {
        int row = m0 + sr_ + (ACT ? hf * 128 : 0); if (ACT) row = min(max(row, seq0), seq0 + S_ - 1);
        aofs[hf][i] = ((unsigned)row * (unsigned)lda + (unsigned)sc_) * 2u;
      }
    }
#define STAGE_A(P, half_, kt) do { const unsigned char* ub_ = (const unsigned char*)A + (size_t)(kt) * 128 + (ACT ? (size_t)0 : (size_t)(half_) * 256 * (size_t)lda); _Pragma("unroll") for (int _i = 0; _i < 2; ++_i) \
      __builtin_amdgcn_global_load_lds((const unsigned*)(ub_ + aofs[half_][_i]), (GL_LAS unsigned*)((P) + tid * 16 + _i * 8192), 16, 0, 0); } while (0)
#define STAGE_B(P, half_, kt) do { const unsigned char* ub_ = (const unsigned char*)Bt + (size_t)(kt) * 128 + (size_t)(half_) * 256 * (size_t)ldb; _Pragma("unroll") for (int _i = 0; _i < 2; ++_i) \
      __builtin_amdgcn_global_load_lds((const unsigned*)(ub_ + bofs[_i]), (GL_LAS unsigned*)((P) + tid * 16 + _i * 8192), 16, 0, 0); } while (0)
#define LDA8(dst, b, h) _Pragma("unroll") for (int m = 0; m < 4; ++m) _Pragma("unroll") for (int k = 0; k < 2; ++k) \
      dst[m][k] = *(const bf16x8*)(SA8(b, h) + a_rd + m * 2048 + k * 1024)
#define LDB8(dst, b, h) _Pragma("unroll") for (int n = 0; n < 2; ++n) _Pragma("unroll") for (int k = 0; k < 2; ++k) \
      dst[n][k] = *(const bf16x8*)(SB8(b, h) + b_rd + n * 2048 + k * 1024)
#define MMA8(ai, bj, At_, Bt_) do { __builtin_amdgcn_s_setprio(1); \
      _Pragma("unroll") for (int m = 0; m < 4; ++m) _Pragma("unroll") for (int n = 0; n < 2; ++n) _Pragma("unroll") for (int k = 0; k < 2; ++k) \
        acc[ai][bj][m][n] = __builtin_amdgcn_mfma_f32_16x16x32_bf16(Bt_[n][k], At_[m][k], acc[ai][bj][m][n], 0, 0, 0); \
      __builtin_amdgcn_s_setprio(0); } while (0)
#define WAIT_V(n) asm volatile("s_waitcnt vmcnt(" #n ")" ::: "memory")
#define WAIT_L(n) asm volatile("s_waitcnt lgkmcnt(" #n ")" ::: "memory")
#define BAR8 __builtin_amdgcn_s_barrier()
#define SCHED8 __builtin_amdgcn_sched_barrier(0)
    f32x4 acc[2][2][4][2];
#pragma unroll
    for (int i0 = 0; i0 < 2; ++i0)
#pragma unroll
      for (int i1 = 0; i1 < 2; ++i1)
#pragma unroll
        for (int i2 = 0; i2 < 4; ++i2)
#pragma unroll
          for (int i3 = 0; i3 < 2; ++i3) acc[i0][i1][i2][i3] = (f32x4){0.f, 0.f, 0.f, 0.f};
    bf16x8 At[4][2], B0[2][2], B1[2][2];
    WAIT_V(0);
    STAGE_B(SB8(0, 0), 0, 0); STAGE_A(SA8(0, 0), 0, 0);
    STAGE_B(SB8(0, 1), 1, 0); STAGE_A(SA8(0, 1), 1, 0);
    if (wr == 1) BAR8;
    WAIT_V(4); BAR8;
    STAGE_B(SB8(1, 0), 0, 1); STAGE_A(SA8(1, 0), 0, 1); STAGE_B(SB8(1, 1), 1, 1);
    WAIT_V(6); BAR8;
    for (int t = 0; t < nt_k - 2; t += 2) {
      LDB8(B0, 0, 0); SCHED8; LDA8(At, 0, 0); STAGE_A(SA8(1, 1), 1, t + 1);
      WAIT_L(8); BAR8; WAIT_L(0); MMA8(0, 0, At, B0); BAR8; SCHED8;
      LDB8(B1, 0, 1); STAGE_B(SB8(0, 0), 0, t + 2);
      BAR8; WAIT_L(0); MMA8(0, 1, At, B1); BAR8;
      LDA8(At, 0, 1); STAGE_A(SA8(0, 0), 0, t + 2);
      BAR8; WAIT_L(0); MMA8(1, 0, At, B0); BAR8; SCHED8;
      STAGE_B(SB8(0, 1), 1, t + 2);
      WAIT_V(6); BAR8; MMA8(1, 1, At, B1); BAR8;
      LDB8(B0, 1, 0); SCHED8; LDA8(At, 1, 0); STAGE_A(SA8(0, 1), 1, t + 2);
      WAIT_L(8); BAR8; WAIT_L(0); MMA8(0, 0, At, B0); BAR8; SCHED8;
      LDB8(B1, 1, 1); STAGE_B(SB8(1, 0), 0, t + 3);
      BAR8; WAIT_L(0); MMA8(0, 1, At, B1); BAR8;
      LDA8(At, 1, 1); STAGE_A(SA8(1, 0), 0, t + 3);
      BAR8; WAIT_L(0); MMA8(1, 0, At, B0); BAR8; SCHED8;
      STAGE_B(SB8(1, 1), 1, t + 3);
      WAIT_V(6); BAR8; MMA8(1, 1, At, B1); BAR8;
    }
    { LDB8(B0, 0, 0); LDA8(At, 0, 0); STAGE_A(SA8(1, 1), 1, nt_k - 1);
      BAR8; WAIT_L(0); MMA8(0, 0, At, B0); BAR8;
      LDB8(B1, 0, 1); BAR8; WAIT_L(0); MMA8(0, 1, At, B1); BAR8;
      LDA8(At, 0, 1); WAIT_V(4); BAR8; WAIT_L(0); MMA8(1, 0, At, B0); MMA8(1, 1, At, B1); BAR8; }
    { LDB8(B0, 1, 0); LDA8(At, 1, 0); WAIT_V(2); BAR8; WAIT_L(0); MMA8(0, 0, At, B0); BAR8;
      LDB8(B1, 1, 1); WAIT_V(0); BAR8; WAIT_L(0); MMA8(0, 1, At, B1); BAR8;
      LDA8(At, 1, 1); BAR8; WAIT_L(0); MMA8(1, 0, At, B0); MMA8(1, 1, At, B1); BAR8; }
    if (wr == 0) BAR8;
    __syncthreads();
    int tid_e = tid; asm volatile("" : "+v"(tid_e));
    const int e_wid = tid_e >> 6, e_lane = tid_e & 63, e_wr = e_wid >> 2, e_wc = e_wid & 3, e_fr = e_lane & 15, e_fq = e_lane >> 4;
    if (!ACT) {
#pragma unroll
      for (int ai = 0; ai < 2; ++ai)
#pragma unroll
        for (int m = 0; m < 4; ++m) {
          const int ml = ai * 128 + e_wr * 64 + m * 16 + e_fr;
          const float sc = epi.rs ? epi.rs[m0 + ml] : 1.f;
#pragma unroll
          for (int bj = 0; bj < 2; ++bj)
#pragma unroll
            for (int n = 0; n < 2; ++n) {
              const f32x4 v = acc[ai][bj][m][n] * sc;
              u32x2 w2; w2.x = pk_bf16(v[0], v[1]); w2.y = pk_bf16(v[2], v[3]);
              *(u32x2*)(lds + ml * 520 + (bj * 128 + e_wc * 32 + n * 16 + e_fq * 4) * 2) = w2;
            }
        }
      __syncthreads();
#pragma unroll 2
      for (int k = 0; k < 16; ++k) {
        const int id = tid_e + 512 * k, row = id >> 5, ch = id & 31;
        const u32x2 lo = *(const u32x2*)(lds + row * 520 + ch * 16), hi = *(const u32x2*)(lds + row * 520 + ch * 16 + 8);
        *(u32x4*)(epi.out0 + (size_t)(m0 + row) * epi.ldc + n0 + ch * 8) = (u32x4){lo.x, lo.y, hi.x, hi.y};
      }
    } else {
      float* G = (float*)lds;
#pragma unroll
      for (int ai = 0; ai < 2; ++ai)
#pragma unroll
        for (int m = 0; m < 4; ++m) {
          const int ml = ai * 128 + e_wr * 64 + m * 16 + e_fr;
          const float sc = epi.rs[min(max(m0 + ml, seq0), seq0 + S_ - 1)];
#pragma unroll
          for (int n = 0; n < 2; ++n) {
            acc[ai][0][m][n] = acc[ai][0][m][n] * sc; acc[ai][1][m][n] = acc[ai][1][m][n] * sc;
#pragma unroll
            for (int j = 0; j < 4; ++j) G[(e_wc * 32 + n * 16 + e_fq * 4 + j) * 256 + ml] = acc[ai][0][m][n][j];
          }
        }
      __syncthreads();
#pragma unroll
      for (int n = 0; n < 2; ++n) {
        const int chl = e_wc * 32 + n * 16 + e_fq * 4, c = nt * 128 + chl;
        const f32x4 w0 = *(const f32x4*)(epi.cw + c), w1 = *(const f32x4*)(epi.cw + FF + c), w2 = *(const f32x4*)(epi.cw + 2 * FF + c);
#pragma unroll
        for (int ai = 0; ai < 2; ++ai)
#pragma unroll
          for (int m = 0; m < 4; ++m) {
            const int ml = ai * 128 + e_wr * 64 + m * 16 + e_fr, t = m0 + ml, sq = t - seq0;
            const int m1 = max(ml - 1, 0), m2 = max(ml - 2, 0);
            float o[4];
#pragma unroll
            for (int j = 0; j < 4; ++j) {
              const float g0 = acc[ai][0][m][n][j];
              const float g1 = (sq >= 1) ? G[(chl + j) * 256 + m1] : 0.f;
              const float g2 = (sq >= 2) ? G[(chl + j) * 256 + m2] : 0.f;
              const float cv = w0[j] * g2 + w1[j] * g1 + w2[j] * g0;
              o[j] = gelu_tanh(cv) * acc[ai][1][m][n][j];
            }
            if (ml >= 2 && sq < S_) {
              u32x2 wv2; wv2.x = pk_bf16(o[0], o[1]); wv2.y = pk_bf16(o[2], o[3]);
              *(u32x2*)(epi.out0 + (size_t)t * FF + c) = wv2;
            }
          }
      }
    }
  }
  __syncthreads();
}

DI void ffn_act_phase(const bf16* __restrict__ gate, bf16* __restrict__ up, const float* __restrict__ cw, int tid) {
  constexpr int CG = FF / 8;
  const int total = (T_ / 16) * CG;
  for (int it = blockIdx.x * 256 + tid; it < total; it += gridDim.x * 256) {
    const int tb = it / CG, cgp = it % CG, t0 = tb * 16, c0 = cgp * 8;
    float w0[8], w1[8], w2[8], g1[8], g2[8];
#pragma unroll
    for (int i = 0; i < 8; ++i) { w0[i] = cw[c0 + i]; w1[i] = cw[FF + c0 + i]; w2[i] = cw[2 * FF + c0 + i]; g1[i] = 0.f; g2[i] = 0.f; }
    if ((t0 & (S_ - 1)) != 0) {
      u32x4 a = *(const u32x4*)(gate + (size_t)(t0 - 2) * FF + c0), b = *(const u32x4*)(gate + (size_t)(t0 - 1) * FF + c0);
#pragma unroll
      for (int i = 0; i < 4; ++i) { g2[2 * i] = bflo(a[i]); g2[2 * i + 1] = bfhi(a[i]); g1[2 * i] = bflo(b[i]); g1[2 * i + 1] = bfhi(b[i]); }
    }
#pragma unroll 4
    for (int t = t0; t < t0 + 16; ++t) {
      u32x4 a = *(const u32x4*)(gate + (size_t)t * FF + c0), u = *(const u32x4*)(up + (size_t)t * FF + c0);
      float g0[8], uu[8], o[8];
#pragma unroll
      for (int i = 0; i < 4; ++i) { g0[2 * i] = bflo(a[i]); g0[2 * i + 1] = bfhi(a[i]); uu[2 * i] = bflo(u[i]); uu[2 * i + 1] = bfhi(u[i]); }
#pragma unroll
      for (int i = 0; i < 8; ++i) { const float c = w0[i] * g2[i] + w1[i] * g1[i] + w2[i] * g0[i]; o[i] = gelu_tanh(c) * uu[i]; g2[i] = g1[i]; g1[i] = g0[i]; }
      u32x4 w; w.x = pk_bf16(o[0], o[1]); w.y = pk_bf16(o[2], o[3]); w.z = pk_bf16(o[4], o[5]); w.w = pk_bf16(o[6], o[7]);
      *(u32x4*)(up + (size_t)t * FF + c0) = w;
    }
  }
}

template <int DK, bool ISA>
DI float gla_lb(const Params& p, int l, int h, int d) {
  if (!ISA || l == 0) return 0.f;
  const float l0 = p.hgrn_lb[h * 64 + d], l1 = p.hgrn_lb[256 + h * 64 + d];
  return 1.f / (1.f + __expf(l0 - l1));
}
template <int DK, bool ISA>
DI void gla_bc(const Params& p, int l, const bf16* __restrict__ z, int t0, int h, float* bcl, int tid) {
  constexpr int NP = 256 / DK, TPP = 64 / NP;
  const int d = tid % DK, part = tid / DK;
  float run = 0.f;
  if (ISA) {
    const float lbv = gla_lb<DK, ISA>(p, l, h, d);
#pragma unroll
    for (int jj = 0; jj < TPP; ++jj) {
      const int j = part * TPP + jj;
      const float zf = bf2f(z[(size_t)(t0 + j) * ZLD + ZA_F + h * 64 + d]);
      const float f = lbv + (1.f - lbv) * sigmoidf_(zf);
      run += __logf(fmaxf(f, 1e-30f));
      bcl[j * DK + d] = run;
    }
  } else {
    float w[16];
#pragma unroll
    for (int rr = 0; rr < 16; ++rr) w[rr] = p.gla_w2[(size_t)l * 16 * 128 + rr * 128 + h * 32 + d];
    const float bias = p.gla_b[l * 128 + h * 32 + d];
#pragma unroll
    for (int jj = 0; jj < TPP; ++jj) {
      const int j = part * TPP + jj;
      const u32x4* cp = (const u32x4*)(z + (size_t)(t0 + j) * ZLD + ZB_CODE);
      u32x4 c0 = cp[0], c1 = cp[1];
      float u = bias;
#pragma unroll
      for (int i = 0; i < 4; ++i) { u += bflo(c0[i]) * w[2 * i] + bfhi(c0[i]) * w[2 * i + 1]; u += bflo(c1[i]) * w[8 + 2 * i] + bfhi(c1[i]) * w[8 + 2 * i + 1]; }
      run += -softplusf_(-u) * (1.f / 16.f);
      bcl[j * DK + d] = run;
    }
  }
  __syncthreads();
  float off = 0.f;
  for (int pp = 0; pp < part; ++pp) off += bcl[(pp * TPP + TPP - 1) * DK + d];
  __syncthreads();
#pragma unroll
  for (int jj = 0; jj < TPP; ++jj) bcl[(part * TPP + jj) * DK + d] += off;
  __syncthreads();
}
template <int DK, bool ISA>
DI float gla_kval(const bf16* __restrict__ z, int t, int h, int d, float lbv) {
  if (ISA) { const float zf = bf2f(z[(size_t)t * ZLD + ZA_F + h * 64 + d]); return (1.f - lbv) * sigmoidf_(-zf); }
  return bf2f(z[(size_t)t * ZLD + ZB_K + h * 32 + d]);
}
template <int DK, bool ISA>
DI float gla_qval(const bf16* __restrict__ z, int t, int h, int d) {
  if (ISA) { const float zq = bf2f(z[(size_t)t * ZLD + ZA_Q + h * 64 + d]); return siluf_(zq) * 0.125f; }
  return bf2f(z[(size_t)t * ZLD + ZB_Q + h * 32 + d]) * 0.17677669529663687f;
}

template <int DK, bool ISA>
DI void gla_local_item(const Params& p, int l, int ci, unsigned char* lds, int tid) {
  const bf16* z = (const bf16*)(p.ws + OFF_AR + AR_Z);
  bf16* UT = (bf16*)(p.ws + OFF_AR + (ISA ? AR_UTA : AR_UTB));
  float* G = (float*)(p.ws + (ISA ? OFF_GA : OFF_GB));
  const int h = ci & 3, t0 = (ci >> 2) * 64;
  float* bcl = (float*)lds;
  bf16* kT = (bf16*)(lds + 16384);
  bf16* vT = (bf16*)(lds + 16384 + 9216);
  bf16 vpre[16];
  {
    const int e = tid & 63, p4 = tid >> 6;
    const int vcol = (ISA ? ZA_I : ZB_V) + h * 64 + e;
#pragma unroll
    for (int jj = 0; jj < 16; ++jj) vpre[jj] = z[(size_t)(t0 + p4 * 16 + jj) * ZLD + vcol];
  }
  gla_bc<DK, ISA>(p, l, z, t0, h, bcl, tid);
  {
    float* bcg = (float*)((unsigned char*)p.out + BC_OFF + (ISA ? 0 : BC_B_OFF)) + (size_t)ci * 64 * DK;
#pragma unroll
    for (int k = 0; k < (64 * DK) / 1024; ++k) *(f32x4*)(bcg + (tid + 256 * k) * 4) = *(const f32x4*)(bcl + (tid + 256 * k) * 4);
  }
  constexpr int NP = 256 / DK, TPP = 64 / NP;
  {
    const int d = tid % DK, part = tid / DK;
    const float lbv = gla_lb<DK, ISA>(p, l, h, d);
    const float bl = bcl[63 * DK + d];
#pragma unroll
    for (int jj = 0; jj < TPP; ++jj) {
      const int j = part * TPP + jj;
      const float kv = gla_kval<DK, ISA>(z, t0 + j, h, d, lbv);
      kT[d * 72 + j] = f2bf(kv * __expf(bl - bcl[j * DK + d]));
    }
    if (part == 0) G[(size_t)ci * DK + d] = __expf(bl);
    const int e = tid & 63, p4 = tid >> 6;
#pragma unroll
    for (int jj = 0; jj < 16; ++jj) { const int j = p4 * 16 + jj; vT[e * 72 + j] = vpre[jj]; }
  }
  __syncthreads();
  const int lane = tid & 63, wv = tid >> 6, wm = wv & 1, wn = wv >> 1, r = lane & 31, hh = lane >> 5;
  if (wm * 32 < DK) {
    f32x16 acc = mm32((const unsigned char*)(kT + wm * 32 * 72), 144, (const unsigned char*)(vT + wn * 32 * 72), 144, 4, zero16(), r, hh);
    const int e = wn * 32 + r;
#pragma unroll
    for (int g = 0; g < 4; ++g) {
      const int d = wm * 32 + 8 * g + 4 * hh;
      u32x2 w; w.x = pk_bf16(acc[4 * g], acc[4 * g + 1]); w.y = pk_bf16(acc[4 * g + 2], acc[4 * g + 3]);
      *(u32x2*)(UT + ((size_t)ci * 64 + e) * DK + d) = w;
    }
  }
  __syncthreads();
}

template <int DK>
DI void gla_scan_item(bf16* __restrict__ UT, const float* __restrict__ G, int b, int h, int slice, int tid) {
  constexpr int GPR = DK / 4, RPS = 256 / GPR;
  const int e = slice * RPS + tid / GPR, d4 = (tid % GPR) * 4;
  f32x4 st = (f32x4){0.f, 0.f, 0.f, 0.f};
  for (int c0 = 0; c0 < 128; c0 += 8) {
    u32x2 u[8]; f32x4 gg[8];
#pragma unroll
    for (int i = 0; i < 8; ++i) {
      const size_t ci = ((size_t)(b * 128 + c0 + i) * 4 + h);
      u[i] = *(const u32x2*)(UT + (ci * 64 + e) * DK + d4);
      gg[i] = *(const f32x4*)(G + ci * DK + d4);
    }
#pragma unroll
    for (int i = 0; i < 8; ++i) {
      const size_t ci = ((size_t)(b * 128 + c0 + i) * 4 + h);
      u32x2 w; w.x = pk_bf16(st.x, st.y); w.y = pk_bf16(st.z, st.w);
      *(u32x2*)(UT + (ci * 64 + e) * DK + d4) = w;
      st = gg[i] * st + (f32x4){bflo(u[i].x), bfhi(u[i].x), bflo(u[i].y), bfhi(u[i].y)};
    }
  }
}

template <bool SIG>
DI void norm_gate_store(const float* obuf, bool has_add, u32x4 a0, u32x4 a1, const float* __restrict__ ng, u32x4 g0, u32x4 g1, bf16* __restrict__ mixo, int tid) {
  const int i = tid >> 2, e0 = (tid & 3) * 16;
  float o[16]; float ss = 0.f;
#pragma unroll
  for (int k = 0; k < 16; ++k) o[k] = obuf[i * 68 + e0 + k];
  if (has_add) {
#pragma unroll
    for (int k = 0; k < 4; ++k) { o[2 * k] += bflo(a0[k]); o[2 * k + 1] += bfhi(a0[k]); o[8 + 2 * k] += bflo(a1[k]); o[8 + 2 * k + 1] += bfhi(a1[k]); }
  }
#pragma unroll
  for (int k = 0; k < 16; ++k) ss += o[k] * o[k];
  ss += __shfl_xor(ss, 1); ss += __shfl_xor(ss, 2);
  const float rsv = rsqrtf(ss * (1.f / 64.f) + EPS);
  float gt[16];
#pragma unroll
  for (int k = 0; k < 4; ++k) { gt[2 * k] = bflo(g0[k]); gt[2 * k + 1] = bfhi(g0[k]); gt[8 + 2 * k] = bflo(g1[k]); gt[8 + 2 * k + 1] = bfhi(g1[k]); }
  unsigned w[8];
#pragma unroll
  for (int k = 0; k < 8; ++k) {
    float a = o[2 * k] * rsv * ng[e0 + 2 * k], b = o[2 * k + 1] * rsv * ng[e0 + 2 * k + 1];
    a *= SIG ? sigmoidf_(gt[2 * k]) : siluf_(gt[2 * k]);
    b *= SIG ? sigmoidf_(gt[2 * k + 1]) : siluf_(gt[2 * k + 1]);
    w[k] = pk_bf16(a, b);
  }
  u32x4* op = (u32x4*)(mixo + (size_t)i * 1024 + e0);
  op[0] = (u32x4){w[0], w[1], w[2], w[3]}; op[1] = (u32x4){w[4], w[5], w[6], w[7]};
}

template <int DK, bool ISA>
DI void gla_out_item(const Params& p, int l, int ci, unsigned char* lds, int tid) {
  const bf16* z = (const bf16*)(p.ws + OFF_AR + AR_Z);
  const bf16* ST = (const bf16*)(p.ws + OFF_AR + (ISA ? AR_UTA : AR_UTB));
  bf16* mix = (bf16*)(p.ws + OFF_AR + AR_MIX);
  const int h = ci & 3, t0 = (ci >> 2) * 64;
  constexpr int LDK = (DK + 8) * 2;
  float* bcl = (float*)lds;
  float* obuf = (float*)lds;
  unsigned char* qh = lds + 17408;
  unsigned char* kt = qh + 9216;
  unsigned char* qc = kt + 9216;
  unsigned char* vT = qc + 9216;
  unsigned char* stl = vT + 9216;
  unsigned char* attn = stl + 9216;
  const u32x4* gpre = (const u32x4*)(z + (size_t)(t0 + (tid >> 2)) * ZLD + (ISA ? ZA_G : ZB_G) + h * 64 + (tid & 3) * 16);
  const u32x4 gq0 = gpre[0], gq1 = gpre[1];
  bf16 vpre[16];
  {
    const int e = tid & 63, p4 = tid >> 6;
    const int vcol = (ISA ? ZA_I : ZB_V) + h * 64 + e;
#pragma unroll
    for (int jj = 0; jj < 16; ++jj) vpre[jj] = z[(size_t)(t0 + p4 * 16 + jj) * ZLD + vcol];
  }
  constexpr int NPq = 256 / DK, TPPq = 64 / NPq;
  bf16 qpre[TPPq], kpre[TPPq];
  {
    const int d = tid % DK, part = tid / DK;
#pragma unroll
    for (int jj = 0; jj < TPPq; ++jj) {
      const size_t t = (size_t)(t0 + part * TPPq + jj);
      qpre[jj] = z[t * ZLD + (ISA ? ZA_Q + h * 64 : ZB_Q + h * 32) + d];
      kpre[jj] = ISA ? (bf16)0 : z[t * ZLD + ZB_K + h * 32 + d];
    }
  }
  constexpr int CPR0 = DK / 8, NST = (64 * CPR0) / 256;
  u32x4 stpre[NST];
#pragma unroll
  for (int k = 0; k < NST; ++k) { const int id = tid + 256 * k; stpre[k] = *(const u32x4*)(ST + ((size_t)ci * 64 + id / CPR0) * DK + (id % CPR0) * 8); }
  {
    const float* bcg = (const float*)((const unsigned char*)p.out + BC_OFF + (ISA ? 0 : BC_B_OFF)) + (size_t)ci * 64 * DK;
#pragma unroll
    for (int k = 0; k < (64 * DK) / 1024; ++k) *(f32x4*)(bcl + (tid + 256 * k) * 4) = *(const f32x4*)(bcg + (tid + 256 * k) * 4);
    __syncthreads();
  }
  constexpr int NP = 256 / DK, TPP = 64 / NP;
  {
    const int d = tid % DK, part = tid / DK;
    const float lbv = gla_lb<DK, ISA>(p, l, h, d);
    const float bref = bcl[31 * DK + d];
#pragma unroll
    for (int jj = 0; jj < TPP; ++jj) {
      const int j = part * TPP + jj;
      const float kv = ISA ? gla_kval<DK, ISA>(z, t0 + j, h, d, lbv) : bf2f(kpre[jj]);
      const float qv = ISA ? siluf_(bf2f(qpre[jj])) * 0.125f : bf2f(qpre[jj]) * 0.17677669529663687f;
      const float bc = bcl[j * DK + d];
      const float dq = fminf(fmaxf(bc - bref, -80.f), 80.f);
      ((bf16*)qh)[j * (DK + 8) + d] = f2bf(qv * __expf(dq));
      ((bf16*)kt)[j * (DK + 8) + d] = f2bf(kv * __expf(-dq));
      ((bf16*)qc)[j * (DK + 8) + d] = f2bf(qv * __expf(bc));
    }
    const int e = tid & 63, p4 = tid >> 6;
#pragma unroll
    for (int jj = 0; jj < 16; ++jj) { const int j = p4 * 16 + jj; ((bf16*)vT)[e * 72 + j] = vpre[jj]; }
#pragma unroll
    for (int k = 0; k < NST; ++k) { const int id = tid + 256 * k; *(u32x4*)(stl + (id / CPR0) * LDK + (id % CPR0) * 16) = stpre[k]; }
  }
  __syncthreads();
  const int lane = tid & 63, wv = tid >> 6, wm = wv & 1, wn = wv >> 1, r = lane & 31, hh = lane >> 5;
  {
    f32x16 acc = mm32(qh + wm * 32 * LDK, LDK, kt + wn * 32 * LDK, LDK, DK / 16, zero16(), r, hh);
    const int jc = wn * 32 + r;
#pragma unroll
    for (int g = 0; g < 4; ++g)
#pragma unroll
      for (int k = 0; k < 4; ++k) {
        const int i = wm * 32 + 8 * g + 4 * hh + k;
        const float v = (jc <= i) ? acc[4 * g + k] : 0.f;
        ((bf16*)attn)[i * 72 + jc] = f2bf(v);
      }
  }
  __syncthreads();
  {
    f32x16 acc = mm32(attn + wm * 32 * 144, 144, vT + wn * 32 * 144, 144, 4, zero16(), r, hh);
    acc = mm32(qc + wm * 32 * LDK, LDK, stl + wn * 32 * LDK, LDK, DK / 16, acc, r, hh);
    const int e = wn * 32 + r;
#pragma unroll
    for (int g = 0; g < 4; ++g)
#pragma unroll
      for (int k = 0; k < 4; ++k) obuf[(wm * 32 + 8 * g + 4 * hh + k) * 68 + e] = acc[4 * g + k];
  }
  __syncthreads();
  norm_gate_store<ISA>(obuf, false, gq0, gq0, (ISA ? p.hgrn_ng : p.gla_ng) + l * 64, gq0, gq1, mix + (size_t)t0 * 1024 + (ISA ? 0 : 256) + h * 64, tid);
  __syncthreads();
}

DI void gdn_local_item(const Params& p, int l, int ci, unsigned char* lds, int tid) {
  const bf16* z = (const bf16*)(p.ws + OFF_AR + AR_Z);
  float* Ac = (float*)(p.ws + OFF_AR + AR_ACD) + (size_t)ci * 4096;
  bf16* BT = (bf16*)(p.ws + OFF_AR + AR_BTD) + (size_t)ci * 4096;
  bf16* Qeff = (bf16*)(p.ws + OFF_AR + AR_QEFF) + (size_t)ci * 4096;
  bf16* Oloc = (bf16*)(p.ws + OFF_AR + AR_OLOC) + (size_t)ci * 4096;
  const int h = ci & 3, t0 = (ci >> 2) * 64, s0 = t0 & (S_ - 1);
  float* Mf = (float*)lds;
  bf16* WT = (bf16*)lds;
  bf16* UT = (bf16*)(lds + 9216);
  float* X = (float*)(lds + 16384);
  bf16* qn = (bf16*)(lds + 16384);
  bf16* kn = qn + 64 * 72;
  bf16* vb = kn + 64 * 72;
  bf16* kbm = (bf16*)(lds + 49152);
  bf16* aqk = kbm;
  bf16* KtT = kbm + 64 * 72;
  float* sm = (float*)(lds + 49152 + 2 * 9216);
  float* betas = sm; float* bcum = sm + 64;
  const int lane = tid & 63, wv = tid >> 6;
  const bf16 zbeta_raw = z[(size_t)(t0 + lane) * ZLD + ZD_BETA + h], za_raw = z[(size_t)(t0 + lane) * ZLD + ZD_A + h];
  {
    const int d = lane, j0 = wv * 16;
    const float* cw = p.gdn_conv + (size_t)l * 4 * 768;
    float qv[16], kv[16];
#pragma unroll
    for (int which = 0; which < 3; ++which) {
      const int cc = which * 256 + h * 64 + d;
      const int zc = (which == 0 ? ZD_Q : (which == 1 ? ZD_K : ZD_V)) + h * 64 + d;
      const float c0 = cw[cc], c1 = cw[768 + cc], c2 = cw[2 * 768 + cc], c3 = cw[3 * 768 + cc];
      float x0 = 0.f, x1 = 0.f, x2 = 0.f;
      if (s0 + j0 >= 3) { x0 = bf2f(z[(size_t)(t0 + j0 - 3) * ZLD + zc]); x1 = bf2f(z[(size_t)(t0 + j0 - 2) * ZLD + zc]); x2 = bf2f(z[(size_t)(t0 + j0 - 1) * ZLD + zc]); }
#pragma unroll
      for (int jj = 0; jj < 16; ++jj) {
        const float x3 = bf2f(z[(size_t)(t0 + j0 + jj) * ZLD + zc]);
        const float o = siluf_(c0 * x0 + c1 * x1 + c2 * x2 + c3 * x3);
        x0 = x1; x1 = x2; x2 = x3;
        if (which == 0) qv[jj] = o; else if (which == 1) kv[jj] = o; else vb[(j0 + jj) * 72 + d] = f2bf(o);
      }
    }
    if (wv == 0) {
      const float be = sigmoidf_(bf2f(zbeta_raw));
      float lg = -__expf(p.gdn_alog[l * 4 + h]) * softplusf_(bf2f(za_raw) + p.gdn_dtb[l * 4 + h]);
#pragma unroll
      for (int o = 1; o < 64; o <<= 1) { const float n = __shfl_up(lg, o); if (lane >= o) lg += n; }
      betas[lane] = be; bcum[lane] = lg;
    }
    __syncthreads();
    const float bl = bcum[63];
#pragma unroll
    for (int jj = 0; jj < 16; ++jj) {
      const int j = j0 + jj;
      const float rq = rsqrtf(wave_sum(qv[jj] * qv[jj]) + EPS) * 0.125f;
      const float rk = rsqrtf(wave_sum(kv[jj] * kv[jj]) + EPS);
      const float qq = qv[jj] * rq, kk = kv[jj] * rk;
      qn[j * 72 + d] = f2bf(qq); kn[j * 72 + d] = f2bf(kk); kbm[j * 72 + d] = f2bf(kk * betas[j]);
      Qeff[j * 64 + d] = f2bf(qq * __expf(bcum[j]));
      KtT[d * 72 + j] = f2bf(kk * __expf(bl - bcum[j]));
    }
  }
  __syncthreads();
  const int wm = wv & 1, wn = wv >> 1, r = lane & 31, hh = lane >> 5;
  {
    f32x16 acc = mm32((const unsigned char*)(kbm + wm * 32 * 72), 144, (const unsigned char*)(kn + wn * 32 * 72), 144, 4, zero16(), r, hh);
    f32x16 acc2 = mm32((const unsigned char*)(qn + wm * 32 * 72), 144, (const unsigned char*)(kn + wn * 32 * 72), 144, 4, zero16(), r, hh);
    const int jc = wn * 32 + r; const float bj = bcum[jc];
    __syncthreads();
#pragma unroll
    for (int g = 0; g < 4; ++g)
#pragma unroll
      for (int k = 0; k < 4; ++k) {
        const int i = wm * 32 + 8 * g + 4 * hh + k;
        const float dec = (jc <= i) ? __expf(bcum[i] - bj) : 0.f;
        Mf[i * 64 + jc] = (jc < i) ? acc[4 * g + k] * dec : 0.f;
        aqk[i * 72 + jc] = f2bf(acc2[4 * g + k] * dec);
      }
  }
  __syncthreads();
  {
    const int c = tid & 127, j0 = (tid >> 7) * 32;
    const bf16* srcp = (c < 64) ? vb : kn;
    float xr[32];
#pragma unroll
    for (int j = 0; j < 32; ++j) { const float f = (c < 64) ? betas[j0 + j] : betas[j0 + j] * __expf(bcum[j0 + j]); xr[j] = bf2f(srcp[(j0 + j) * 72 + (c & 63)]) * f; }
    __syncthreads();
#pragma unroll
    for (int j = 0; j < 32; ++j) X[(j0 + j) * 128 + c] = xr[j];
  }
  __syncthreads();
  {
    const int g4 = lane >> 4, c16 = lane & 15;
#pragma unroll
    for (int I = 0; I < 4; ++I) {
      if (I > 0) {
        f32x4 acc0 = (f32x4){0.f, 0.f, 0.f, 0.f}, acc1 = acc0;
#pragma unroll
        for (int J = 0; J < I; ++J) {
#pragma unroll
          for (int kk = 0; kk < 4; ++kk) {
            const float av = Mf[(16 * I + c16) * 64 + 16 * J + 4 * kk + g4];
            const float b0 = X[(16 * J + 4 * kk + g4) * 128 + (2 * wv) * 16 + c16];
            const float b1 = X[(16 * J + 4 * kk + g4) * 128 + (2 * wv + 1) * 16 + c16];
            acc0 = __builtin_amdgcn_mfma_f32_16x16x4f32(av, b0, acc0, 0, 0, 0);
            acc1 = __builtin_amdgcn_mfma_f32_16x16x4f32(av, b1, acc1, 0, 0, 0);
          }
        }
#pragma unroll
        for (int r4 = 0; r4 < 4; ++r4) {
          X[(16 * I + 4 * g4 + r4) * 128 + (2 * wv) * 16 + c16] -= acc0[r4];
          X[(16 * I + 4 * g4 + r4) * 128 + (2 * wv + 1) * 16 + c16] -= acc1[r4];
        }
        __syncthreads();
      }
      if (tid < 128) {
        float x[16];
#pragma unroll
        for (int r4 = 0; r4 < 16; ++r4) x[r4] = X[(16 * I + r4) * 128 + tid];
#pragma unroll
        for (int r4 = 1; r4 < 16; ++r4) {
          const float* mr = Mf + (16 * I + r4) * 64 + 16 * I;
          float a0 = x[r4];
#pragma unroll
          for (int qb = 0; qb < (r4 + 3) / 4; ++qb) {
            const f32x4 m4 = *(const f32x4*)(mr + 4 * qb);
#pragma unroll
            for (int qq = 0; qq < 4; ++qq) if (4 * qb + qq < r4) a0 -= m4[qq] * x[4 * qb + qq];
          }
          x[r4] = a0;
        }
#pragma unroll
        for (int r4 = 0; r4 < 16; ++r4) X[(16 * I + r4) * 128 + tid] = x[r4];
      }
      __syncthreads();
    }
  }
  {
    float xr[64];
    const int c = tid & 127;
    if (tid < 128) {
#pragma unroll
      for (int j = 0; j < 64; ++j) xr[j] = X[j * 128 + c];
    }
    __syncthreads();
    if (tid < 128) {
      bf16* dst = (tid < 64 ? UT : WT) + (tid & 63) * 72;
#pragma unroll
      for (int j = 0; j < 64; j += 8) {
        u32x4 w; w.x = pk_bf16(xr[j], xr[j + 1]); w.y = pk_bf16(xr[j + 2], xr[j + 3]); w.z = pk_bf16(xr[j + 4], xr[j + 5]); w.w = pk_bf16(xr[j + 6], xr[j + 7]);
        *(u32x4*)(dst + j) = w;
      }
    }
  }
  __syncthreads();
  {
    const float bl = bcum[63];
    u32x2 qpre[4];
#pragma unroll
    for (int g = 0; g < 4; ++g) qpre[g] = *(const u32x2*)(Qeff + (wn * 32 + r) * 64 + wm * 32 + 8 * g + 4 * hh);
    f32x16 a1 = mm32((const unsigned char*)(WT + wm * 32 * 72), 144, (const unsigned char*)(aqk + wn * 32 * 72), 144, 4, zero16(), r, hh);
    f32x16 a2 = mm32((const unsigned char*)(UT + wm * 32 * 72), 144, (const unsigned char*)(aqk + wn * 32 * 72), 144, 4, zero16(), r, hh);
    f32x16 a3 = mm32((const unsigned char*)(WT + wm * 32 * 72), 144, (const unsigned char*)(KtT + wn * 32 * 72), 144, 4, zero16(), r, hh);
    f32x16 a4 = mm32((const unsigned char*)(KtT + wm * 32 * 72), 144, (const unsigned char*)(UT + wn * 32 * 72), 144, 4, zero16(), r, hh);
    const int cidx = wn * 32 + r;
    const float ebl = __expf(bl);
#pragma unroll
    for (int g = 0; g < 4; ++g) {
      const int rb = wm * 32 + 8 * g + 4 * hh;
      const u32x2 qraw = qpre[g];
      u32x2 w;
      w.x = pk_bf16(bflo(qraw.x) - a1[4 * g], bfhi(qraw.x) - a1[4 * g + 1]);
      w.y = pk_bf16(bflo(qraw.y) - a1[4 * g + 2], bfhi(qraw.y) - a1[4 * g + 3]);
      *(u32x2*)(Qeff + cidx * 64 + rb) = w;
      w.x = pk_bf16(a2[4 * g], a2[4 * g + 1]); w.y = pk_bf16(a2[4 * g + 2], a2[4 * g + 3]);
      *(u32x2*)(Oloc + cidx * 64 + rb) = w;
      f32x4 av;
#pragma unroll
      for (int k = 0; k < 4; ++k) av[k] = ((rb + k) == cidx ? ebl : 0.f) - a3[4 * g + k];
      *(f32x4*)(Ac + cidx * 64 + rb) = av;
      w.x = pk_bf16(a4[4 * g], a4[4 * g + 1]); w.y = pk_bf16(a4[4 * g + 2], a4[4 * g + 3]);
      *(u32x2*)(BT + cidx * 64 + rb) = w;
    }
  }
  __syncthreads();
}

DI void gdn_scan_item(const Params& p, int b, int h, int es, unsigned char* lds, int tid) {
  const float* AcB = (const float*)(p.ws + OFF_AR + AR_ACD);
  bf16* BTB = (bf16*)(p.ws + OFF_AR + AR_BTD);
  const int lane = tid & 63, w = tid >> 6, g = lane >> 4, c16 = lane & 15;
  float* stl = (float*)lds;
  for (int i = tid; i < 2 * 16 * 68; i += 256) stl[i] = 0.f;
  __syncthreads();
  f32x4 cur = (f32x4){0.f, 0.f, 0.f, 0.f};
  f32x4 bq[4][4]; bf16 bt[4][4];
  const size_t ci0 = ((size_t)(b * 128) * 4 + h);
  const float* apb = AcB + ci0 * 4096 + (16 * w + c16) * 64 + 16 * g;
  bf16* btb = BTB + ci0 * 4096 + (es * 16 + 4 * g) * 64 + 16 * w + c16;
#pragma unroll
  for (int s4 = 0; s4 < 4; ++s4) {
#pragma unroll
    for (int k = 0; k < 4; ++k) bq[s4][k] = *(const f32x4*)(apb + (size_t)s4 * 4 * 4096 + 4 * k);
#pragma unroll
    for (int k = 0; k < 4; ++k) bt[s4][k] = btb[(size_t)s4 * 4 * 4096 + k * 64];
  }
  for (int c0 = 0; c0 < 128; c0 += 4) {
    const bool pf = (c0 + 4 < 128);
#pragma unroll
    for (int s4 = 0; s4 < 4; ++s4) {
      const int c = c0 + s4;
      const size_t co = (size_t)c * 4 * 4096;
#pragma unroll
      for (int k = 0; k < 4; ++k) btb[co + k * 64] = f2bf(cur[k]);
      const float* sc = stl + (s4 & 1) * 16 * 68;
      f32x4 aq[4];
#pragma unroll
      for (int k = 0; k < 4; ++k) aq[k] = *(const f32x4*)(sc + c16 * 68 + 16 * g + 4 * k);
      f32x4 acc[4];
      acc[0] = (f32x4){bf2f(bt[s4][0]), bf2f(bt[s4][1]), bf2f(bt[s4][2]), bf2f(bt[s4][3])};
      acc[1] = (f32x4){0.f, 0.f, 0.f, 0.f}; acc[2] = acc[1]; acc[3] = acc[1];
#pragma unroll
      for (int q = 0; q < 4; ++q)
#pragma unroll
        for (int k = 0; k < 4; ++k) acc[k] = __builtin_amdgcn_mfma_f32_16x16x4f32(aq[k][q], bq[s4][k][q], acc[k], 0, 0, 0);
      cur = (acc[0] + acc[1]) + (acc[2] + acc[3]);
      if (pf) {
#pragma unroll
        for (int k = 0; k < 4; ++k) bq[s4][k] = *(const f32x4*)(apb + co + (size_t)4 * 4 * 4096 + 4 * k);
#pragma unroll
        for (int k = 0; k < 4; ++k) bt[s4][k] = btb[co + (size_t)4 * 4 * 4096 + k * 64];
      }
      float* sn = stl + ((s4 + 1) & 1) * 16 * 68;
#pragma unroll
      for (int k = 0; k < 4; ++k) sn[(4 * g + k) * 68 + 16 * w + c16] = cur[k];
      __syncthreads();
    }
  }
}

DI void gdn_out_item(const Params& p, int l, int ci, unsigned char* lds, int tid) {
  const bf16* z = (const bf16*)(p.ws + OFF_AR + AR_Z);
  const bf16* ST = (const bf16*)(p.ws + OFF_AR + AR_BTD) + (size_t)ci * 4096;
  const bf16* Qeff = (const bf16*)(p.ws + OFF_AR + AR_QEFF) + (size_t)ci * 4096;
  const bf16* Oloc = (const bf16*)(p.ws + OFF_AR + AR_OLOC) + (size_t)ci * 4096;
  bf16* mix = (bf16*)(p.ws + OFF_AR + AR_MIX);
  const int h = ci & 3, t0 = (ci >> 2) * 64;
  float* obuf = (float*)lds;
  unsigned char* ql = lds + 17408;
  unsigned char* sl = ql + 9216;
  const u32x4* gpre = (const u32x4*)(z + (size_t)(t0 + (tid >> 2)) * ZLD + ZD_Z + h * 64 + (tid & 3) * 16);
  const u32x4 gq0 = gpre[0], gq1 = gpre[1];
  const u32x4* apre = (const u32x4*)(Oloc + (tid >> 2) * 64 + (tid & 3) * 16);
  const u32x4 aq0 = apre[0], aq1 = apre[1];
#pragma unroll
  for (int id = tid; id < 512; id += 256) {
    const int rr = id >> 3, ch = id & 7;
    *(u32x4*)(ql + rr * 144 + ch * 16) = *(const u32x4*)(Qeff + rr * 64 + ch * 8);
    *(u32x4*)(sl + rr * 144 + ch * 16) = *(const u32x4*)(ST + rr * 64 + ch * 8);
  }
  __syncthreads();
  const int lane = tid & 63, wv = tid >> 6, wm = wv & 1, wn = wv >> 1, r = lane & 31, hh = lane >> 5;
  {
    f32x16 acc = mm32(ql + wm * 32 * 144, 144, sl + wn * 32 * 144, 144, 4, zero16(), r, hh);
    const int e = wn * 32 + r;
#pragma unroll
    for (int g = 0; g < 4; ++g)
#pragma unroll
      for (int k = 0; k < 4; ++k) obuf[(wm * 32 + 8 * g + 4 * hh + k) * 68 + e] = acc[4 * g + k];
  }
  __syncthreads();
  norm_gate_store<false>(obuf, true, aq0, aq1, p.gdn_ng + l * 64, gq0, gq1, mix + (size_t)t0 * 1024 + 768 + h * 64, tid);
  __syncthreads();
}

DI void mla_proj_item(const Params& p, int l, int tile, unsigned char* lds, int tid) {
  const bf16* z = (const bf16*)(p.ws + OFF_AR + AR_Z);
  const bf16* Wl = (const bf16*)(p.ws + OFF_W) + (size_t)l * WL_E;
  const bf16* Wuq = Wl + WO_UQ;
  const bf16* Wukv = Wl + WO_UKV;
  bf16* Qg = (bf16*)(p.ws + OFF_AR + AR_Q);
  bf16* Kg = (bf16*)(p.ws + OFF_AR + AR_K);
  bf16* Vt = (bf16*)(p.ws + OFF_AR + AR_VT);
  const int t0 = tile * 64, b = t0 / S_, s0 = t0 % S_;
  unsigned char* Aq = lds;
  unsigned char* Akv = lds + 33792;
  float* rsq = (float*)(lds + 33792 + 17408);
  float* rskv = rsq + 64;
#pragma unroll
  for (int id = tid; id < 64 * 32; id += 256) { const int rr = id >> 5, ch = id & 31; *(u32x4*)(Aq + rr * 528 + ch * 16) = *(const u32x4*)(z + (size_t)(t0 + rr) * ZLD + ZC_Q + ch * 8); }
#pragma unroll
  for (int id = tid; id < 64 * 16; id += 256) { const int rr = id >> 4, ch = id & 15; *(u32x4*)(Akv + rr * 272 + ch * 16) = *(const u32x4*)(z + (size_t)(t0 + rr) * ZLD + ZC_KV + ch * 8); }
  __syncthreads();
  {
    const int rr = tid >> 2, qd = tid & 3;
    float s1 = 0.f, s2 = 0.f;
#pragma unroll
    for (int k = 0; k < 8; ++k) { const u32x4 u = *(const u32x4*)(Aq + rr * 528 + qd * 128 + k * 16);
#pragma unroll
      for (int i = 0; i < 4; ++i) { const float a = bflo(u[i]), b = bfhi(u[i]); s1 += a * a + b * b; } }
#pragma unroll
    for (int k = 0; k < 4; ++k) { const u32x4 u = *(const u32x4*)(Akv + rr * 272 + qd * 64 + k * 16);
#pragma unroll
      for (int i = 0; i < 4; ++i) { const float a = bflo(u[i]), b = bfhi(u[i]); s2 += a * a + b * b; } }
    s1 += __shfl_xor(s1, 1); s1 += __shfl_xor(s1, 2); s2 += __shfl_xor(s2, 1); s2 += __shfl_xor(s2, 2);
    if (qd == 0) { rsq[rr] = rsqrtf(s1 * (1.f / 256.f) + EPS); rskv[rr] = rsqrtf(s2 * (1.f / 128.f) + EPS); }
#pragma unroll
    for (int id = tid; id < 1024; id += 256) {
      const int m = id >> 4, i = id & 15;
      const float inv = __builtin_amdgcn_exp2f(-(float)i * (13.287712379549449f / 16.f));
      const float ang = (float)(s0 + m) * inv;
      const double rev = (double)ang * 0.15915494309189535;
      const float fr = (float)(rev - floor(rev));
      const float sn = __builtin_amdgcn_sinf(fr), cs = __builtin_amdgcn_cosf(fr);
      const float x1 = bf2f(z[(size_t)(t0 + m) * ZLD + ZC_KR + i]), x2 = bf2f(z[(size_t)(t0 + m) * ZLD + ZC_KR + 16 + i]);
      const bf16 o1 = f2bf(x1 * cs - x2 * sn), o2 = f2bf(x2 * cs + x1 * sn);
      { bf16* krl = (bf16*)(lds + 51712); krl[m * 32 + i] = o1; krl[m * 32 + 16 + i] = o2; }
    }
  }
  __syncthreads();
  const int lane = tid & 63, hd = tid >> 6, r = lane & 31, hh = lane >> 5;
  const float QS = 0.10206207261596575f * 1.4426950408889634f;
  {
    f32x16 acc[3][2];
#pragma unroll
    for (int i = 0; i < 3; ++i) { acc[i][0] = zero16(); acc[i][1] = zero16(); }
#pragma unroll 4
    for (int kk = 0; kk < 16; ++kk) {
      bf16x8 af[2], bw[3];
#pragma unroll
      for (int mi = 0; mi < 2; ++mi) af[mi] = *(const bf16x8*)(Aq + (mi * 32 + r) * 528 + kk * 32 + hh * 16);
#pragma unroll
      for (int ni = 0; ni < 3; ++ni) bw[ni] = *(const bf16x8*)(Wuq + ((size_t)(((hd * 16 + kk) * 3 + ni) * 64 + lane)) * 8);
#pragma unroll
      for (int ni = 0; ni < 3; ++ni)
#pragma unroll
        for (int mi = 0; mi < 2; ++mi) acc[ni][mi] = MFMA32(bw[ni], af[mi], acc[ni][mi]);
    }
    __syncthreads();
    unsigned char* wbuf = lds + hd * 6400;
#pragma unroll
    for (int mi = 0; mi < 2; ++mi) {
      const int m = mi * 32 + r;
      const float sc = rsq[m] * QS;
      bf16* qp = (bf16*)(wbuf + r * 200);
#pragma unroll
      for (int ni = 0; ni < 2; ++ni)
#pragma unroll
        for (int g = 0; g < 4; ++g) {
          u32x2 w; w.x = pk_bf16(acc[ni][mi][4 * g] * sc, acc[ni][mi][4 * g + 1] * sc); w.y = pk_bf16(acc[ni][mi][4 * g + 2] * sc, acc[ni][mi][4 * g + 3] * sc);
          *(u32x2*)(qp + ni * 32 + 8 * g + 4 * hh) = w;
        }
#pragma unroll
      for (int g = 0; g < 2; ++g) {
        float o1[4], o2[4];
#pragma unroll
        for (int k = 0; k < 4; ++k) {
          const int i = 8 * g + 4 * hh + k;
          const float inv = __builtin_amdgcn_exp2f(-(float)i * (13.287712379549449f / 16.f));
          const float ang = (float)(s0 + m) * inv;
          const double rev = (double)ang * 0.15915494309189535;
          const float fr = (float)(rev - floor(rev));
          const float sn = __builtin_amdgcn_sinf(fr), cs = __builtin_amdgcn_cosf(fr);
          const float x1 = acc[2][mi][4 * g + k] * sc, x2 = acc[2][mi][4 * (g + 2) + k] * sc;
          o1[k] = x1 * cs - x2 * sn; o2[k] = x2 * cs + x1 * sn;
        }
        u32x2 w; w.x = pk_bf16(o1[0], o1[1]); w.y = pk_bf16(o1[2], o1[3]);
        *(u32x2*)(qp + 64 + 8 * g + 4 * hh) = w;
        w.x = pk_bf16(o2[0], o2[1]); w.y = pk_bf16(o2[2], o2[3]);
        *(u32x2*)(qp + 80 + 8 * g + 4 * hh) = w;
      }
#pragma unroll
      for (int k = 0; k < 6; ++k) {
        const int id = lane + 64 * k, row = id / 12, ch = id % 12;
        const u32x2 lo = *(const u32x2*)(wbuf + row * 200 + ch * 16), hi = *(const u32x2*)(wbuf + row * 200 + ch * 16 + 8);
        *(u32x4*)(Qg + ((size_t)(b * 4 + hd) * S_ + s0 + mi * 32 + row) * 96 + ch * 8) = (u32x4){lo.x, lo.y, hi.x, hi.y};
      }
    }
  }
  {
    f32x16 acc[2][2];
#pragma unroll
    for (int i = 0; i < 2; ++i) { acc[i][0] = zero16(); acc[i][1] = zero16(); }
#pragma unroll
    for (int kk = 0; kk < 8; ++kk) {
      bf16x8 af[2], bw[2];
#pragma unroll
      for (int mi = 0; mi < 2; ++mi) af[mi] = *(const bf16x8*)(Akv + (mi * 32 + r) * 272 + kk * 32 + hh * 16);
#pragma unroll
      for (int ni = 0; ni < 2; ++ni) bw[ni] = *(const bf16x8*)(Wukv + ((size_t)((((hd * 2 + 0) * 8 + kk) * 2 + ni) * 64 + lane)) * 8);
#pragma unroll
      for (int ni = 0; ni < 2; ++ni)
#pragma unroll
        for (int mi = 0; mi < 2; ++mi) acc[ni][mi] = MFMA32(bw[ni], af[mi], acc[ni][mi]);
    }
    unsigned char* wbuf = lds + hd * 6400;
    const unsigned char* krl = lds + 51712;
#pragma unroll
    for (int mi = 0; mi < 2; ++mi) {
      const int m = mi * 32 + r;
      const float sc = rskv[m];
      bf16* kp = (bf16*)(wbuf + r * 200);
#pragma unroll
      for (int ni = 0; ni < 2; ++ni)
#pragma unroll
        for (int g = 0; g < 4; ++g) {
          u32x2 w; w.x = pk_bf16(acc[ni][mi][4 * g] * sc, acc[ni][mi][4 * g + 1] * sc); w.y = pk_bf16(acc[ni][mi][4 * g + 2] * sc, acc[ni][mi][4 * g + 3] * sc);
          *(u32x2*)(kp + ni * 32 + 8 * g + 4 * hh) = w;
        }
#pragma unroll
      for (int k = 0; k < 6; ++k) {
        const int id = lane + 64 * k, row = id / 12, ch = id % 12;
        const unsigned char* src = (ch < 8) ? (wbuf + row * 200 + ch * 16) : (krl + (mi * 32 + row) * 64 + (ch - 8) * 16);
        const u32x2 lo = *(const u32x2*)src, hi = *(const u32x2*)(src + 8);
        *(u32x4*)(Kg + ((size_t)(b * 4 + hd) * S_ + s0 + mi * 32 + row) * 96 + ch * 8) = (u32x4){lo.x, lo.y, hi.x, hi.y};
      }
    }
  }
  {
    f32x16 acc[2][2];
#pragma unroll
    for (int i = 0; i < 2; ++i) { acc[i][0] = zero16(); acc[i][1] = zero16(); }
#pragma unroll
    for (int kk = 0; kk < 8; ++kk) {
      bf16x8 af[2], bw[2];
#pragma unroll
      for (int mi = 0; mi < 2; ++mi) af[mi] = *(const bf16x8*)(Akv + (mi * 32 + r) * 272 + kk * 32 + hh * 16);
#pragma unroll
      for (int ni = 0; ni < 2; ++ni) bw[ni] = *(const bf16x8*)(Wukv + ((size_t)((((hd * 2 + 1) * 8 + kk) * 2 + ni) * 64 + lane)) * 8);
#pragma unroll
      for (int mi = 0; mi < 2; ++mi)
#pragma unroll
        for (int ni = 0; ni < 2; ++ni) acc[mi][ni] = MFMA32(af[mi], bw[ni], acc[mi][ni]);
    }
#pragma unroll
    for (int ni = 0; ni < 2; ++ni) {
      bf16* vp = Vt + ((size_t)(b * 4 + hd) * 64 + ni * 32 + r) * S_ + s0;
#pragma unroll
      for (int mi = 0; mi < 2; ++mi)
#pragma unroll
        for (int g = 0; g < 4; ++g) {
          const int m = mi * 32 + 8 * g + 4 * hh;
          u32x2 w; w.x = pk_bf16(acc[mi][ni][4 * g] * rskv[m], acc[mi][ni][4 * g + 1] * rskv[m + 1]); w.y = pk_bf16(acc[mi][ni][4 * g + 2] * rskv[m + 2], acc[mi][ni][4 * g + 3] * rskv[m + 3]);
          *(u32x2*)(vp + m) = w;
        }
    }
  }
  __syncthreads();
}

DI void attn_item(const Params& p, int bh, int qb, unsigned char* lds, int tid) {
  const bf16* Qg = (const bf16*)(p.ws + OFF_AR + AR_Q) + (size_t)bh * S_ * 96;
  const bf16* Kg = (const bf16*)(p.ws + OFF_AR + AR_K) + (size_t)bh * S_ * 96;
  const bf16* Vt = (const bf16*)(p.ws + OFF_AR + AR_VT) + (size_t)bh * 64 * S_;
  bf16* mix = (bf16*)(p.ws + OFF_AR + AR_MIX);
  const int lane = tid & 63, w = tid >> 6, r = lane & 31, hh = lane >> 5;
  const int q0 = qb * 128, qrow = q0 + 32 * w + r;
  const int ntiles = 2 * qb + 2;
  constexpr int STG = 64 * 208 + 64 * 144;
  bf16x8 qf[6];
#pragma unroll
  for (int kk = 0; kk < 6; ++kk) qf[kk] = *(const bf16x8*)(Qg + (size_t)qrow * 96 + kk * 16 + hh * 8);
  f32x16 ot[2] = {zero16(), zero16()};
  float mrun = -1e30f, lrun = 0.f;
  u32x4 rk[3], rv[2];
  int krow[3], kch[3];
#pragma unroll
  for (int i = 0; i < 3; ++i) { const int id = tid + 256 * i; krow[i] = id / 12; kch[i] = id % 12; }
  const int vrow0 = tid >> 3, vch = tid & 7;
#pragma unroll
  for (int i = 0; i < 3; ++i) rk[i] = *(const u32x4*)(Kg + (size_t)krow[i] * 96 + kch[i] * 8);
#pragma unroll
  for (int i = 0; i < 2; ++i) rv[i] = *(const u32x4*)(Vt + (size_t)(vrow0 + 32 * i) * S_ + vch * 8);
  __syncthreads();
#pragma unroll
  for (int i = 0; i < 3; ++i) *(u32x4*)(lds + krow[i] * 208 + kch[i] * 16) = rk[i];
#pragma unroll
  for (int i = 0; i < 2; ++i) *(u32x4*)(lds + 13312 + (vrow0 + 32 * i) * 144 + vch * 16) = rv[i];
  __syncthreads();
  for (int kt = 0; kt < ntiles; ++kt) {
    const unsigned char* Ks = lds + (kt & 1) * STG;
    const unsigned char* Vs = Ks + 13312;
    if (kt + 1 < ntiles) {
#pragma unroll
      for (int i = 0; i < 3; ++i) rk[i] = *(const u32x4*)(Kg + (size_t)((kt + 1) * 64 + krow[i]) * 96 + kch[i] * 8);
#pragma unroll
      for (int i = 0; i < 2; ++i) rv[i] = *(const u32x4*)(Vt + (size_t)(vrow0 + 32 * i) * S_ + (kt + 1) * 64 + vch * 8);
    }
    if (kt * 64 <= q0 + 32 * w + 31) {
      f32x16 st[2];
#pragma unroll
      for (int k2 = 0; k2 < 2; ++k2) {
        st[k2] = zero16();
#pragma unroll
        for (int kk = 0; kk < 6; ++kk) {
          bf16x8 kf = *(const bf16x8*)(Ks + (k2 * 32 + r) * 208 + kk * 32 + hh * 16);
          st[k2] = MFMA32(kf, qf[kk], st[k2]);
        }
      }
      if (kt * 64 + 63 > q0 + 32 * w) {
#pragma unroll
        for (int k2 = 0; k2 < 2; ++k2)
#pragma unroll
          for (int g = 0; g < 4; ++g)
#pragma unroll
            for (int k = 0; k < 4; ++k) {
              const int key = kt * 64 + k2 * 32 + 8 * g + 4 * hh + k;
              if (key > qrow) st[k2][4 * g + k] = -1e30f;
            }
      }
      float mt = st[0][0];
#pragma unroll
      for (int k2 = 0; k2 < 2; ++k2)
#pragma unroll
        for (int i = 0; i < 16; ++i) mt = fmaxf(mt, st[k2][i]);
      mt = fmaxf(mt, __shfl_xor(mt, 32));
      const float mnew = fmaxf(mrun, mt);
      const float alpha = __builtin_amdgcn_exp2f(mrun - mnew);
      mrun = mnew;
      float ls = 0.f;
#pragma unroll
      for (int k2 = 0; k2 < 2; ++k2)
#pragma unroll
        for (int i = 0; i < 16; ++i) { const float pv = __builtin_amdgcn_exp2f(st[k2][i] - mnew); st[k2][i] = pv; ls += pv; }
      lrun = lrun * alpha + ls;
      if (__any(alpha != 1.f)) {
#pragma unroll
        for (int dt = 0; dt < 2; ++dt)
#pragma unroll
          for (int i = 0; i < 16; ++i) ot[dt][i] *= alpha;
      }
#pragma unroll
      for (int k2 = 0; k2 < 2; ++k2)
#pragma unroll
        for (int s = 0; s < 2; ++s) {
          u32x4 pw;
          pw.x = pk_bf16(st[k2][8 * s], st[k2][8 * s + 1]); pw.y = pk_bf16(st[k2][8 * s + 2], st[k2][8 * s + 3]);
          pw.z = pk_bf16(st[k2][8 * s + 4], st[k2][8 * s + 5]); pw.w = pk_bf16(st[k2][8 * s + 6], st[k2][8 * s + 7]);
          const bf16x8 pf = __builtin_bit_cast(bf16x8, pw);
#pragma unroll
          for (int dt = 0; dt < 2; ++dt) {
            const unsigned char* vp = Vs + (dt * 32 + r) * 144 + (k2 * 32 + s * 16 + 4 * hh) * 2;
            u32x2 v0 = *(const u32x2*)vp, v1 = *(const u32x2*)(vp + 16);
            u32x4 vw = (u32x4){v0.x, v0.y, v1.x, v1.y};
            ot[dt] = MFMA32(__builtin_bit_cast(bf16x8, vw), pf, ot[dt]);
          }
        }
    }
    if (kt + 1 < ntiles) {
      unsigned char* Kw = lds + ((kt + 1) & 1) * STG;
#pragma unroll
      for (int i = 0; i < 3; ++i) *(u32x4*)(Kw + krow[i] * 208 + kch[i] * 16) = rk[i];
#pragma unroll
      for (int i = 0; i < 2; ++i) *(u32x4*)(Kw + 13312 + (vrow0 + 32 * i) * 144 + vch * 16) = rv[i];
    }
    __syncthreads();
  }
  const float lt = lrun + __shfl_xor(lrun, 32);
  const float inv = 1.f / lt;
  const int b = bh >> 2, hd = bh & 3;
  bf16* op = mix + ((size_t)b * S_ + qrow) * 1024 + 512 + hd * 64;
#pragma unroll
  for (int dt = 0; dt < 2; ++dt)
#pragma unroll
    for (int g = 0; g < 4; ++g) {
      u32x2 wv; wv.x = pk_bf16(ot[dt][4 * g] * inv, ot[dt][4 * g + 1] * inv); wv.y = pk_bf16(ot[dt][4 * g + 2] * inv, ot[dt][4 * g + 3] * inv);
      *(u32x2*)(op + dt * 32 + 8 * g + 4 * hh) = wv;
    }
}

DI void grid_bar(unsigned* flags, unsigned k) {
  asm volatile("s_waitcnt vmcnt(0) lgkmcnt(0)" ::: "memory");
  __syncthreads();
  if (threadIdx.x == 0) { __threadfence(); __hip_atomic_store(flags + blockIdx.x, k, __ATOMIC_RELAXED, __HIP_MEMORY_SCOPE_AGENT); }
  const unsigned nb = gridDim.x;
  for (;;) {
    int ok = 1;
    for (unsigned i = threadIdx.x; i < nb; i += blockDim.x) ok &= (__hip_atomic_load(flags + i, __ATOMIC_RELAXED, __HIP_MEMORY_SCOPE_AGENT) >= k) ? 1 : 0;
    if (__syncthreads_and(ok)) break;
    __builtin_amdgcn_s_sleep(1);
  }
  if (threadIdx.x == 0) __threadfence();
  __syncthreads();
}
__global__ void __launch_bounds__(512, 2) fwd_megakernel(Params p0) {
  extern __shared__ __attribute__((aligned(16))) unsigned char lds_all[];
  __shared__ int s_item;
  cg::grid_group grid = cg::this_grid();
  unsigned nbar = 0;
  const int nvb = gridDim.x * 2;
#define GBAR() do { nbar += 1; grid_bar((unsigned*)(p0.ws + OFF_CTL) + 256, nbar); } while (0)
#define PH_BEGIN() Params q = p0; { unsigned long long w_ = (unsigned long long)q.ws; asm volatile("" : "+s"(w_)); q.ws = (unsigned char*)w_; } int tid5 = threadIdx.x; asm volatile("" : "+v"(tid5)); const int tid = tid5 & 255, half = tid5 >> 8, vb = blockIdx.x * 2 + half; unsigned char* lds = lds_all + half * LDS_HALF; (void)vb; (void)lds; \
  unsigned char* ws = q.ws; bf16* W = (bf16*)(ws + OFF_W); float* rs = (float*)(ws + OFF_RS); bf16* zb = (bf16*)(ws + OFF_AR + AR_Z); bf16* yb = (bf16*)(ws + OFF_AR + AR_Y); \
  bf16* up = (bf16*)(ws + OFF_AR + AR_UP); bf16* mix = (bf16*)(ws + OFF_AR + AR_MIX); bf16* xb = mix; unsigned* ctl = (unsigned*)(ws + OFF_CTL); \
  const bf16* Wl = W + (size_t)l * WL_E; (void)rs; (void)zb; (void)yb; (void)up; (void)mix; (void)xb; (void)ctl; (void)Wl; (void)tid; (void)tid5;
  { const int l = 0; PH_BEGIN(); phase0(q, lds, tid, half); }
  { const int l = 0; PH_BEGIN(); resid_phase(q.x, nullptr, nullptr, nullptr, nullptr, xb, rs, tid, vb, nvb); }
  if (p0.ws == nullptr) grid.sync();
  GBAR();

  for (int l = 0; l < 2; ++l) {
    { PH_BEGIN(); EpiStore e{zb, zb, 1 << 30, ZLD, rs, nullptr}; gemm_phase<false>(l == 0 ? xb : (const bf16*)q.out, 1024, Wl + WO_IN, 1024, 1024, 128, 13, e, lds_all, tid5); }
    GBAR();
    for (int pi = blockIdx.x; pi < (2048 * 3 + 512) / 2; pi += gridDim.x) {
      PH_BEGIN();
      const int it = 2 * pi + half;
      if (it < 2048) gdn_local_item(q, l, it, lds, tid);
      else if (it < 4096) gla_local_item<64, true>(q, l, it - 2048, lds, tid);
      else if (it < 6144) gla_local_item<32, false>(q, l, it - 4096, lds, tid);
      else mla_proj_item(q, l, it - 6144, lds, tid);
    }
    GBAR();
    for (;;) {
      PH_BEGIN();
      if (tid5 == 0) s_item = (int)atomicAdd(&ctl[l], 1u);
      __syncthreads();
      const int pit = s_item;
      __syncthreads();
      if (pit >= 80 + 512) break;
      if (pit < 32) { const int it = 2 * pit + half; gdn_scan_item(q, it >> 4, (it >> 2) & 3, it & 3, lds, tid); }
      else if (pit < 64) { const int j = 2 * (pit - 32) + half; gla_scan_item<64>((bf16*)(ws + OFF_AR + AR_UTA), (const float*)(ws + OFF_GA), j >> 4, (j >> 2) & 3, j & 3, tid); }
      else if (pit < 80) { const int j = 2 * (pit - 64) + half; gla_scan_item<32>((bf16*)(ws + OFF_AR + AR_UTB), (const float*)(ws + OFF_GB), j >> 3, (j >> 1) & 3, j & 1, tid); }
      else { const int a = pit - 80; attn_item(q, 2 * (a & 7) + half, 63 - (a >> 3), lds, tid); }
    }
    GBAR();
    for (int pi = blockIdx.x; pi < 2048 * 3 / 2; pi += gridDim.x) {
      PH_BEGIN();
      const int it = 2 * pi + half;
      if (it < 2048) gdn_out_item(q, l, it, lds, tid);
      else if (it < 4096) gla_out_item<64, true>(q, l, it - 2048, lds, tid);
      else gla_out_item<32, false>(q, l, it - 4096, lds, tid);
    }
    GBAR();
    { PH_BEGIN(); EpiStore e{yb, yb, 1 << 30, 1024, nullptr, nullptr}; gemm_phase<false>(mix, 1024, Wl + WO_OUT, 1024, 1024, 128, 4, e, lds_all, tid5); }
    GBAR();
    { PH_BEGIN(); resid_phase(l == 0 ? q.x : nullptr, (const bf16*)q.out, yb, q.post_mix_g + l * 1024, nullptr, xb, rs, tid, vb, nvb); }
    GBAR();
    { PH_BEGIN(); EpiStore e{up, up, 1 << 30, FF, rs, q.ffn_conv + (size_t)l * 3 * FF}; gemm_phase<true>(xb, 1024, Wl + WO_GU, 1024, 1024, 136, 22, e, lds_all, tid5); }
    GBAR();
    { PH_BEGIN(); EpiStore e{yb, yb, 1 << 30, 1024, nullptr, nullptr}; gemm_phase<false>(up, FF, Wl + WO_DN, FF, FF, 128, 4, e, lds_all, tid5); }
    GBAR();
    { PH_BEGIN(); resid_phase(nullptr, xb, yb, q.post_ffn_g + l * 1024, l == 1 ? q.out : nullptr, l == 1 ? nullptr : (bf16*)q.out, rs, tid, vb, nvb); }
    GBAR();
  }
}

extern "C" void kernel_launch(void* const* d_in, const int* in_sizes, int n_in, void* d_out, int out_size, void* d_ws, size_t ws_size, hipStream_t stream) {
  static int grid_blocks = 0;
  if (!grid_blocks) {
    int dev = 0, cus = 0, per_cu = 0;
    hipGetDevice(&dev);
    hipDeviceGetAttribute(&cus, hipDeviceAttributeMultiprocessorCount, dev);
    hipFuncSetAttribute((const void*)fwd_megakernel, hipFuncAttributeMaxDynamicSharedMemorySize, LDS_BYTES);
    hipOccupancyMaxActiveBlocksPerMultiprocessor(&per_cu, (const void*)fwd_megakernel, 512, LDS_BYTES);
    if (per_cu < 1) per_cu = 1;
    if (per_cu > 1) per_cu = 1;
    grid_blocks = cus * per_cu;
    if (ws_size < WS_END) fprintf(stderr, "kernel_launch: workspace too small: %zu < %zu\n", ws_size, (size_t)WS_END);
  }
  Params p{};
  const float** pp = (const float**)&p;
  for (int i = 0; i < 24; ++i) pp[i] = (const float*)d_in[i];
  p.out = (float*)d_out; p.ws = (unsigned char*)d_ws;
  hipMemsetAsync((unsigned char*)d_ws + OFF_CTL, 0, 8192, stream);
  void* args[] = {&p};
  hipError_t e = hipLaunchCooperativeKernel((const void*)fwd_megakernel, dim3(grid_blocks), dim3(512), args, LDS_BYTES, stream);
  if (e != hipSuccess) fprintf(stderr, "cooperative launch failed: %s (grid %d)\n", hipGetErrorString(e), grid_blocks);
}
```

```cpp
#include <hip/hip_runtime.h>
#include <hip/hip_cooperative_groups.h>
#include <cstdio>
#include <cstdint>
namespace cg = cooperative_groups;

#define DI __device__ __forceinline__
typedef unsigned short bf16;
typedef __attribute__((ext_vector_type(8))) short bf16x8;
typedef __attribute__((ext_vector_type(4))) short bf16x4;
typedef __attribute__((ext_vector_type(16))) float f32x16;
typedef __attribute__((ext_vector_type(4))) float f32x4;
typedef __attribute__((ext_vector_type(4))) unsigned u32x4;
typedef __attribute__((ext_vector_type(2))) unsigned u32x2;

constexpr int T_ = 32768, S_ = 8192, D_ = 1024, ZLD = 3328, FF = 2816, DIN = 3256;
constexpr float EPS = 1e-6f;
constexpr int ZA_Q = 0, ZA_F = 256, ZA_I = 512, ZA_G = 768, ZB_Q = 1024, ZB_K = 1152, ZB_V = 1280, ZB_G = 1536, ZC_Q = 1792, ZC_KV = 2048,
              ZD_Q = 2176, ZD_K = 2432, ZD_V = 2688, ZD_Z = 2944, ZC_KR = 3200, ZB_CODE = 3232, ZD_BETA = 3248, ZD_A = 3252;
constexpr size_t WIN_E = (size_t)ZLD * 1024, WOUT_E = 1024 * 1024, WGU_E = (size_t)2 * FF * 1024, WDN_E = (size_t)1024 * FF, WUQ_E = 384 * 256, WUKV_E = 512 * 128;
constexpr size_t WO_IN = 0, WO_OUT = WO_IN + WIN_E, WO_GU = WO_OUT + WOUT_E, WO_DN = WO_GU + WGU_E, WO_UQ = WO_DN + WDN_E, WO_UKV = WO_UQ + WUQ_E, WL_E = WO_UKV + WUKV_E;
constexpr size_t OFF_W = 0;
constexpr size_t OFF_CTL = OFF_W + 2 * WL_E * 2;
constexpr size_t OFF_RS = OFF_CTL + 8192;
constexpr size_t OFF_GA = OFF_RS + (size_t)T_ * 4;
constexpr size_t OFF_GB = OFF_GA + (size_t)2048 * 64 * 4;
constexpr size_t OFF_AR = OFF_GB + (size_t)2048 * 32 * 4;
constexpr size_t AR_Z = 0, AR_Y = 0, AR_GATE = 0, AR_UP = (size_t)T_ * FF * 2;
constexpr size_t AR_SCAN = (size_t)T_ * ZLD * 2;
constexpr size_t AR_UTA = AR_SCAN, AR_UTB = AR_UTA + (size_t)2048 * 64 * 64 * 2, AR_ACD = AR_UTB + (size_t)2048 * 64 * 32 * 2, AR_BTD = AR_ACD + (size_t)2048 * 4096 * 4,
                 AR_QEFF = AR_BTD + (size_t)2048 * 4096 * 2, AR_OLOC = AR_QEFF + (size_t)2048 * 4096 * 2, AR_MLA = AR_OLOC + (size_t)2048 * 4096 * 2;
constexpr size_t AR_Q = AR_MLA, AR_K = AR_Q + (size_t)T_ * 4 * 96 * 2, AR_VT = AR_K + (size_t)T_ * 4 * 96 * 2, AR_MIX = AR_VT + (size_t)T_ * 4 * 64 * 2;
constexpr size_t AR_END = AR_MIX + (size_t)T_ * 1024 * 2;
constexpr size_t WS_END = OFF_AR + AR_END;
static_assert(WS_END <= (size_t)512 * 1024 * 1024, "workspace too large");
static_assert(AR_UP + (size_t)T_ * FF * 2 <= AR_MIX, "gate/up overlaps xb");

constexpr size_t BC_OFF = (size_t)T_ * 1024 * 2, BC_B_OFF = (size_t)2048 * 64 * 64 * 4;
static_assert(BC_OFF + BC_B_OFF + (size_t)2048 * 64 * 32 * 4 <= (size_t)T_ * 1024 * 4, "decay tables exceed the output buffer");
constexpr int LDS_HALF = 73728, LDS_BYTES = 2 * LDS_HALF;
#ifndef PROBE_DUP
#define PROBE_DUP 0
#endif

struct Params {
  const float* x; const float* w_in; const float* w_out; const float* pre_mix_g; const float* post_mix_g; const float* pre_ffn_g; const float* post_ffn_g;
  const float* hgrn_lb; const float* hgrn_ng; const float* gla_w2; const float* gla_b; const float* gla_ng;
  const float* mla_qg; const float* mla_wuq; const float* mla_kvg; const float* mla_wukv;
  const float* gdn_conv; const float* gdn_alog; const float* gdn_dtb; const float* gdn_ng;
  const float* ffn_wg; const float* ffn_wu; const float* ffn_conv; const float* ffn_wd;
  float* out; unsigned char* ws;
};

typedef __bf16 bf16v2_t __attribute__((ext_vector_type(2)));
typedef float f32v2_t __attribute__((ext_vector_type(2)));
DI unsigned pk_bf16(float lo, float hi) { f32v2_t v = {lo, hi}; bf16v2_t b = __builtin_convertvector(v, bf16v2_t); return __builtin_bit_cast(unsigned, b); }
DI float bf2f(bf16 v) { return __uint_as_float(((unsigned)v) << 16); }
DI bf16 f2bf(float x) { return (bf16)(pk_bf16(x, 0.f) & 0xffffu); }
DI float bflo(unsigned u) { return __uint_as_float(u << 16); }
DI float bfhi(unsigned u) { return __uint_as_float(u & 0xffff0000u); }
DI float sigmoidf_(float x) { return 1.f / (1.f + __expf(-x)); }
DI float siluf_(float x) { return x * sigmoidf_(x); }
DI float softplusf_(float x) { return fmaxf(x, 0.f) + __logf(1.f + __expf(-fabsf(x))); }
DI float wave_sum(float v) {
#pragma unroll
  for (int o = 1; o < 64; o <<= 1) v += __shfl_xor(v, o);
  return v;
}
#define MFMA32(a, b, c) __builtin_amdgcn_mfma_f32_32x32x16_bf16((a), (b), (c), 0, 0, 0)

DI f32x16 mm32(const unsigned char* A, int lda, const unsigned char* B, int ldb, int ks, f32x16 acc, int r, int h) {
  const unsigned char* pa = A + r * lda + h * 16;
  const unsigned char* pb = B + r * ldb + h * 16;
  for (int kk = 0; kk < ks; ++kk) {
    bf16x8 a = *(const bf16x8*)(pa + kk * 32);
    bf16x8 b = *(const bf16x8*)(pb + kk * 32);
    acc = MFMA32(a, b, acc);
  }
  return acc;
}
DI f32x16 zero16() { f32x16 z; for (int i = 0; i < 16; ++i) z[i] = 0.f; return z; }

DI int win_srccol(int n) {
  if (n < 1536) return n;
  if (n < 1792) return 1552 + (n - 1536);
  if (n < 2048) return 1808 + (n - 1792);
  if (n < 2176) return 2064 + (n - 2048);
  if (n < 2432) return 2224 + (n - 2176);
  if (n < 2688) return 2480 + (n - 2432);
  if (n < 2944) return 2736 + (n - 2688);
  if (n < 3200) return 3000 + (n - 2944);
  if (n < 3232) return 2192 + (n - 3200);
  if (n < 3248) return 1536 + (n - 3232);
  if (n < 3252) return 2992 + (n - 3248);
  if (n < 3256) return 2996 + (n - 3252);
  return -1;
}
DI int gu_rowmap(int c, int mode) { return mode == 0 ? c : ((c >> 7) * 256 + (c & 127) + (mode == 2 ? 128 : 0)); }
DI void transpose_tile(const float* __restrict__ src, int ldsrc, int K, bool perm, const float* __restrict__ gain, bf16* __restrict__ dst, int n0, int k0, unsigned char* lds, int tid, int rowmode = 0) {
  bf16* t = (bf16*)lds;
  const int nl = tid & 63, kq = tid >> 6;
  const int sc = perm ? win_srccol(n0 + nl) : (n0 + nl);
  float tv[16];
#pragma unroll
  for (int i = 0; i < 16; ++i) {
    const int k = k0 + kq + 4 * i;
    float v = 0.f;
    if (sc >= 0) { v = src[(size_t)k * ldsrc + sc]; if (gain) v *= gain[k]; }
    tv[i] = v;
  }
#pragma unroll
  for (int i = 0; i < 16; ++i) t[nl * 72 + kq + 4 * i] = f2bf(tv[i]);
  __syncthreads();
  const int r = tid >> 2, c = (tid & 3) * 16;
  u32x4 a = *(const u32x4*)(t + r * 72 + c), b = *(const u32x4*)(t + r * 72 + c + 8);
  bf16* o = dst + (size_t)gu_rowmap(n0 + r, rowmode) * K + k0 + c;
  *(u32x4*)o = a; *(u32x4*)(o + 8) = b;
  __syncthreads();
}

DI void frag_tile(const float* __restrict__ src, int ldsrc, bool isq, const float* __restrict__ gain, bf16* __restrict__ dst, int n0, int k0, int tid) {
  const int n = n0 + (tid & 63), kq = tid >> 6;
#pragma unroll
  for (int gi = 0; gi < 2; ++gi) {
    const int kg = k0 + (kq * 2 + gi) * 8;
    float v[8];
#pragma unroll
    for (int j = 0; j < 8; ++j) v[j] = src[(size_t)(kg + j) * ldsrc + n] * gain[kg + j];
    const int kk = kg >> 4, hh = (kg >> 3) & 1, r = n & 31;
    size_t off;
    if (isq) { const int hd = n / 96, nl = n % 96; off = ((size_t)(((hd * 16 + kk) * 3 + (nl >> 5)) * 64 + hh * 32 + r)) * 8; }
    else { const int hd = n >> 7, nl = n & 127; off = ((size_t)((((hd * 2 + (nl >> 6)) * 8 + kk) * 2 + ((nl >> 5) & 1)) * 64 + hh * 32 + r)) * 8; }
    u32x4 w; w.x = pk_bf16(v[0], v[1]); w.y = pk_bf16(v[2], v[3]); w.z = pk_bf16(v[4], v[5]); w.w = pk_bf16(v[6], v[7]);
    *(u32x4*)(dst + off) = w;
  }
  __syncthreads();
  __syncthreads();
}
DI void phase0(const Params& p, unsigned char* lds, int tid, int half) {
  bf16* W = (bf16*)(p.ws + OFF_W);
  constexpr int NT_L = 832 + 256 + 704 + 704 + 704 + 24 + 16;
  for (int pi = blockIdx.x; pi < NT_L; pi += gridDim.x) {
    const int it = 2 * pi + half;
    const int l = it / NT_L; int r = it % NT_L;
    bf16* Wl = W + (size_t)l * WL_E;
    if (r < 832) { transpose_tile(p.w_in + (size_t)l * 1024 * DIN, DIN, 1024, true, p.pre_mix_g + l * 1024, Wl + WO_IN, (r / 16) * 64, (r % 16) * 64, lds, tid); continue; } r -= 832;
    if (r < 256) { transpose_tile(p.w_out + (size_t)l * 1024 * 1024, 1024, 1024, false, nullptr, Wl + WO_OUT, (r / 16) * 64, (r % 16) * 64, lds, tid); continue; } r -= 256;
    if (r < 704) { transpose_tile(p.ffn_wg + (size_t)l * 1024 * FF, FF, 1024, false, p.pre_ffn_g + l * 1024, Wl + WO_GU, (r / 16) * 64, (r % 16) * 64, lds, tid, 1); continue; } r -= 704;
    if (r < 704) { transpose_tile(p.ffn_wu + (size_t)l * 1024 * FF, FF, 1024, false, p.pre_ffn_g + l * 1024, Wl + WO_GU, (r / 16) * 64, (r % 16) * 64, lds, tid, 2); continue; } r -= 704;
    if (r < 704) { transpose_tile(p.ffn_wd + (size_t)l * FF * 1024, 1024, FF, false, nullptr, Wl + WO_DN, (r / 44) * 64, (r % 44) * 64, lds, tid); continue; } r -= 704;
    if (r < 24) { frag_tile(p.mla_wuq + (size_t)l * 256 * 384, 384, true, p.mla_qg + l * 256, Wl + WO_UQ, (r / 4) * 64, (r % 4) * 64, tid); continue; } r -= 24;
    frag_tile(p.mla_wukv + (size_t)l * 128 * 512, 512, false, p.mla_kvg + l * 128, Wl + WO_UKV, (r / 2) * 64, (r % 2) * 64, tid);
  }
}

DI void resid_phase(const float* __restrict__ xin, const bf16* __restrict__ xinb, const bf16* __restrict__ y, const float* __restrict__ g, float* __restrict__ xout, bf16* __restrict__ xb, float* __restrict__ rs, int tid, int vb, int nvb) {
  const int lane = tid & 63, wv = tid >> 6;
  const int stride = nvb * 4;
  for (int row0 = vb * 4 + wv; row0 < T_; row0 += 2 * stride) {
    f32x4 v[2][4]; u32x2 yu[2][4];
#pragma unroll
    for (int q = 0; q < 2; ++q) {
      const int row = min(row0 + q * stride, T_ - 1);
      if (xin) {
#pragma unroll
        for (int j = 0; j < 4; ++j) v[q][j] = *(const f32x4*)(xin + (size_t)row * 1024 + lane * 4 + 256 * j);
      } else {
#pragma unroll
        for (int j = 0; j < 4; ++j) { const u32x2 u = *(const u32x2*)(xinb + (size_t)row * 1024 + lane * 4 + 256 * j); v[q][j] = (f32x4){bflo(u.x), bfhi(u.x), bflo(u.y), bfhi(u.y)}; }
      }
      if (y) {
#pragma unroll
        for (int j = 0; j < 4; ++j) yu[q][j] = *(const u32x2*)(y + (size_t)row * 1024 + lane * 4 + 256 * j);
      }
    }
#pragma unroll
    for (int q = 0; q < 2; ++q) {
      const int row = row0 + q * stride;
      if (y) {
        f32x4 yv[4]; float ss = 0.f;
#pragma unroll
        for (int j = 0; j < 4; ++j) {
          yv[j] = (f32x4){bflo(yu[q][j].x), bfhi(yu[q][j].x), bflo(yu[q][j].y), bfhi(yu[q][j].y)};
          ss += yv[j].x * yv[j].x + yv[j].y * yv[j].y + yv[j].z * yv[j].z + yv[j].w * yv[j].w;
        }
        const float ry = rsqrtf(wave_sum(ss) * (1.f / 1024.f) + EPS);
#pragma unroll
        for (int j = 0; j < 4; ++j) { f32x4 gg = *(const f32x4*)(g + lane * 4 + 256 * j); v[q][j] = v[q][j] + yv[j] * ry * gg; }
      }
      float sx = 0.f;
#pragma unroll
      for (int j = 0; j < 4; ++j) sx += v[q][j].x * v[q][j].x + v[q][j].y * v[q][j].y + v[q][j].z * v[q][j].z + v[q][j].w * v[q][j].w;
      sx = wave_sum(sx);
      if (row < T_) {
#pragma unroll
        for (int j = 0; j < 4; ++j) {
          if (xout) *(f32x4*)(xout + (size_t)row * 1024 + lane * 4 + 256 * j) = v[q][j];
          if (xb) {
            u32x2 o; o.x = pk_bf16(v[q][j].x, v[q][j].y); o.y = pk_bf16(v[q][j].z, v[q][j].w);
            *(u32x2*)(xb + (size_t)row * 1024 + lane * 4 + 256 * j) = o;
          }
        }
        if (xb && lane == 0) rs[row] = rsqrtf(sx * (1.f / 1024.f) + EPS);
      }
    }
  }
}

DI float gelu_tanh(float x) {
  const float u = 0.7978845608028654f * (x + 0.044715f * x * x * x);
  const float e = __expf(2.f * u);
  const float th = 1.f - 2.f / (e + 1.f);
  return 0.5f * x * (1.f + th);
}
struct EpiStore {
  bf16* out0; bf16* out1; int split; int ldc; const float* rs; const float* cw;
  DI void store4(int m, int n, f32x4 v) const {
    bf16* o = out0; if (n >= split) { o = out1; n -= split; }
    u32x2 w; w.x = pk_bf16(v.x, v.y); w.y = pk_bf16(v.z, v.w);
    *(u32x2*)(o + (size_t)m * ldc + n) = w;
  }
};

#define GL_LAS __attribute__((address_space(3)))
DI int g8_lds_byte(int r, int c) { const int st = (r >> 4) * 2 + (c >> 5), rr = r & 15, cc = c & 31, ob = rr * 64 + cc * 2; return st * 1024 + (ob ^ (((ob >> 9) & 1) << 5)); }
DI void g8_stage_rc(int b, int& R, int& C) { const int st = b / 1024, sb = b % 1024, swz = sb ^ (((sb >> 9) & 1) << 5); R = (st >> 1) * 16 + swz / 64; C = (st & 1) * 32 + (swz % 64) / 2; }
template <bool ACT>
DI void gemm_phase(const bf16* __restrict__ A, int lda, const bf16* __restrict__ Bt, int ldb, int K, int MT, int NT, const EpiStore& epi, unsigned char* lds, int tid) {
  constexpr int HTB = 128 * 64 * 2;
  const int nt_k = K / 64;
  const int xcd = blockIdx.x & 7, jb = blockIdx.x >> 3, nbx = (gridDim.x + 7 - xcd) >> 3;
  const int band = MT / 8, per_x = band * NT;
  for (int lt = jb; lt < per_x; lt += nbx) {
    const int mg = lt / (8 * NT), rem = lt % (8 * NT), gs = min(8, band - 8 * mg);
    const int mt = xcd * band + mg * 8 + rem % gs, nt = rem / gs, n0 = nt * 256;
    int m0 = mt * 256, seq0 = 0;
    if (ACT) { const int bs = mt / 34, ti = mt % 34; if (ti == 33) continue; seq0 = bs * S_; m0 = seq0 + 254 * ti - 2; }
    __syncthreads();
    asm volatile("" : "+v"(tid));
    const int wid = tid >> 6, lane = tid & 63, wr = wid >> 2, wc = wid & 3, fr = lane & 15, fq = lane >> 4;
    const int obs = (fr * 64 + fq * 16) ^ ((((fr * 64 + fq * 16) >> 9) & 1) << 5);
    const int a_rd = obs + wr * 8192, b_rd = obs + wc * 4096;
#define SA8(b, h) (lds + ((b) * 2 + (h)) * HTB)
#define SB8(b, h) (lds + (4 + (b) * 2 + (h)) * HTB)
    unsigned aofs[2][2], bofs[2];
#pragma unroll
    for (int i = 0; i < 2; ++i) {
      int sr_, sc_; g8_stage_rc(tid * 16 + i * 8192, sr_, sc_);
      bofs[i] = ((unsigned)(n0 + sr_) * (unsigned)ldb + (unsigned)sc_) * 2u;
#pragma unroll
      for (int hf = 0; hf < 2; ++hf) {
        int row = m0 + sr_ + (ACT ? hf * 128 : 0); if (ACT) row = min(max(row, seq0), seq0 + S_ - 1);
        aofs[hf][i] = ((unsigned)row * (unsigned)lda + (unsigned)sc_) * 2u;
      }
    }
#define STAGE_A(P, half_, kt) do { const unsigned char* ub_ = (const unsigned char*)A + (size_t)(kt) * 128 + (ACT ? (size_t)0 : (size_t)(half_) * 256 * (size_t)lda); _Pragma("unroll") for (int _i = 0; _i < 2; ++_i) \
      __builtin_amdgcn_global_load_lds((const unsigned*)(ub_ + aofs[half_][_i]), (GL_LAS unsigned*)((P) + tid * 16 + _i * 8192), 16, 0, 0); } while (0)
#define STAGE_B(P, half_, kt) do { const unsigned char* ub_ = (const unsigned char*)Bt + (size_t)(kt) * 128 + (size_t)(half_) * 256 * (size_t)ldb; _Pragma("unroll") for (int _i = 0; _i < 2; ++_i) \
      __builtin_amdgcn_global_load_lds((const unsigned*)(ub_ + bofs[_i]), (GL_LAS unsigned*)((P) + tid * 16 + _i * 8192), 16, 0, 0); } while (0)
#define LDA8(dst, b, h) _Pragma("unroll") for (int m = 0; m < 4; ++m) _Pragma("unroll") for (int k = 0; k < 2; ++k) \
      dst[m][k] = *(const bf16x8*)(SA8(b, h) + a_rd + m * 2048 + k * 1024)
#define LDB8(dst, b, h) _Pragma("unroll") for (int n = 0; n < 2; ++n) _Pragma("unroll") for (int k = 0; k < 2; ++k) \
      dst[n][k] = *(const bf16x8*)(SB8(b, h) + b_rd + n * 2048 + k * 1024)
#define MMA8(ai, bj, At_, Bt_) do { __builtin_amdgcn_s_setprio(1); \
      _Pragma("unroll") for (int m = 0; m < 4; ++m) _Pragma("unroll") for (int n = 0; n < 2; ++n) _Pragma("unroll") for (int k = 0; k < 2; ++k) \
        acc[ai][bj][m][n] = __builtin_amdgcn_mfma_f32_16x16x32_bf16(Bt_[n][k], At_[m][k], acc[ai][bj][m][n], 0, 0, 0); \
      __builtin_amdgcn_s_setprio(0); } while (0)
#define WAIT_V(n) asm volatile("s_waitcnt vmcnt(" #n ")" ::: "memory")
#define WAIT_L(n) asm volatile("s_waitcnt lgkmcnt(" #n ")" ::: "memory")
#define BAR8 __builtin_amdgcn_s_barrier()
#define SCHED8 __builtin_amdgcn_sched_barrier(0)
    f32x4 acc[2][2][4][2];
#pragma unroll
    for (int i0 = 0; i0 < 2; ++i0)
#pragma unroll
      for (int i1 = 0; i1 < 2; ++i1)
#pragma unroll
        for (int i2 = 0; i2 < 4; ++i2)
#pragma unroll
          for (int i3 = 0; i3 < 2; ++i3) acc[i0][i1][i2][i3] = (f32x4){0.f, 0.f, 0.f, 0.f};
    bf16x8 At[4][2], B0[2][2], B1[2][2];
    STAGE_B(SB8(0, 0), 0, 0); STAGE_A(SA8(0, 0), 0, 0);
    STAGE_B(SB8(0, 1), 1, 0); STAGE_A(SA8(0, 1), 1, 0);
    if (wr == 1) BAR8;
    WAIT_V(4); BAR8;
    STAGE_B(SB8(1, 0), 0, 1); STAGE_A(SA8(1, 0), 0, 1); STAGE_B(SB8(1, 1), 1, 1);
    WAIT_V(6); BAR8;
    for (int t = 0; t < nt_k - 2; t += 2) {
      LDB8(B0, 0, 0); SCHED8; LDA8(At, 0, 0); STAGE_A(SA8(1, 1), 1, t + 1);
      WAIT_L(8); BAR8; WAIT_L(0); MMA8(0, 0, At, B0); BAR8; SCHED8;
      LDB8(B1, 0, 1); STAGE_B(SB8(0, 0), 0, t + 2);
      BAR8; WAIT_L(0); MMA8(0, 1, At, B1); BAR8;
      LDA8(At, 0, 1); STAGE_A(SA8(0, 0), 0, t + 2);
      BAR8; WAIT_L(0); MMA8(1, 0, At, B0); BAR8; SCHED8;
      STAGE_B(SB8(0, 1), 1, t + 2);
      WAIT_V(6); BAR8; MMA8(1, 1, At, B1); BAR8;
      LDB8(B0, 1, 0); SCHED8; LDA8(At, 1, 0); STAGE_A(SA8(0, 1), 1, t + 2);
      WAIT_L(8); BAR8; WAIT_L(0); MMA8(0, 0, At, B0); BAR8; SCHED8;
      LDB8(B1, 1, 1); STAGE_B(SB8(1, 0), 0, t + 3);
      BAR8; WAIT_L(0); MMA8(0, 1, At, B1); BAR8;
      LDA8(At, 1, 1); STAGE_A(SA8(1, 0), 0, t + 3);
      BAR8; WAIT_L(0); MMA8(1, 0, At, B0); BAR8; SCHED8;
      STAGE_B(SB8(1, 1), 1, t + 3);
      WAIT_V(6); BAR8; MMA8(1, 1, At, B1); BAR8;
    }
    { LDB8(B0, 0, 0); LDA8(At, 0, 0); STAGE_A(SA8(1, 1), 1, nt_k - 1);
      BAR8; WAIT_L(0); MMA8(0, 0, At, B0); BAR8;
      LDB8(B1, 0, 1); BAR8; WAIT_L(0); MMA8(0, 1, At, B1); BAR8;
      LDA8(At, 0, 1); WAIT_V(4); BAR8; WAIT_L(0); MMA8(1, 0, At, B0); MMA8(1, 1, At, B1); BAR8; }
    { LDB8(B0, 1, 0); LDA8(At, 1, 0); WAIT_V(2); BAR8; WAIT_L(0); MMA8(0, 0, At, B0); BAR8;
      LDB8(B1, 1, 1); WAIT_V(0); BAR8; WAIT_L(0); MMA8(0, 1, At, B1); BAR8;
      LDA8(At, 1, 1); BAR8; WAIT_L(0); MMA8(1, 0, At, B0); MMA8(1, 1, At, B1); BAR8; }
    if (wr == 0) BAR8;
    __syncthreads();
    int tid_e = tid; asm volatile("" : "+v"(tid_e));
    const int e_wid = tid_e >> 6, e_lane = tid_e & 63, e_wr = e_wid >> 2, e_wc = e_wid & 3, e_fr = e_lane & 15, e_fq = e_lane >> 4;
    if (!ACT) {
#pragma unroll
      for (int ai = 0; ai < 2; ++ai)
#pragma unroll
        for (int m = 0; m < 4; ++m) {
          const int ml = ai * 128 + e_wr * 64 + m * 16 + e_fr;
          const float sc = epi.rs ? epi.rs[m0 + ml] : 1.f;
#pragma unroll
          for (int bj = 0; bj < 2; ++bj)
#pragma unroll
            for (int n = 0; n < 2; ++n) {
              const f32x4 v = acc[ai][bj][m][n] * sc;
              u32x2 w2; w2.x = pk_bf16(v[0], v[1]); w2.y = pk_bf16(v[2], v[3]);
              *(u32x2*)(lds + ml * 520 + (bj * 128 + e_wc * 32 + n * 16 + e_fq * 4) * 2) = w2;
            }
        }
      __syncthreads();
#pragma unroll 2
      for (int k = 0; k < 16; ++k) {
        const int id = tid_e + 512 * k, row = id >> 5, ch = id & 31;
        const u32x2 lo = *(const u32x2*)(lds + row * 520 + ch * 16), hi = *(const u32x2*)(lds + row * 520 + ch * 16 + 8);
        *(u32x4*)(epi.out0 + (size_t)(m0 + row) * epi.ldc + n0 + ch * 8) = (u32x4){lo.x, lo.y, hi.x, hi.y};
      }
    } else {
      float* G = (float*)lds;
#pragma unroll
      for (int ai = 0; ai < 2; ++ai)
#pragma unroll
        for (int m = 0; m < 4; ++m) {
          const int ml = ai * 128 + e_wr * 64 + m * 16 + e_fr;
          const float sc = epi.rs[min(max(m0 + ml, seq0), seq0 + S_ - 1)];
#pragma unroll
          for (int n = 0; n < 2; ++n) {
            acc[ai][0][m][n] = acc[ai][0][m][n] * sc; acc[ai][1][m][n] = acc[ai][1][m][n] * sc;
#pragma unroll
            for (int j = 0; j < 4; ++j) G[(e_wc * 32 + n * 16 + e_fq * 4 + j) * 256 + ml] = acc[ai][0][m][n][j];
          }
        }
      __syncthreads();
#pragma unroll
      for (int n = 0; n < 2; ++n) {
        const int chl = e_wc * 32 + n * 16 + e_fq * 4, c = nt * 128 + chl;
        const f32x4 w0 = *(const f32x4*)(epi.cw + c), w1 = *(const f32x4*)(epi.cw + FF + c), w2 = *(const f32x4*)(epi.cw + 2 * FF + c);
#pragma unroll
        for (int ai = 0; ai < 2; ++ai)
#pragma unroll
          for (int m = 0; m < 4; ++m) {
            const int ml = ai * 128 + e_wr * 64 + m * 16 + e_fr, t = m0 + ml, sq = t - seq0;
            const int m1 = max(ml - 1, 0), m2 = max(ml - 2, 0);
            float o[4];
#pragma unroll
            for (int j = 0; j < 4; ++j) {
              const float g0 = acc[ai][0][m][n][j];
              const float g1 = (sq >= 1) ? G[(chl + j) * 256 + m1] : 0.f;
              const float g2 = (sq >= 2) ? G[(chl + j) * 256 + m2] : 0.f;
              const float cv = w0[j] * g2 + w1[j] * g1 + w2[j] * g0;
              o[j] = gelu_tanh(cv) * acc[ai][1][m][n][j];
            }
            if (ml >= 2 && sq < S_) {
              u32x2 wv2; wv2.x = pk_bf16(o[0], o[1]); wv2.y = pk_bf16(o[2], o[3]);
              *(u32x2*)(epi.out0 + (size_t)t * FF + c) = wv2;
            }
          }
      }
    }
  }
  __syncthreads();
}

DI void ffn_act_phase(const bf16* __restrict__ gate, bf16* __restrict__ up, const float* __restrict__ cw, int tid) {
  constexpr int CG = FF / 8;
  const int total = (T_ / 16) * CG;
  for (int it = blockIdx.x * 256 + tid; it < total; it += gridDim.x * 256) {
    const int tb = it / CG, cgp = it % CG, t0 = tb * 16, c0 = cgp * 8;
    float w0[8], w1[8], w2[8], g1[8], g2[8];
#pragma unroll
    for (int i = 0; i < 8; ++i) { w0[i] = cw[c0 + i]; w1[i] = cw[FF + c0 + i]; w2[i] = cw[2 * FF + c0 + i]; g1[i] = 0.f; g2[i] = 0.f; }
    if ((t0 & (S_ - 1)) != 0) {
      u32x4 a = *(const u32x4*)(gate + (size_t)(t0 - 2) * FF + c0), b = *(const u32x4*)(gate + (size_t)(t0 - 1) * FF + c0);
#pragma unroll
      for (int i = 0; i < 4; ++i) { g2[2 * i] = bflo(a[i]); g2[2 * i + 1] = bfhi(a[i]); g1[2 * i] = bflo(b[i]); g1[2 * i + 1] = bfhi(b[i]); }
    }
#pragma unroll 4
    for (int t = t0; t < t0 + 16; ++t) {
      u32x4 a = *(const u32x4*)(gate + (size_t)t * FF + c0), u = *(const u32x4*)(up + (size_t)t * FF + c0);
      float g0[8], uu[8], o[8];
#pragma unroll
      for (int i = 0; i < 4; ++i) { g0[2 * i] = bflo(a[i]); g0[2 * i + 1] = bfhi(a[i]); uu[2 * i] = bflo(u[i]); uu[2 * i + 1] = bfhi(u[i]); }
#pragma unroll
      for (int i = 0; i < 8; ++i) { const float c = w0[i] * g2[i] + w1[i] * g1[i] + w2[i] * g0[i]; o[i] = gelu_tanh(c) * uu[i]; g2[i] = g1[i]; g1[i] = g0[i]; }
      u32x4 w; w.x = pk_bf16(o[0], o[1]); w.y = pk_bf16(o[2], o[3]); w.z = pk_bf16(o[4], o[5]); w.w = pk_bf16(o[6], o[7]);
      *(u32x4*)(up + (size_t)t * FF + c0) = w;
    }
  }
}

template <int DK, bool ISA>
DI float gla_lb(const Params& p, int l, int h, int d) {
  if (!ISA || l == 0) return 0.f;
  const float l0 = p.hgrn_lb[h * 64 + d], l1 = p.hgrn_lb[256 + h * 64 + d];
  return 1.f / (1.f + __expf(l0 - l1));
}
template <int DK, bool ISA>
DI void gla_bc(const Params& p, int l, const bf16* __restrict__ z, int t0, int h, float* bcl, int tid) {
  constexpr int NP = 256 / DK, TPP = 64 / NP;
  const int d = tid % DK, part = tid / DK;
  float run = 0.f;
  if (ISA) {
    const float lbv = gla_lb<DK, ISA>(p, l, h, d);
#pragma unroll
    for (int jj = 0; jj < TPP; ++jj) {
      const int j = part * TPP + jj;
      const float zf = bf2f(z[(size_t)(t0 + j) * ZLD + ZA_F + h * 64 + d]);
      const float f = lbv + (1.f - lbv) * sigmoidf_(zf);
      run += __logf(fmaxf(f, 1e-30f));
      bcl[j * DK + d] = run;
    }
  } else {
    float w[16];
#pragma unroll
    for (int rr = 0; rr < 16; ++rr) w[rr] = p.gla_w2[(size_t)l * 16 * 128 + rr * 128 + h * 32 + d];
    const float bias = p.gla_b[l * 128 + h * 32 + d];
#pragma unroll
    for (int jj = 0; jj < TPP; ++jj) {
      const int j = part * TPP + jj;
      const u32x4* cp = (const u32x4*)(z + (size_t)(t0 + j) * ZLD + ZB_CODE);
      u32x4 c0 = cp[0], c1 = cp[1];
      float u = bias;
#pragma unroll
      for (int i = 0; i < 4; ++i) { u += bflo(c0[i]) * w[2 * i] + bfhi(c0[i]) * w[2 * i + 1]; u += bflo(c1[i]) * w[8 + 2 * i] + bfhi(c1[i]) * w[8 + 2 * i + 1]; }
      run += -softplusf_(-u) * (1.f / 16.f);
      bcl[j * DK + d] = run;
    }
  }
  __syncthreads();
  float off = 0.f;
  for (int pp = 0; pp < part; ++pp) off += bcl[(pp * TPP + TPP - 1) * DK + d];
  __syncthreads();
#pragma unroll
  for (int jj = 0; jj < TPP; ++jj) bcl[(part * TPP + jj) * DK + d] += off;
  __syncthreads();
}
template <int DK, bool ISA>
DI float gla_kval(const bf16* __restrict__ z, int t, int h, int d, float lbv) {
  if (ISA) { const float zf = bf2f(z[(size_t)t * ZLD + ZA_F + h * 64 + d]); return (1.f - lbv) * sigmoidf_(-zf); }
  return bf2f(z[(size_t)t * ZLD + ZB_K + h * 32 + d]);
}
template <int DK, bool ISA>
DI float gla_qval(const bf16* __restrict__ z, int t, int h, int d) {
  if (ISA) { const float zq = bf2f(z[(size_t)t * ZLD + ZA_Q + h * 64 + d]); return siluf_(zq) * 0.125f; }
  return bf2f(z[(size_t)t * ZLD + ZB_Q + h * 32 + d]) * 0.17677669529663687f;
}

template <int DK, bool ISA>
DI void gla_local_item(const Params& p, int l, int ci, unsigned char* lds, int tid) {
  const bf16* z = (const bf16*)(p.ws + OFF_AR + AR_Z);
  bf16* UT = (bf16*)(p.ws + OFF_AR + (ISA ? AR_UTA : AR_UTB));
  float* G = (float*)(p.ws + (ISA ? OFF_GA : OFF_GB));
  const int h = ci & 3, t0 = (ci >> 2) * 64;
  float* bcl = (float*)lds;
  bf16* kT = (bf16*)(lds + 16384);
  bf16* vT = (bf16*)(lds + 16384 + 9216);
  bf16 vpre[16];
  {
    const int e = tid & 63, p4 = tid >> 6;
    const int vcol = (ISA ? ZA_I : ZB_V) + h * 64 + e;
#pragma unroll
    for (int jj = 0; jj < 16; ++jj) vpre[jj] = z[(size_t)(t0 + p4 * 16 + jj) * ZLD + vcol];
  }
  gla_bc<DK, ISA>(p, l, z, t0, h, bcl, tid);
  {
    float* bcg = (float*)((unsigned char*)p.out + BC_OFF + (ISA ? 0 : BC_B_OFF)) + (size_t)ci * 64 * DK;
#pragma unroll
    for (int k = 0; k < (64 * DK) / 1024; ++k) *(f32x4*)(bcg + (tid + 256 * k) * 4) = *(const f32x4*)(bcl + (tid + 256 * k) * 4);
  }
  constexpr int NP = 256 / DK, TPP = 64 / NP;
  {
    const int d = tid % DK, part = tid / DK;
    const float lbv = gla_lb<DK, ISA>(p, l, h, d);
    const float bl = bcl[63 * DK + d];
#pragma unroll
    for (int jj = 0; jj < TPP; ++jj) {
      const int j = part * TPP + jj;
      const float kv = gla_kval<DK, ISA>(z, t0 + j, h, d, lbv);
      kT[d * 72 + j] = f2bf(kv * __expf(bl - bcl[j * DK + d]));
    }
    if (part == 0) G[(size_t)ci * DK + d] = __expf(bl);
    const int e = tid & 63, p4 = tid >> 6;
#pragma unroll
    for (int jj = 0; jj < 16; ++jj) { const int j = p4 * 16 + jj; vT[e * 72 + j] = vpre[jj]; }
  }
  __syncthreads();
  const int lane = tid & 63, wv = tid >> 6, wm = wv & 1, wn = wv >> 1, r = lane & 31, hh = lane >> 5;
  if (wm * 32 < DK) {
    f32x16 acc = mm32((const unsigned char*)(kT + wm * 32 * 72), 144, (const unsigned char*)(vT + wn * 32 * 72), 144, 4, zero16(), r, hh);
    const int e = wn * 32 + r;
#pragma unroll
    for (int g = 0; g < 4; ++g) {
      const int d = wm * 32 + 8 * g + 4 * hh;
      u32x2 w; w.x = pk_bf16(acc[4 * g], acc[4 * g + 1]); w.y = pk_bf16(acc[4 * g + 2], acc[4 * g + 3]);
      *(u32x2*)(UT + ((size_t)ci * 64 + e) * DK + d) = w;
    }
  }
  __syncthreads();
}

template <int DK>
DI void gla_scan_item(bf16* __restrict__ UT, const float* __restrict__ G, int b, int h, int slice, int tid) {
  constexpr int GPR = DK / 4, RPS = 256 / GPR;
  const int e = slice * RPS + tid / GPR, d4 = (tid % GPR) * 4;
  f32x4 st = (f32x4){0.f, 0.f, 0.f, 0.f};
  for (int c0 = 0; c0 < 128; c0 += 8) {
    u32x2 u[8]; f32x4 gg[8];
#pragma unroll
    for (int i = 0; i < 8; ++i) {
      const size_t ci = ((size_t)(b * 128 + c0 + i) * 4 + h);
      u[i] = *(const u32x2*)(UT + (ci * 64 + e) * DK + d4);
      gg[i] = *(const f32x4*)(G + ci * DK + d4);
    }
#pragma unroll
    for (int i = 0; i < 8; ++i) {
      const size_t ci = ((size_t)(b * 128 + c0 + i) * 4 + h);
      u32x2 w; w.x = pk_bf16(st.x, st.y); w.y = pk_bf16(st.z, st.w);
      *(u32x2*)(UT + (ci * 64 + e) * DK + d4) = w;
      st = gg[i] * st + (f32x4){bflo(u[i].x), bfhi(u[i].x), bflo(u[i].y), bfhi(u[i].y)};
    }
  }
}

template <bool SIG>
DI void norm_gate_store(const float* obuf, bool has_add, u32x4 a0, u32x4 a1, const float* __restrict__ ng, u32x4 g0, u32x4 g1, bf16* __restrict__ mixo, int tid) {
  const int i = tid >> 2, e0 = (tid & 3) * 16;
  float o[16]; float ss = 0.f;
#pragma unroll
  for (int k = 0; k < 16; ++k) o[k] = obuf[i * 68 + e0 + k];
  if (has_add) {
#pragma unroll
    for (int k = 0; k < 4; ++k) { o[2 * k] += bflo(a0[k]); o[2 * k + 1] += bfhi(a0[k]); o[8 + 2 * k] += bflo(a1[k]); o[8 + 2 * k + 1] += bfhi(a1[k]); }
  }
#pragma unroll
  for (int k = 0; k < 16; ++k) ss += o[k] * o[k];
  ss += __shfl_xor(ss, 1); ss += __shfl_xor(ss, 2);
  const float rsv = rsqrtf(ss * (1.f / 64.f) + EPS);
  float gt[16];
#pragma unroll
  for (int k = 0; k < 4; ++k) { gt[2 * k] = bflo(g0[k]); gt[2 * k + 1] = bfhi(g0[k]); gt[8 + 2 * k] = bflo(g1[k]); gt[8 + 2 * k + 1] = bfhi(g1[k]); }
  unsigned w[8];
#pragma unroll
  for (int k = 0; k < 8; ++k) {
    float a = o[2 * k] * rsv * ng[e0 + 2 * k], b = o[2 * k + 1] * rsv * ng[e0 + 2 * k + 1];
    a *= SIG ? sigmoidf_(gt[2 * k]) : siluf_(gt[2 * k]);
    b *= SIG ? sigmoidf_(gt[2 * k + 1]) : siluf_(gt[2 * k + 1]);
    w[k] = pk_bf16(a, b);
  }
  u32x4* op = (u32x4*)(mixo + (size_t)i * 1024 + e0);
  op[0] = (u32x4){w[0], w[1], w[2], w[3]}; op[1] = (u32x4){w[4], w[5], w[6], w[7]};
}

template <int DK, bool ISA>
DI void gla_out_item(const Params& p, int l, int ci, unsigned char* lds, int tid) {
  const bf16* z = (const bf16*)(p.ws + OFF_AR + AR_Z);
  const bf16* ST = (const bf16*)(p.ws + OFF_AR + (ISA ? AR_UTA : AR_UTB));
  bf16* mix = (bf16*)(p.ws + OFF_AR + AR_MIX);
  const int h = ci & 3, t0 = (ci >> 2) * 64;
  constexpr int LDK = (DK + 8) * 2;
  float* bcl = (float*)lds;
  float* obuf = (float*)lds;
  unsigned char* qh = lds + 17408;
  unsigned char* kt = qh + 9216;
  unsigned char* qc = kt + 9216;
  unsigned char* vT = qc + 9216;
  unsigned char* stl = vT + 9216;
  unsigned char* attn = stl + 9216;
  const u32x4* gpre = (const u32x4*)(z + (size_t)(t0 + (tid >> 2)) * ZLD + (ISA ? ZA_G : ZB_G) + h * 64 + (tid & 3) * 16);
  const u32x4 gq0 = gpre[0], gq1 = gpre[1];
  bf16 vpre[16];
  {
    const int e = tid & 63, p4 = tid >> 6;
    const int vcol = (ISA ? ZA_I : ZB_V) + h * 64 + e;
#pragma unroll
    for (int jj = 0; jj < 16; ++jj) vpre[jj] = z[(size_t)(t0 + p4 * 16 + jj) * ZLD + vcol];
  }
  constexpr int NPq = 256 / DK, TPPq = 64 / NPq;
  bf16 qpre[TPPq], kpre[TPPq];
  {
    const int d = tid % DK, part = tid / DK;
#pragma unroll
    for (int jj = 0; jj < TPPq; ++jj) {
      const size_t t = (size_t)(t0 + part * TPPq + jj);
      qpre[jj] = z[t * ZLD + (ISA ? ZA_Q + h * 64 : ZB_Q + h * 32) + d];
      kpre[jj] = ISA ? (bf16)0 : z[t * ZLD + ZB_K + h * 32 + d];
    }
  }
  constexpr int CPR0 = DK / 8, NST = (64 * CPR0) / 256;
  u32x4 stpre[NST];
#pragma unroll
  for (int k = 0; k < NST; ++k) { const int id = tid + 256 * k; stpre[k] = *(const u32x4*)(ST + ((size_t)ci * 64 + id / CPR0) * DK + (id % CPR0) * 8); }
  {
    const float* bcg = (const float*)((const unsigned char*)p.out + BC_OFF + (ISA ? 0 : BC_B_OFF)) + (size_t)ci * 64 * DK;
#pragma unroll
    for (int k = 0; k < (64 * DK) / 1024; ++k) *(f32x4*)(bcl + (tid + 256 * k) * 4) = *(const f32x4*)(bcg + (tid + 256 * k) * 4);
    __syncthreads();
  }
  constexpr int NP = 256 / DK, TPP = 64 / NP;
  {
    const int d = tid % DK, part = tid / DK;
    const float lbv = gla_lb<DK, ISA>(p, l, h, d);
    const float bref = bcl[31 * DK + d];
#pragma unroll
    for (int jj = 0; jj < TPP; ++jj) {
      const int j = part * TPP + jj;
      const float kv = ISA ? gla_kval<DK, ISA>(z, t0 + j, h, d, lbv) : bf2f(kpre[jj]);
      const float qv = ISA ? siluf_(bf2f(qpre[jj])) * 0.125f : bf2f(qpre[jj]) * 0.17677669529663687f;
      const float bc = bcl[j * DK + d];
      const float dq = fminf(fmaxf(bc - bref, -80.f), 80.f);
      ((bf16*)qh)[j * (DK + 8) + d] = f2bf(qv * __expf(dq));
      ((bf16*)kt)[j * (DK + 8) + d] = f2bf(kv * __expf(-dq));
      ((bf16*)qc)[j * (DK + 8) + d] = f2bf(qv * __expf(bc));
    }
    const int e = tid & 63, p4 = tid >> 6;
#pragma unroll
    for (int jj = 0; jj < 16; ++jj) { const int j = p4 * 16 + jj; ((bf16*)vT)[e * 72 + j] = vpre[jj]; }
#pragma unroll
    for (int k = 0; k < NST; ++k) { const int id = tid + 256 * k; *(u32x4*)(stl + (id / CPR0) * LDK + (id % CPR0) * 16) = stpre[k]; }
  }
  __syncthreads();
  const int lane = tid & 63, wv = tid >> 6, wm = wv & 1, wn = wv >> 1, r = lane & 31, hh = lane >> 5;
  {
    f32x16 acc = mm32(qh + wm * 32 * LDK, LDK, kt + wn * 32 * LDK, LDK, DK / 16, zero16(), r, hh);
    const int jc = wn * 32 + r;
#pragma unroll
    for (int g = 0; g < 4; ++g)
#pragma unroll
      for (int k = 0; k < 4; ++k) {
        const int i = wm * 32 + 8 * g + 4 * hh + k;
        const float v = (jc <= i) ? acc[4 * g + k] : 0.f;
        ((bf16*)attn)[i * 72 + jc] = f2bf(v);
      }
  }
  __syncthreads();
  {
    f32x16 acc = mm32(attn + wm * 32 * 144, 144, vT + wn * 32 * 144, 144, 4, zero16(), r, hh);
    acc = mm32(qc + wm * 32 * LDK, LDK, stl + wn * 32 * LDK, LDK, DK / 16, acc, r, hh);
    const int e = wn * 32 + r;
#pragma unroll
    for (int g = 0; g < 4; ++g)
#pragma unroll
      for (int k = 0; k < 4; ++k) obuf[(wm * 32 + 8 * g + 4 * hh + k) * 68 + e] = acc[4 * g + k];
  }
  __syncthreads();
  norm_gate_store<ISA>(obuf, false, gq0, gq0, (ISA ? p.hgrn_ng : p.gla_ng) + l * 64, gq0, gq1, mix + (size_t)t0 * 1024 + (ISA ? 0 : 256) + h * 64, tid);
  __syncthreads();
}

DI void gdn_local_item(const Params& p, int l, int ci, unsigned char* lds, int tid) {
  const bf16* z = (const bf16*)(p.ws + OFF_AR + AR_Z);
  float* Ac = (float*)(p.ws + OFF_AR + AR_ACD) + (size_t)ci * 4096;
  bf16* BT = (bf16*)(p.ws + OFF_AR + AR_BTD) + (size_t)ci * 4096;
  bf16* Qeff = (bf16*)(p.ws + OFF_AR + AR_QEFF) + (size_t)ci * 4096;
  bf16* Oloc = (bf16*)(p.ws + OFF_AR + AR_OLOC) + (size_t)ci * 4096;
  const int h = ci & 3, t0 = (ci >> 2) * 64, s0 = t0 & (S_ - 1);
  float* Mf = (float*)lds;
  bf16* WT = (bf16*)lds;
  bf16* UT = (bf16*)(lds + 9216);
  float* X = (float*)(lds + 16384);
  bf16* qn = (bf16*)(lds + 16384);
  bf16* kn = qn + 64 * 72;
  bf16* vb = kn + 64 * 72;
  bf16* kbm = (bf16*)(lds + 49152);
  bf16* aqk = kbm;
  bf16* KtT = kbm + 64 * 72;
  float* sm = (float*)(lds + 49152 + 2 * 9216);
  float* betas = sm; float* bcum = sm + 64;
  const int lane = tid & 63, wv = tid >> 6;
  const bf16 zbeta_raw = z[(size_t)(t0 + lane) * ZLD + ZD_BETA + h], za_raw = z[(size_t)(t0 + lane) * ZLD + ZD_A + h];
  {
    const int d = lane, j0 = wv * 16;
    const float* cw = p.gdn_conv + (size_t)l * 4 * 768;
    float qv[16], kv[16];
#pragma unroll
    for (int which = 0; which < 3; ++which) {
      const int cc = which * 256 + h * 64 + d;
      const int zc = (which == 0 ? ZD_Q : (which == 1 ? ZD_K : ZD_V)) + h * 64 + d;
      const float c0 = cw[cc], c1 = cw[768 + cc], c2 = cw[2 * 768 + cc], c3 = cw[3 * 768 + cc];
      float x0 = 0.f, x1 = 0.f, x2 = 0.f;
      if (s0 + j0 >= 3) { x0 = bf2f(z[(size_t)(t0 + j0 - 3) * ZLD + zc]); x1 = bf2f(z[(size_t)(t0 + j0 - 2) * ZLD + zc]); x2 = bf2f(z[(size_t)(t0 + j0 - 1) * ZLD + zc]); }
#pragma unroll
      for (int jj = 0; jj < 16; ++jj) {
        const float x3 = bf2f(z[(size_t)(t0 + j0 + jj) * ZLD + zc]);
        const float o = siluf_(c0 * x0 + c1 * x1 + c2 * x2 + c3 * x3);
        x0 = x1; x1 = x2; x2 = x3;
        if (which == 0) qv[jj] = o; else if (which == 1) kv[jj] = o; else vb[(j0 + jj) * 72 + d] = f2bf(o);
      }
    }
    if (wv == 0) {
      const float be = sigmoidf_(bf2f(zbeta_raw));
      float lg = -__expf(p.gdn_alog[l * 4 + h]) * softplusf_(bf2f(za_raw) + p.gdn_dtb[l * 4 + h]);
#pragma unroll
      for (int o = 1; o < 64; o <<= 1) { const float n = __shfl_up(lg, o); if (lane >= o) lg += n; }
      betas[lane] = be; bcum[lane] = lg;
    }
    __syncthreads();
    const float bl = bcum[63];
#pragma unroll
    for (int jj = 0; jj < 16; ++jj) {
      const int j = j0 + jj;
      const float rq = rsqrtf(wave_sum(qv[jj] * qv[jj]) + EPS) * 0.125f;
      const float rk = rsqrtf(wave_sum(kv[jj] * kv[jj]) + EPS);
      const float qq = qv[jj] * rq, kk = kv[jj] * rk;
      qn[j * 72 + d] = f2bf(qq); kn[j * 72 + d] = f2bf(kk); kbm[j * 72 + d] = f2bf(kk * betas[j]);
      Qeff[j * 64 + d] = f2bf(qq * __expf(bcum[j]));
      KtT[d * 72 + j] = f2bf(kk * __expf(bl - bcum[j]));
    }
  }
  __syncthreads();
  const int wm = wv & 1, wn = wv >> 1, r = lane & 31, hh = lane >> 5;
  {
    f32x16 acc = mm32((const unsigned char*)(kbm + wm * 32 * 72), 144, (const unsigned char*)(kn + wn * 32 * 72), 144, 4, zero16(), r, hh);
    f32x16 acc2 = mm32((const unsigned char*)(qn + wm * 32 * 72), 144, (const unsigned char*)(kn + wn * 32 * 72), 144, 4, zero16(), r, hh);
    const int jc = wn * 32 + r; const float bj = bcum[jc];
    __syncthreads();
#pragma unroll
    for (int g = 0; g < 4; ++g)
#pragma unroll
      for (int k = 0; k < 4; ++k) {
        const int i = wm * 32 + 8 * g + 4 * hh + k;
        const float dec = (jc <= i) ? __expf(bcum[i] - bj) : 0.f;
        Mf[i * 64 + jc] = (jc < i) ? acc[4 * g + k] * dec : 0.f;
        aqk[i * 72 + jc] = f2bf(acc2[4 * g + k] * dec);
      }
  }
  __syncthreads();
  {
    const int c = tid & 127, j0 = (tid >> 7) * 32;
    const bf16* srcp = (c < 64) ? vb : kn;
    float xr[32];
#pragma unroll
    for (int j = 0; j < 32; ++j) { const float f = (c < 64) ? betas[j0 + j] : betas[j0 + j] * __expf(bcum[j0 + j]); xr[j] = bf2f(srcp[(j0 + j) * 72 + (c & 63)]) * f; }
    __syncthreads();
#pragma unroll
    for (int j = 0; j < 32; ++j) X[(j0 + j) * 128 + c] = xr[j];
  }
  __syncthreads();
  {
    const int g4 = lane >> 4, c16 = lane & 15;
#pragma unroll
    for (int I = 0; I < 4; ++I) {
      if (I > 0) {
        f32x4 acc0 = (f32x4){0.f, 0.f, 0.f, 0.f}, acc1 = acc0;
#pragma unroll
        for (int J = 0; J < I; ++J) {
#pragma unroll
          for (int kk = 0; kk < 4; ++kk) {
            const float av = Mf[(16 * I + c16) * 64 + 16 * J + 4 * kk + g4];
            const float b0 = X[(16 * J + 4 * kk + g4) * 128 + (2 * wv) * 16 + c16];
            const float b1 = X[(16 * J + 4 * kk + g4) * 128 + (2 * wv + 1) * 16 + c16];
            acc0 = __builtin_amdgcn_mfma_f32_16x16x4f32(av, b0, acc0, 0, 0, 0);
            acc1 = __builtin_amdgcn_mfma_f32_16x16x4f32(av, b1, acc1, 0, 0, 0);
          }
        }
#pragma unroll
        for (int r4 = 0; r4 < 4; ++r4) {
          X[(16 * I + 4 * g4 + r4) * 128 + (2 * wv) * 16 + c16] -= acc0[r4];
          X[(16 * I + 4 * g4 + r4) * 128 + (2 * wv + 1) * 16 + c16] -= acc1[r4];
        }
        __syncthreads();
      }
      if (tid < 128) {
        float x[16];
#pragma unroll
        for (int r4 = 0; r4 < 16; ++r4) x[r4] = X[(16 * I + r4) * 128 + tid];
#pragma unroll
        for (int r4 = 1; r4 < 16; ++r4) {
          const float* mr = Mf + (16 * I + r4) * 64 + 16 * I;
          float a0 = x[r4];
#pragma unroll
          for (int qb = 0; qb < (r4 + 3) / 4; ++qb) {
            const f32x4 m4 = *(const f32x4*)(mr + 4 * qb);
#pragma unroll
            for (int qq = 0; qq < 4; ++qq) if (4 * qb + qq < r4) a0 -= m4[qq] * x[4 * qb + qq];
          }
          x[r4] = a0;
        }
#pragma unroll
        for (int r4 = 0; r4 < 16; ++r4) X[(16 * I + r4) * 128 + tid] = x[r4];
      }
      __syncthreads();
    }
  }
  {
    float xr[64];
    const int c = tid & 127;
    if (tid < 128) {
#pragma unroll
      for (int j = 0; j < 64; ++j) xr[j] = X[j * 128 + c];
    }
    __syncthreads();
    if (tid < 128) {
      bf16* dst = (tid < 64 ? UT : WT) + (tid & 63) * 72;
#pragma unroll
      for (int j = 0; j < 64; j += 8) {
        u32x4 w; w.x = pk_bf16(xr[j], xr[j + 1]); w.y = pk_bf16(xr[j + 2], xr[j + 3]); w.z = pk_bf16(xr[j + 4], xr[j + 5]); w.w = pk_bf16(xr[j + 6], xr[j + 7]);
        *(u32x4*)(dst + j) = w;
      }
    }
  }
  __syncthreads();
  {
    const float bl = bcum[63];
    u32x2 qpre[4];
#pragma unroll
    for (int g = 0; g < 4; ++g) qpre[g] = *(const u32x2*)(Qeff + (wn * 32 + r) * 64 + wm * 32 + 8 * g + 4 * hh);
    f32x16 a1 = mm32((const unsigned char*)(WT + wm * 32 * 72), 144, (const unsigned char*)(aqk + wn * 32 * 72), 144, 4, zero16(), r, hh);
    f32x16 a2 = mm32((const unsigned char*)(UT + wm * 32 * 72), 144, (const unsigned char*)(aqk + wn * 32 * 72), 144, 4, zero16(), r, hh);
    f32x16 a3 = mm32((const unsigned char*)(WT + wm * 32 * 72), 144, (const unsigned char*)(KtT + wn * 32 * 72), 144, 4, zero16(), r, hh);
    f32x16 a4 = mm32((const unsigned char*)(KtT + wm * 32 * 72), 144, (const unsigned char*)(UT + wn * 32 * 72), 144, 4, zero16(), r, hh);
    const int cidx = wn * 32 + r;
    const float ebl = __expf(bl);
#pragma unroll
    for (int g = 0; g < 4; ++g) {
      const int rb = wm * 32 + 8 * g + 4 * hh;
      const u32x2 qraw = qpre[g];
      u32x2 w;
      w.x = pk_bf16(bflo(qraw.x) - a1[4 * g], bfhi(qraw.x) - a1[4 * g + 1]);
      w.y = pk_bf16(bflo(qraw.y) - a1[4 * g + 2], bfhi(qraw.y) - a1[4 * g + 3]);
      *(u32x2*)(Qeff + cidx * 64 + rb) = w;
      w.x = pk_bf16(a2[4 * g], a2[4 * g + 1]); w.y = pk_bf16(a2[4 * g + 2], a2[4 * g + 3]);
      *(u32x2*)(Oloc + cidx * 64 + rb) = w;
      f32x4 av;
#pragma unroll
      for (int k = 0; k < 4; ++k) av[k] = ((rb + k) == cidx ? ebl : 0.f) - a3[4 * g + k];
      *(f32x4*)(Ac + cidx * 64 + rb) = av;
      w.x = pk_bf16(a4[4 * g], a4[4 * g + 1]); w.y = pk_bf16(a4[4 * g + 2], a4[4 * g + 3]);
      *(u32x2*)(BT + cidx * 64 + rb) = w;
    }
  }
  __syncthreads();
}

DI void gdn_scan_item(const Params& p, int b, int h, int es, unsigned char* lds, int tid) {
  const float* AcB = (const float*)(p.ws + OFF_AR + AR_ACD);
  bf16* BTB = (bf16*)(p.ws + OFF_AR + AR_BTD);
  const int lane = tid & 63, w = tid >> 6, g = lane >> 4, c16 = lane & 15;
  float* stl = (float*)lds;
  for (int i = tid; i < 2 * 16 * 68; i += 256) stl[i] = 0.f;
  __syncthreads();
  f32x4 cur = (f32x4){0.f, 0.f, 0.f, 0.f};
  f32x4 bq[4][4]; bf16 bt[4][4];
  const size_t ci0 = ((size_t)(b * 128) * 4 + h);
  const float* apb = AcB + ci0 * 4096 + (16 * w + c16) * 64 + 16 * g;
  bf16* btb = BTB + ci0 * 4096 + (es * 16 + 4 * g) * 64 + 16 * w + c16;
#pragma unroll
  for (int s4 = 0; s4 < 4; ++s4) {
#pragma unroll
    for (int k = 0; k < 4; ++k) bq[s4][k] = *(const f32x4*)(apb + (size_t)s4 * 4 * 4096 + 4 * k);
#pragma unroll
    for (int k = 0; k < 4; ++k) bt[s4][k] = btb[(size_t)s4 * 4 * 4096 + k * 64];
  }
  for (int c0 = 0; c0 < 128; c0 += 4) {
    const bool pf = (c0 + 4 < 128);
#pragma unroll
    for (int s4 = 0; s4 < 4; ++s4) {
      const int c = c0 + s4;
      const size_t co = (size_t)c * 4 * 4096;
#pragma unroll
      for (int k = 0; k < 4; ++k) btb[co + k * 64] = f2bf(cur[k]);
      const float* sc = stl + (s4 & 1) * 16 * 68;
      f32x4 aq[4];
#pragma unroll
      for (int k = 0; k < 4; ++k) aq[k] = *(const f32x4*)(sc + c16 * 68 + 16 * g + 4 * k);
      f32x4 acc[4];
      acc[0] = (f32x4){bf2f(bt[s4][0]), bf2f(bt[s4][1]), bf2f(bt[s4][2]), bf2f(bt[s4][3])};
      acc[1] = (f32x4){0.f, 0.f, 0.f, 0.f}; acc[2] = acc[1]; acc[3] = acc[1];
#pragma unroll
      for (int q = 0; q < 4; ++q)
#pragma unroll
        for (int k = 0; k < 4; ++k) acc[k] = __builtin_amdgcn_mfma_f32_16x16x4f32(aq[k][q], bq[s4][k][q], acc[k], 0, 0, 0);
      cur = (acc[0] + acc[1]) + (acc[2] + acc[3]);
      if (pf) {
#pragma unroll
        for (int k = 0; k < 4; ++k) bq[s4][k] = *(const f32x4*)(apb + co + (size_t)4 * 4 * 4096 + 4 * k);
#pragma unroll
        for (int k = 0; k < 4; ++k) bt[s4][k] = btb[co + (size_t)4 * 4 * 4096 + k * 64];
      }
      float* sn = stl + ((s4 + 1) & 1) * 16 * 68;
#pragma unroll
      for (int k = 0; k < 4; ++k) sn[(4 * g + k) * 68 + 16 * w + c16] = cur[k];
      __syncthreads();
    }
  }
}

DI void gdn_out_item(const Params& p, int l, int ci, unsigned char* lds, int tid) {
  const bf16* z = (const bf16*)(p.ws + OFF_AR + AR_Z);
  const bf16* ST = (const bf16*)(p.ws + OFF_AR + AR_BTD) + (size_t)ci * 4096;
  const bf16* Qeff = (const bf16*)(p.ws + OFF_AR + AR_QEFF) + (size_t)ci * 4096;
  const bf16* Oloc = (const bf16*)(p.ws + OFF_AR + AR_OLOC) + (size_t)ci * 4096;
  bf16* mix = (bf16*)(p.ws + OFF_AR + AR_MIX);
  const int h = ci & 3, t0 = (ci >> 2) * 64;
  float* obuf = (float*)lds;
  unsigned char* ql = lds + 17408;
  unsigned char* sl = ql + 9216;
  const u32x4* gpre = (const u32x4*)(z + (size_t)(t0 + (tid >> 2)) * ZLD + ZD_Z + h * 64 + (tid & 3) * 16);
  const u32x4 gq0 = gpre[0], gq1 = gpre[1];
  const u32x4* apre = (const u32x4*)(Oloc + (tid >> 2) * 64 + (tid & 3) * 16);
  const u32x4 aq0 = apre[0], aq1 = apre[1];
#pragma unroll
  for (int id = tid; id < 512; id += 256) {
    const int rr = id >> 3, ch = id & 7;
    *(u32x4*)(ql + rr * 144 + ch * 16) = *(const u32x4*)(Qeff + rr * 64 + ch * 8);
    *(u32x4*)(sl + rr * 144 + ch * 16) = *(const u32x4*)(ST + rr * 64 + ch * 8);
  }
  __syncthreads();
  const int lane = tid & 63, wv = tid >> 6, wm = wv & 1, wn = wv >> 1, r = lane & 31, hh = lane >> 5;
  {
    f32x16 acc = mm32(ql + wm * 32 * 144, 144, sl + wn * 32 * 144, 144, 4, zero16(), r, hh);
    const int e = wn * 32 + r;
#pragma unroll
    for (int g = 0; g < 4; ++g)
#pragma unroll
      for (int k = 0; k < 4; ++k) obuf[(wm * 32 + 8 * g + 4 * hh + k) * 68 + e] = acc[4 * g + k];
  }
  __syncthreads();
  norm_gate_store<false>(obuf, true, aq0, aq1, p.gdn_ng + l * 64, gq0, gq1, mix + (size_t)t0 * 1024 + 768 + h * 64, tid);
  __syncthreads();
}

DI void mla_proj_item(const Params& p, int l, int tile, unsigned char* lds, int tid) {
  const bf16* z = (const bf16*)(p.ws + OFF_AR + AR_Z);
  const bf16* Wl = (const bf16*)(p.ws + OFF_W) + (size_t)l * WL_E;
  const bf16* Wuq = Wl + WO_UQ;
  const bf16* Wukv = Wl + WO_UKV;
  bf16* Qg = (bf16*)(p.ws + OFF_AR + AR_Q);
  bf16* Kg = (bf16*)(p.ws + OFF_AR + AR_K);
  bf16* Vt = (bf16*)(p.ws + OFF_AR + AR_VT);
  const int t0 = tile * 64, b = t0 / S_, s0 = t0 % S_;
  unsigned char* Aq = lds;
  unsigned char* Akv = lds + 33792;
  float* rsq = (float*)(lds + 33792 + 17408);
  float* rskv = rsq + 64;
#pragma unroll
  for (int id = tid; id < 64 * 32; id += 256) { const int rr = id >> 5, ch = id & 31; *(u32x4*)(Aq + rr * 528 + ch * 16) = *(const u32x4*)(z + (size_t)(t0 + rr) * ZLD + ZC_Q + ch * 8); }
#pragma unroll
  for (int id = tid; id < 64 * 16; id += 256) { const int rr = id >> 4, ch = id & 15; *(u32x4*)(Akv + rr * 272 + ch * 16) = *(const u32x4*)(z + (size_t)(t0 + rr) * ZLD + ZC_KV + ch * 8); }
  bf16 kr1[4], kr2[4];
#pragma unroll
  for (int k = 0; k < 4; ++k) { const int id = tid + 256 * k, m = id >> 4, i2 = id & 15; kr1[k] = z[(size_t)(t0 + m) * ZLD + ZC_KR + i2]; kr2[k] = z[(size_t)(t0 + m) * ZLD + ZC_KR + 16 + i2]; }
  __syncthreads();
  {
    const int rr = tid >> 2, qd = tid & 3;
    float s1 = 0.f, s2 = 0.f;
#pragma unroll
    for (int k = 0; k < 8; ++k) { const u32x4 u = *(const u32x4*)(Aq + rr * 528 + qd * 128 + k * 16);
#pragma unroll
      for (int i = 0; i < 4; ++i) { const float a = bflo(u[i]), b = bfhi(u[i]); s1 += a * a + b * b; } }
#pragma unroll
    for (int k = 0; k < 4; ++k) { const u32x4 u = *(const u32x4*)(Akv + rr * 272 + qd * 64 + k * 16);
#pragma unroll
      for (int i = 0; i < 4; ++i) { const float a = bflo(u[i]), b = bfhi(u[i]); s2 += a * a + b * b; } }
    s1 += __shfl_xor(s1, 1); s1 += __shfl_xor(s1, 2); s2 += __shfl_xor(s2, 1); s2 += __shfl_xor(s2, 2);
    if (qd == 0) { rsq[rr] = rsqrtf(s1 * (1.f / 256.f) + EPS); rskv[rr] = rsqrtf(s2 * (1.f / 128.f) + EPS); }
#pragma unroll
    for (int id = tid; id < 1024; id += 256) {
      const int m = id >> 4, i = id & 15;
      const float inv = __builtin_amdgcn_exp2f(-(float)i * (13.287712379549449f / 16.f));
      const float ang = (float)(s0 + m) * inv;
      const double rev = (double)ang * 0.15915494309189535;
      const float fr = (float)(rev - floor(rev));
      const float sn = __builtin_amdgcn_sinf(fr), cs = __builtin_amdgcn_cosf(fr);
      const float x1 = bf2f(kr1[id >> 8]), x2 = bf2f(kr2[id >> 8]);
      const bf16 o1 = f2bf(x1 * cs - x2 * sn), o2 = f2bf(x2 * cs + x1 * sn);
      { bf16* krl = (bf16*)(lds + 51712); krl[m * 32 + i] = o1; krl[m * 32 + 16 + i] = o2; }
    }
  }
  __syncthreads();
  const int lane = tid & 63, hd = tid >> 6, r = lane & 31, hh = lane >> 5;
  const float QS = 0.10206207261596575f * 1.4426950408889634f;
  {
    f32x16 acc[3][2];
#pragma unroll
    for (int i = 0; i < 3; ++i) { acc[i][0] = zero16(); acc[i][1] = zero16(); }
#pragma unroll 4
    for (int kk = 0; kk < 16; ++kk) {
      bf16x8 af[2], bw[3];
#pragma unroll
      for (int mi = 0; mi < 2; ++mi) af[mi] = *(const bf16x8*)(Aq + (mi * 32 + r) * 528 + kk * 32 + hh * 16);
#pragma unroll
      for (int ni = 0; ni < 3; ++ni) bw[ni] = *(const bf16x8*)(Wuq + ((size_t)(((hd * 16 + kk) * 3 + ni) * 64 + lane)) * 8);
#pragma unroll
      for (int ni = 0; ni < 3; ++ni)
#pragma unroll
        for (int mi = 0; mi < 2; ++mi) acc[ni][mi] = MFMA32(bw[ni], af[mi], acc[ni][mi]);
    }
    __syncthreads();
    unsigned char* wbuf = lds + hd * 6400;
#pragma unroll
    for (int mi = 0; mi < 2; ++mi) {
      const int m = mi * 32 + r;
      const float sc = rsq[m] * QS;
      bf16* qp = (bf16*)(wbuf + r * 200);
#pragma unroll
      for (int ni = 0; ni < 2; ++ni)
#pragma unroll
        for (int g = 0; g < 4; ++g) {
          u32x2 w; w.x = pk_bf16(acc[ni][mi][4 * g] * sc, acc[ni][mi][4 * g + 1] * sc); w.y = pk_bf16(acc[ni][mi][4 * g + 2] * sc, acc[ni][mi][4 * g + 3] * sc);
          *(u32x2*)(qp + ni * 32 + 8 * g + 4 * hh) = w;
        }
#pragma unroll
      for (int g = 0; g < 2; ++g) {
        float o1[4], o2[4];
#pragma unroll
        for (int k = 0; k < 4; ++k) {
          const int i = 8 * g + 4 * hh + k;
          const float inv = __builtin_amdgcn_exp2f(-(float)i * (13.287712379549449f / 16.f));
          const float ang = (float)(s0 + m) * inv;
          const double rev = (double)ang * 0.15915494309189535;
          const float fr = (float)(rev - floor(rev));
          const float sn = __builtin_amdgcn_sinf(fr), cs = __builtin_amdgcn_cosf(fr);
          const float x1 = acc[2][mi][4 * g + k] * sc, x2 = acc[2][mi][4 * (g + 2) + k] * sc;
          o1[k] = x1 * cs - x2 * sn; o2[k] = x2 * cs + x1 * sn;
        }
        u32x2 w; w.x = pk_bf16(o1[0], o1[1]); w.y = pk_bf16(o1[2], o1[3]);
        *(u32x2*)(qp + 64 + 8 * g + 4 * hh) = w;
        w.x = pk_bf16(o2[0], o2[1]); w.y = pk_bf16(o2[2], o2[3]);
        *(u32x2*)(qp + 80 + 8 * g + 4 * hh) = w;
      }
#pragma unroll
      for (int k = 0; k < 6; ++k) {
        const int id = lane + 64 * k, row = id / 12, ch = id % 12;
        const u32x2 lo = *(const u32x2*)(wbuf + row * 200 + ch * 16), hi = *(const u32x2*)(wbuf + row * 200 + ch * 16 + 8);
        *(u32x4*)(Qg + ((size_t)(b * 4 + hd) * S_ + s0 + mi * 32 + row) * 96 + ch * 8) = (u32x4){lo.x, lo.y, hi.x, hi.y};
      }
    }
  }
  {
    f32x16 acc[2][2];
#pragma unroll
    for (int i = 0; i < 2; ++i) { acc[i][0] = zero16(); acc[i][1] = zero16(); }
#pragma unroll
    for (int kk = 0; kk < 8; ++kk) {
      bf16x8 af[2], bw[2];
#pragma unroll
      for (int mi = 0; mi < 2; ++mi) af[mi] = *(const bf16x8*)(Akv + (mi * 32 + r) * 272 + kk * 32 + hh * 16);
#pragma unroll
      for (int ni = 0; ni < 2; ++ni) bw[ni] = *(const bf16x8*)(Wukv + ((size_t)((((hd * 2 + 0) * 8 + kk) * 2 + ni) * 64 + lane)) * 8);
#pragma unroll
      for (int ni = 0; ni < 2; ++ni)
#pragma unroll
        for (int mi = 0; mi < 2; ++mi) acc[ni][mi] = MFMA32(bw[ni], af[mi], acc[ni][mi]);
    }
    unsigned char* wbuf = lds + hd * 6400;
    const unsigned char* krl = lds + 51712;
#pragma unroll
    for (int mi = 0; mi < 2; ++mi) {
      const int m = mi * 32 + r;
      const float sc = rskv[m];
      bf16* kp = (bf16*)(wbuf + r * 200);
#pragma unroll
      for (int ni = 0; ni < 2; ++ni)
#pragma unroll
        for (int g = 0; g < 4; ++g) {
          u32x2 w; w.x = pk_bf16(acc[ni][mi][4 * g] * sc, acc[ni][mi][4 * g + 1] * sc); w.y = pk_bf16(acc[ni][mi][4 * g + 2] * sc, acc[ni][mi][4 * g + 3] * sc);
          *(u32x2*)(kp + ni * 32 + 8 * g + 4 * hh) = w;
        }
#pragma unroll
      for (int k = 0; k < 6; ++k) {
        const int id = lane + 64 * k, row = id / 12, ch = id % 12;
        const unsigned char* src = (ch < 8) ? (wbuf + row * 200 + ch * 16) : (krl + (mi * 32 + row) * 64 + (ch - 8) * 16);
        const u32x2 lo = *(const u32x2*)src, hi = *(const u32x2*)(src + 8);
        *(u32x4*)(Kg + ((size_t)(b * 4 + hd) * S_ + s0 + mi * 32 + row) * 96 + ch * 8) = (u32x4){lo.x, lo.y, hi.x, hi.y};
      }
    }
  }
  {
    f32x16 acc[2][2];
#pragma unroll
    for (int i = 0; i < 2; ++i) { acc[i][0] = zero16(); acc[i][1] = zero16(); }
#pragma unroll
    for (int kk = 0; kk < 8; ++kk) {
      bf16x8 af[2], bw[2];
#pragma unroll
      for (int mi = 0; mi < 2; ++mi) af[mi] = *(const bf16x8*)(Akv + (mi * 32 + r) * 272 + kk * 32 + hh * 16);
#pragma unroll
      for (int ni = 0; ni < 2; ++ni) bw[ni] = *(const bf16x8*)(Wukv + ((size_t)((((hd * 2 + 1) * 8 + kk) * 2 + ni) * 64 + lane)) * 8);
#pragma unroll
      for (int mi = 0; mi < 2; ++mi)
#pragma unroll
        for (int ni = 0; ni < 2; ++ni) acc[mi][ni] = MFMA32(af[mi], bw[ni], acc[mi][ni]);
    }
#pragma unroll
    for (int ni = 0; ni < 2; ++ni) {
      unsigned char* wbuf = lds + hd * 6400;
      bf16* vp = (bf16*)(wbuf + r * 136);
#pragma unroll
      for (int mi = 0; mi < 2; ++mi)
#pragma unroll
        for (int g = 0; g < 4; ++g) {
          const int m = mi * 32 + 8 * g + 4 * hh;
          u32x2 w; w.x = pk_bf16(acc[mi][ni][4 * g] * rskv[m], acc[mi][ni][4 * g + 1] * rskv[m + 1]); w.y = pk_bf16(acc[mi][ni][4 * g + 2] * rskv[m + 2], acc[mi][ni][4 * g + 3] * rskv[m + 3]);
          *(u32x2*)(vp + m) = w;
        }
#pragma unroll
      for (int k = 0; k < 4; ++k) {
        const int id = lane + 64 * k, row = id >> 3, ch = id & 7;
        const u32x2 lo = *(const u32x2*)(wbuf + row * 136 + ch * 16), hi = *(const u32x2*)(wbuf + row * 136 + ch * 16 + 8);
        *(u32x4*)(Vt + ((size_t)(b * 4 + hd) * 64 + ni * 32 + row) * S_ + s0 + ch * 8) = (u32x4){lo.x, lo.y, hi.x, hi.y};
      }
    }
  }
  __syncthreads();
}

DI void attn_item(const Params& p, int bh, int qb, unsigned char* lds, int tid) {
  const bf16* Qg = (const bf16*)(p.ws + OFF_AR + AR_Q) + (size_t)bh * S_ * 96;
  const bf16* Kg = (const bf16*)(p.ws + OFF_AR + AR_K) + (size_t)bh * S_ * 96;
  const bf16* Vt = (const bf16*)(p.ws + OFF_AR + AR_VT) + (size_t)bh * 64 * S_;
  bf16* mix = (bf16*)(p.ws + OFF_AR + AR_MIX);
  const int lane = tid & 63, w = tid >> 6, r = lane & 31, hh = lane >> 5;
  const int q0 = qb * 128, qrow = q0 + 32 * w + r;
  const int ntiles = 2 * qb + 2;
  constexpr int STG = 64 * 208 + 64 * 144;
  bf16x8 qf[6];
#pragma unroll
  for (int kk = 0; kk < 6; ++kk) qf[kk] = *(const bf16x8*)(Qg + (size_t)qrow * 96 + kk * 16 + hh * 8);
  f32x16 ot[2] = {zero16(), zero16()};
  float mrun = -1e30f, lrun = 0.f;
  u32x4 rk[3], rv[2];
  int krow[3], kch[3];
#pragma unroll
  for (int i = 0; i < 3; ++i) { const int id = tid + 256 * i; krow[i] = id / 12; kch[i] = id % 12; }
  const int vrow0 = tid >> 3, vch = tid & 7;
#pragma unroll
  for (int i = 0; i < 3; ++i) rk[i] = *(const u32x4*)(Kg + (size_t)krow[i] * 96 + kch[i] * 8);
#pragma unroll
  for (int i = 0; i < 2; ++i) rv[i] = *(const u32x4*)(Vt + (size_t)(vrow0 + 32 * i) * S_ + vch * 8);
  __syncthreads();
#pragma unroll
  for (int i = 0; i < 3; ++i) *(u32x4*)(lds + krow[i] * 208 + kch[i] * 16) = rk[i];
#pragma unroll
  for (int i = 0; i < 2; ++i) *(u32x4*)(lds + 13312 + (vrow0 + 32 * i) * 144 + vch * 16) = rv[i];
  __syncthreads();
  for (int kt = 0; kt < ntiles; ++kt) {
    const unsigned char* Ks = lds + (kt & 1) * STG;
    const unsigned char* Vs = Ks + 13312;
    if (kt + 1 < ntiles) {
#pragma unroll
      for (int i = 0; i < 3; ++i) rk[i] = *(const u32x4*)(Kg + (size_t)((kt + 1) * 64 + krow[i]) * 96 + kch[i] * 8);
#pragma unroll
      for (int i = 0; i < 2; ++i) rv[i] = *(const u32x4*)(Vt + (size_t)(vrow0 + 32 * i) * S_ + (kt + 1) * 64 + vch * 8);
    }
    if (kt * 64 <= q0 + 32 * w + 31) {
      f32x16 st[2];
#pragma unroll
      for (int k2 = 0; k2 < 2; ++k2) {
        st[k2] = zero16();
#pragma unroll
        for (int kk = 0; kk < 6; ++kk) {
          bf16x8 kf = *(const bf16x8*)(Ks + (k2 * 32 + r) * 208 + kk * 32 + hh * 16);
          st[k2] = MFMA32(kf, qf[kk], st[k2]);
        }
      }
      if (kt * 64 + 63 > q0 + 32 * w) {
#pragma unroll
        for (int k2 = 0; k2 < 2; ++k2)
#pragma unroll
          for (int g = 0; g < 4; ++g)
#pragma unroll
            for (int k = 0; k < 4; ++k) {
              const int key = kt * 64 + k2 * 32 + 8 * g + 4 * hh + k;
              if (key > qrow) st[k2][4 * g + k] = -1e30f;
            }
      }
      float mt = st[0][0];
#pragma unroll
      for (int k2 = 0; k2 < 2; ++k2)
#pragma unroll
        for (int i = 0; i < 16; ++i) mt = fmaxf(mt, st[k2][i]);
      mt = fmaxf(mt, __shfl_xor(mt, 32));
      const float mnew = fmaxf(mrun, mt);
      const float alpha = __builtin_amdgcn_exp2f(mrun - mnew);
      mrun = mnew;
      float ls = 0.f;
#pragma unroll
      for (int k2 = 0; k2 < 2; ++k2)
#pragma unroll
        for (int i = 0; i < 16; ++i) { const float pv = __builtin_amdgcn_exp2f(st[k2][i] - mnew); st[k2][i] = pv; ls += pv; }
      lrun = lrun * alpha + ls;
      if (__any(alpha != 1.f)) {
#pragma unroll
        for (int dt = 0; dt < 2; ++dt)
#pragma unroll
          for (int i = 0; i < 16; ++i) ot[dt][i] *= alpha;
      }
#pragma unroll
      for (int k2 = 0; k2 < 2; ++k2)
#pragma unroll
        for (int s = 0; s < 2; ++s) {
          u32x4 pw;
          pw.x = pk_bf16(st[k2][8 * s], st[k2][8 * s + 1]); pw.y = pk_bf16(st[k2][8 * s + 2], st[k2][8 * s + 3]);
          pw.z = pk_bf16(st[k2][8 * s + 4], st[k2][8 * s + 5]); pw.w = pk_bf16(st[k2][8 * s + 6], st[k2][8 * s + 7]);
          const bf16x8 pf = __builtin_bit_cast(bf16x8, pw);
#pragma unroll
          for (int dt = 0; dt < 2; ++dt) {
            const unsigned char* vp = Vs + (dt * 32 + r) * 144 + (k2 * 32 + s * 16 + 4 * hh) * 2;
            u32x2 v0 = *(const u32x2*)vp, v1 = *(const u32x2*)(vp + 16);
            u32x4 vw = (u32x4){v0.x, v0.y, v1.x, v1.y};
            ot[dt] = MFMA32(__builtin_bit_cast(bf16x8, vw), pf, ot[dt]);
          }
        }
    }
    if (kt + 1 < ntiles) {
      unsigned char* Kw = lds + ((kt + 1) & 1) * STG;
#pragma unroll
      for (int i = 0; i < 3; ++i) *(u32x4*)(Kw + krow[i] * 208 + kch[i] * 16) = rk[i];
#pragma unroll
      for (int i = 0; i < 2; ++i) *(u32x4*)(Kw + 13312 + (vrow0 + 32 * i) * 144 + vch * 16) = rv[i];
    }
    __syncthreads();
  }
  const float lt = lrun + __shfl_xor(lrun, 32);
  const float inv = 1.f / lt;
  const int b = bh >> 2, hd = bh & 3;
  bf16* op = mix + ((size_t)b * S_ + qrow) * 1024 + 512 + hd * 64;
#pragma unroll
  for (int dt = 0; dt < 2; ++dt)
#pragma unroll
    for (int g = 0; g < 4; ++g) {
      u32x2 wv; wv.x = pk_bf16(ot[dt][4 * g] * inv, ot[dt][4 * g + 1] * inv); wv.y = pk_bf16(ot[dt][4 * g + 2] * inv, ot[dt][4 * g + 3] * inv);
      *(u32x2*)(op + dt * 32 + 8 * g + 4 * hh) = wv;
    }
}

DI void grid_bar(unsigned* flags, unsigned k) {
  asm volatile("s_waitcnt vmcnt(0) lgkmcnt(0)" ::: "memory");
  __syncthreads();
  if (threadIdx.x == 0) { __threadfence(); __hip_atomic_store(flags + blockIdx.x, k, __ATOMIC_RELAXED, __HIP_MEMORY_SCOPE_AGENT); }
  const unsigned nb = gridDim.x;
  for (;;) {
    int ok = 1;
    for (unsigned i = threadIdx.x; i < nb; i += blockDim.x) ok &= (__hip_atomic_load(flags + i, __ATOMIC_RELAXED, __HIP_MEMORY_SCOPE_AGENT) >= k) ? 1 : 0;
    if (__syncthreads_and(ok)) break;
    __builtin_amdgcn_s_sleep(1);
  }
  if (threadIdx.x == 0) __threadfence();
  __syncthreads();
}
__global__ void __launch_bounds__(512, 2) fwd_megakernel(Params p0) {
  extern __shared__ __attribute__((aligned(16))) unsigned char lds_all[];
  __shared__ int s_item;
  cg::grid_group grid = cg::this_grid();
  unsigned nbar = 0;
  const int nvb = gridDim.x * 2;
#define GBAR() do { nbar += 1; grid_bar((unsigned*)(p0.ws + OFF_CTL) + 256, nbar); } while (0)
#define PH_BEGIN() Params q = p0; { unsigned long long w_ = (unsigned long long)q.ws; asm volatile("" : "+s"(w_)); q.ws = (unsigned char*)w_; } int tid5 = threadIdx.x; asm volatile("" : "+v"(tid5)); const int tid = tid5 & 255, half = tid5 >> 8, vb = blockIdx.x * 2 + half; unsigned char* lds = lds_all + half * LDS_HALF; (void)vb; (void)lds; \
  unsigned char* ws = q.ws; bf16* W = (bf16*)(ws + OFF_W); float* rs = (float*)(ws + OFF_RS); bf16* zb = (bf16*)(ws + OFF_AR + AR_Z); bf16* yb = (bf16*)(ws + OFF_AR + AR_Y); \
  bf16* up = (bf16*)(ws + OFF_AR + AR_UP); bf16* mix = (bf16*)(ws + OFF_AR + AR_MIX); bf16* xb = mix; unsigned* ctl = (unsigned*)(ws + OFF_CTL); \
  const bf16* Wl = W + (size_t)l * WL_E; (void)rs; (void)zb; (void)yb; (void)up; (void)mix; (void)xb; (void)ctl; (void)Wl; (void)tid; (void)tid5;
  { const int l = 0; PH_BEGIN(); phase0(q, lds, tid, half); }
  { const int l = 0; PH_BEGIN(); resid_phase(q.x, nullptr, nullptr, nullptr, nullptr, xb, rs, tid, vb, nvb); }
  if (p0.ws == nullptr) grid.sync();
  GBAR();

  for (int l = 0; l < 2; ++l) {
    { PH_BEGIN(); EpiStore e{zb, zb, 1 << 30, ZLD, rs, nullptr}; gemm_phase<false>(l == 0 ? xb : (const bf16*)q.out, 1024, Wl + WO_IN, 1024, 1024, 128, 13, e, lds_all, tid5); }
    GBAR();
    for (int pi = blockIdx.x; pi < (2048 * 3 + 512) / 2; pi += gridDim.x) {
      PH_BEGIN();
      const int it = 2 * pi + half;
      if (it < 2048) gdn_local_item(q, l, it, lds, tid);
      else if (it < 4096) gla_local_item<64, true>(q, l, it - 2048, lds, tid);
      else if (it < 6144) gla_local_item<32, false>(q, l, it - 4096, lds, tid);
      else mla_proj_item(q, l, it - 6144, lds, tid);
    }
    GBAR();
    for (;;) {
      PH_BEGIN();
      if (tid5 == 0) s_item = (int)atomicAdd(&ctl[l], 1u);
      __syncthreads();
      const int pit = s_item;
      __syncthreads();
      if (pit >= 80 + 512) break;
      if (pit < 32) { const int it = 2 * pit + half; gdn_scan_item(q, it >> 4, (it >> 2) & 3, it & 3, lds, tid); }
      else if (pit < 64) { const int j = 2 * (pit - 32) + half; gla_scan_item<64>((bf16*)(ws + OFF_AR + AR_UTA), (const float*)(ws + OFF_GA), j >> 4, (j >> 2) & 3, j & 3, tid); }
      else if (pit < 80) { const int j = 2 * (pit - 64) + half; gla_scan_item<32>((bf16*)(ws + OFF_AR + AR_UTB), (const float*)(ws + OFF_GB), j >> 3, (j >> 1) & 3, j & 1, tid); }
      else { const int a = pit - 80; attn_item(q, 2 * (a & 7) + half, 63 - (a >> 3), lds, tid); }
    }
    GBAR();
    for (int pi = blockIdx.x; pi < 2048 * 3 / 2; pi += gridDim.x) {
      PH_BEGIN();
      const int it = 2 * pi + half;
      if (it < 2048) gdn_out_item(q, l, it, lds, tid);
      else if (it < 4096) gla_out_item<64, true>(q, l, it - 2048, lds, tid);
      else gla_out_item<32, false>(q, l, it - 4096, lds, tid);
    }
    GBAR();
    { PH_BEGIN(); EpiStore e{yb, yb, 1 << 30, 1024, nullptr, nullptr}; gemm_phase<false>(mix, 1024, Wl + WO_OUT, 1024, 1024, 128, 4, e, lds_all, tid5); }
    GBAR();
    { PH_BEGIN(); resid_phase(l == 0 ? q.x : nullptr, (const bf16*)q.out, yb, q.post_mix_g + l * 1024, nullptr, xb, rs, tid, vb, nvb); }
    GBAR();
    { PH_BEGIN(); EpiStore e{up, up, 1 << 30, FF, rs, q.ffn_conv + (size_t)l * 3 * FF}; gemm_phase<true>(xb, 1024, Wl + WO_GU, 1024, 1024, 136, 22, e, lds_all, tid5); }
    GBAR();
    { PH_BEGIN(); EpiStore e{yb, yb, 1 << 30, 1024, nullptr, nullptr}; gemm_phase<false>(up, FF, Wl + WO_DN, FF, FF, 128, 4, e, lds_all, tid5); }
    GBAR();
    { PH_BEGIN(); resid_phase(nullptr, xb, yb, q.post_ffn_g + l * 1024, l == 1 ? q.out : nullptr, l == 1 ? nullptr : (bf16*)q.out, rs, tid, vb, nvb); }
    GBAR();
  }
}

extern "C" void kernel_launch(void* const* d_in, const int* in_sizes, int n_in, void* d_out, int out_size, void* d_ws, size_t ws_size, hipStream_t stream) {
  static int grid_blocks = 0;
  if (!grid_blocks) {
    int dev = 0, cus = 0, per_cu = 0;
    hipGetDevice(&dev);
    hipDeviceGetAttribute(&cus, hipDeviceAttributeMultiprocessorCount, dev);
    hipFuncSetAttribute((const void*)fwd_megakernel, hipFuncAttributeMaxDynamicSharedMemorySize, LDS_BYTES);
    hipOccupancyMaxActiveBlocksPerMultiprocessor(&per_cu, (const void*)fwd_megakernel, 512, LDS_BYTES);
    if (per_cu < 1) per_cu = 1;
    if (per_cu > 1) per_cu = 1;
    grid_blocks = cus * per_cu;
    if (ws_size < WS_END) fprintf(stderr, "kernel_launch: workspace too small: %zu < %zu\n", ws_size, (size_t)WS_END);
  }
  Params p{};
  const float** pp = (const float**)&p;
  for (int i = 0; i < 24; ++i) pp[i] = (const float*)d_in[i];
  p.out = (float*)d_out; p.ws = (unsigned char*)d_ws;
  hipMemsetAsync((unsigned char*)d_ws + OFF_CTL, 0, 8192, stream);
  void* args[] = {&p};
  hipError_t e = hipLaunchCooperativeKernel((const void*)fwd_megakernel, dim3(grid_blocks), dim3(512), args, LDS_BYTES, stream);
  if (e != hipSuccess) fprintf(stderr, "cooperative launch failed: %s (grid %d)\n", hipGetErrorString(e), grid_blocks);
}
```

```cpp
#include <hip/hip_runtime.h>
#include <hip/hip_cooperative_groups.h>
#include <cstdio>
#include <cstdint>
namespace cg = cooperative_groups;

#define DI __device__ __forceinline__
typedef unsigned short bf16;
typedef __attribute__((ext_vector_type(8))) short bf16x8;
typedef __attribute__((ext_vector_type(4))) short bf16x4;
typedef __attribute__((ext_vector_type(16))) float f32x16;
typedef __attribute__((ext_vector_type(4))) float f32x4;
typedef __attribute__((ext_vector_type(4))) unsigned u32x4;
typedef __attribute__((ext_vector_type(2))) unsigned u32x2;

constexpr int T_ = 32768, S_ = 8192, D_ = 1024, ZLD = 3328, FF = 2816, DIN = 3256;
constexpr float EPS = 1e-6f;
constexpr int ZA_Q = 0, ZA_F = 256, ZA_I = 512, ZA_G = 768, ZB_Q = 1024, ZB_K = 1152, ZB_V = 1280, ZB_G = 1536, ZC_Q = 1792, ZC_KV = 2048,
              ZD_Q = 2176, ZD_K = 2432, ZD_V = 2688, ZD_Z = 2944, ZC_KR = 3200, ZB_CODE = 3232, ZD_BETA = 3248, ZD_A = 3252;
constexpr size_t WIN_E = (size_t)ZLD * 1024, WOUT_E = 1024 * 1024, WGU_E = (size_t)2 * FF * 1024, WDN_E = (size_t)1024 * FF, WUQ_E = 384 * 256, WUKV_E = 512 * 128;
constexpr size_t WO_IN = 0, WO_OUT = WO_IN + WIN_E, WO_GU = WO_OUT + WOUT_E, WO_DN = WO_GU + WGU_E, WO_UQ = WO_DN + WDN_E, WO_UKV = WO_UQ + WUQ_E, WL_E = WO_UKV + WUKV_E;
constexpr size_t OFF_W = 0;
constexpr size_t OFF_CTL = OFF_W + 2 * WL_E * 2;
constexpr size_t OFF_RS = OFF_CTL + 8192;
constexpr size_t OFF_GA = OFF_RS + (size_t)T_ * 4;
constexpr size_t OFF_GB = OFF_GA + (size_t)2048 * 64 * 4;
constexpr size_t OFF_AR = OFF_GB + (size_t)2048 * 32 * 4;
constexpr size_t AR_Z = 0, AR_Y = 0, AR_GATE = 0, AR_UP = (size_t)T_ * FF * 2;
constexpr size_t AR_SCAN = (size_t)T_ * ZLD * 2;
constexpr size_t AR_UTA = AR_SCAN, AR_UTB = AR_UTA + (size_t)2048 * 64 * 64 * 2, AR_ACD = AR_UTB + (size_t)2048 * 64 * 32 * 2, AR_BTD = AR_ACD + (size_t)2048 * 4096 * 4,
                 AR_QEFF = AR_BTD + (size_t)2048 * 4096 * 2, AR_OLOC = AR_QEFF + (size_t)2048 * 4096 * 2, AR_MLA = AR_OLOC + (size_t)2048 * 4096 * 2;
constexpr size_t AR_Q = AR_MLA, AR_K = AR_Q + (size_t)T_ * 4 * 96 * 2, AR_VT = AR_K + (size_t)T_ * 4 * 96 * 2, AR_MIX = AR_VT + (size_t)T_ * 4 * 64 * 2;
constexpr size_t AR_END = AR_MIX + (size_t)T_ * 1024 * 2;
constexpr size_t WS_END = OFF_AR + AR_END;
static_assert(WS_END <= (size_t)512 * 1024 * 1024, "workspace too large");
static_assert(AR_UP + (size_t)T_ * FF * 2 <= AR_MIX, "gate/up overlaps xb");

constexpr size_t BC_OFF = (size_t)T_ * 1024 * 2, BC_B_OFF = (size_t)2048 * 64 * 64 * 4;
static_assert(BC_OFF + BC_B_OFF + (size_t)2048 * 64 * 32 * 4 <= (size_t)T_ * 1024 * 4, "decay tables exceed the output buffer");
constexpr int LDS_HALF = 73728, LDS_BYTES = 2 * LDS_HALF;
#ifndef PROBE_DUP
#define PROBE_DUP 0
#endif

struct Params {
  const float* x; const float* w_in; const float* w_out; const float* pre_mix_g; const float* post_mix_g; const float* pre_ffn_g; const float* post_ffn_g;
  const float* hgrn_lb; const float* hgrn_ng; const float* gla_w2; const float* gla_b; const float* gla_ng;
  const float* mla_qg; const float* mla_wuq; const float* mla_kvg; const float* mla_wukv;
  const float* gdn_conv; const float* gdn_alog; const float* gdn_dtb; const float* gdn_ng;
  const float* ffn_wg; const float* ffn_wu; const float* ffn_conv; const float* ffn_wd;
  float* out; unsigned char* ws;
};

typedef __bf16 bf16v2_t __attribute__((ext_vector_type(2)));
typedef float f32v2_t __attribute__((ext_vector_type(2)));
DI unsigned pk_bf16(float lo, float hi) { f32v2_t v = {lo, hi}; bf16v2_t b = __builtin_convertvector(v, bf16v2_t); return __builtin_bit_cast(unsigned, b); }
DI float bf2f(bf16 v) { return __uint_as_float(((unsigned)v) << 16); }
DI bf16 f2bf(float x) { return (bf16)(pk_bf16(x, 0.f) & 0xffffu); }
DI float bflo(unsigned u) { return __uint_as_float(u << 16); }
DI float bfhi(unsigned u) { return __uint_as_float(u & 0xffff0000u); }
DI float sigmoidf_(float x) { return 1.f / (1.f + __expf(-x)); }
DI float siluf_(float x) { return x * sigmoidf_(x); }
DI float softplusf_(float x) { return fmaxf(x, 0.f) + __logf(1.f + __expf(-fabsf(x))); }
DI float wave_sum(float v) {
#pragma unroll
  for (int o = 1; o < 64; o <<= 1) v += __shfl_xor(v, o);
  return v;
}
#define MFMA32(a, b, c) __builtin_amdgcn_mfma_f32_32x32x16_bf16((a), (b), (c), 0, 0, 0)

DI f32x16 mm32(const unsigned char* A, int lda, const unsigned char* B, int ldb, int ks, f32x16 acc, int r, int h) {
  const unsigned char* pa = A + r * lda + h * 16;
  const unsigned char* pb = B + r * ldb + h * 16;
  for (int kk = 0; kk < ks; ++kk) {
    bf16x8 a = *(const bf16x8*)(pa + kk * 32);
    bf16x8 b = *(const bf16x8*)(pb + kk * 32);
    acc = MFMA32(a, b, acc);
  }
  return acc;
}
DI f32x16 zero16() { f32x16 z; for (int i = 0; i < 16; ++i) z[i] = 0.f; return z; }

DI int win_srccol(int n) {
  if (n < 1536) return n;
  if (n < 1792) return 1552 + (n - 1536);
  if (n < 2048) return 1808 + (n - 1792);
  if (n < 2176) return 2064 + (n - 2048);
  if (n < 2432) return 2224 + (n - 2176);
  if (n < 2688) return 2480 + (n - 2432);
  if (n < 2944) return 2736 + (n - 2688);
  if (n < 3200) return 3000 + (n - 2944);
  if (n < 3232) return 2192 + (n - 3200);
  if (n < 3248) return 1536 + (n - 3232);
  if (n < 3252) return 2992 + (n - 3248);
  if (n < 3256) return 2996 + (n - 3252);
  return -1;
}
DI int gu_rowmap(int c, int mode) { return mode == 0 ? c : ((c >> 7) * 256 + (c & 127) + (mode == 2 ? 128 : 0)); }
DI void transpose_tile(const float* __restrict__ src, int ldsrc, int K, bool perm, const float* __restrict__ gain, bf16* __restrict__ dst, int n0, int k0, unsigned char* lds, int tid, int rowmode = 0) {
  bf16* t = (bf16*)lds;
  const int nl = tid & 63, kq = tid >> 6;
  const int sc = perm ? win_srccol(n0 + nl) : (n0 + nl);
  float tv[16];
#pragma unroll
  for (int i = 0; i < 16; ++i) {
    const int k = k0 + kq + 4 * i;
    float v = 0.f;
    if (sc >= 0) { v = src[(size_t)k * ldsrc + sc]; if (gain) v *= gain[k]; }
    tv[i] = v;
  }
#pragma unroll
  for (int i = 0; i < 16; ++i) t[nl * 72 + kq + 4 * i] = f2bf(tv[i]);
  __syncthreads();
  const int r = tid >> 2, c = (tid & 3) * 16;
  u32x4 a = *(const u32x4*)(t + r * 72 + c), b = *(const u32x4*)(t + r * 72 + c + 8);
  bf16* o = dst + (size_t)gu_rowmap(n0 + r, rowmode) * K + k0 + c;
  *(u32x4*)o = a; *(u32x4*)(o + 8) = b;
  __syncthreads();
}

DI void frag_tile(const float* __restrict__ src, int ldsrc, bool isq, const float* __restrict__ gain, bf16* __restrict__ dst, int n0, int k0, int tid) {
  const int n = n0 + (tid & 63), kq = tid >> 6;
#pragma unroll
  for (int gi = 0; gi < 2; ++gi) {
    const int kg = k0 + (kq * 2 + gi) * 8;
    float v[8];
#pragma unroll
    for (int j = 0; j < 8; ++j) v[j] = src[(size_t)(kg + j) * ldsrc + n] * gain[kg + j];
    const int kk = kg >> 4, hh = (kg >> 3) & 1, r = n & 31;
    size_t off;
    if (isq) { const int hd = n / 96, nl = n % 96; off = ((size_t)(((hd * 16 + kk) * 3 + (nl >> 5)) * 64 + hh * 32 + r)) * 8; }
    else { const int hd = n >> 7, nl = n & 127; off = ((size_t)((((hd * 2 + (nl >> 6)) * 8 + kk) * 2 + ((nl >> 5) & 1)) * 64 + hh * 32 + r)) * 8; }
    u32x4 w; w.x = pk_bf16(v[0], v[1]); w.y = pk_bf16(v[2], v[3]); w.z = pk_bf16(v[4], v[5]); w.w = pk_bf16(v[6], v[7]);
    *(u32x4*)(dst + off) = w;
  }
  __syncthreads();
  __syncthreads();
}
DI void phase0(const Params& p, unsigned char* lds, int tid, int half) {
  bf16* W = (bf16*)(p.ws + OFF_W);
  constexpr int NT_L = 832 + 256 + 704 + 704 + 704 + 24 + 16;
  for (int pi = blockIdx.x; pi < NT_L; pi += gridDim.x) {
    const int it = 2 * pi + half;
    const int l = it / NT_L; int r = it % NT_L;
    bf16* Wl = W + (size_t)l * WL_E;
    if (r < 832) { transpose_tile(p.w_in + (size_t)l * 1024 * DIN, DIN, 1024, true, p.pre_mix_g + l * 1024, Wl + WO_IN, (r / 16) * 64, (r % 16) * 64, lds, tid); continue; } r -= 832;
    if (r < 256) { transpose_tile(p.w_out + (size_t)l * 1024 * 1024, 1024, 1024, false, nullptr, Wl + WO_OUT, (r / 16) * 64, (r % 16) * 64, lds, tid); continue; } r -= 256;
    if (r < 704) { transpose_tile(p.ffn_wg + (size_t)l * 1024 * FF, FF, 1024, false, p.pre_ffn_g + l * 1024, Wl + WO_GU, (r / 16) * 64, (r % 16) * 64, lds, tid, 1); continue; } r -= 704;
    if (r < 704) { transpose_tile(p.ffn_wu + (size_t)l * 1024 * FF, FF, 1024, false, p.pre_ffn_g + l * 1024, Wl + WO_GU, (r / 16) * 64, (r % 16) * 64, lds, tid, 2); continue; } r -= 704;
    if (r < 704) { transpose_tile(p.ffn_wd + (size_t)l * FF * 1024, 1024, FF, false, nullptr, Wl + WO_DN, (r / 44) * 64, (r % 44) * 64, lds, tid); continue; } r -= 704;
    if (r < 24) { frag_tile(p.mla_wuq + (size_t)l * 256 * 384, 384, true, p.mla_qg + l * 256, Wl + WO_UQ, (r / 4) * 64, (r % 4) * 64, tid); continue; } r -= 24;
    frag_tile(p.mla_wukv + (size_t)l * 128 * 512, 512, false, p.mla_kvg + l * 128, Wl + WO_UKV, (r / 2) * 64, (r % 2) * 64, tid);
  }
}

DI void resid_phase(const float* __restrict__ xin, const bf16* __restrict__ xinb, const bf16* __restrict__ y, const float* __restrict__ g, float* __restrict__ xout, bf16* __restrict__ xb, float* __restrict__ rs, int tid, int vb, int nvb) {
  const int lane = tid & 63, wv = tid >> 6;
  const int stride = nvb * 4;
  for (int row0 = vb * 4 + wv; row0 < T_; row0 += 2 * stride) {
    f32x4 v[2][4]; u32x2 yu[2][4];
#pragma unroll
    for (int q = 0; q < 2; ++q) {
      const int row = min(row0 + q * stride, T_ - 1);
      if (xin) {
#pragma unroll
        for (int j = 0; j < 4; ++j) v[q][j] = *(const f32x4*)(xin + (size_t)row * 1024 + lane * 4 + 256 * j);
      } else {
#pragma unroll
        for (int j = 0; j < 4; ++j) { const u32x2 u = *(const u32x2*)(xinb + (size_t)row * 1024 + lane * 4 + 256 * j); v[q][j] = (f32x4){bflo(u.x), bfhi(u.x), bflo(u.y), bfhi(u.y)}; }
      }
      if (y) {
#pragma unroll
        for (int j = 0; j < 4; ++j) yu[q][j] = *(const u32x2*)(y + (size_t)row * 1024 + lane * 4 + 256 * j);
      }
    }
#pragma unroll
    for (int q = 0; q < 2; ++q) {
      const int row = row0 + q * stride;
      if (y) {
        f32x4 yv[4]; float ss = 0.f;
#pragma unroll
        for (int j = 0; j < 4; ++j) {
          yv[j] = (f32x4){bflo(yu[q][j].x), bfhi(yu[q][j].x), bflo(yu[q][j].y), bfhi(yu[q][j].y)};
          ss += yv[j].x * yv[j].x + yv[j].y * yv[j].y + yv[j].z * yv[j].z + yv[j].w * yv[j].w;
        }
        const float ry = rsqrtf(wave_sum(ss) * (1.f / 1024.f) + EPS);
#pragma unroll
        for (int j = 0; j < 4; ++j) { f32x4 gg = *(const f32x4*)(g + lane * 4 + 256 * j); v[q][j] = v[q][j] + yv[j] * ry * gg; }
      }
      float sx = 0.f;
#pragma unroll
      for (int j = 0; j < 4; ++j) sx += v[q][j].x * v[q][j].x + v[q][j].y * v[q][j].y + v[q][j].z * v[q][j].z + v[q][j].w * v[q][j].w;
      sx = wave_sum(sx);
      if (row < T_) {
#pragma unroll
        for (int j = 0; j < 4; ++j) {
          if (xout) *(f32x4*)(xout + (size_t)row * 1024 + lane * 4 + 256 * j) = v[q][j];
          if (xb) {
            u32x2 o; o.x = pk_bf16(v[q][j].x, v[q][j].y); o.y = pk_bf16(v[q][j].z, v[q][j].w);
            *(u32x2*)(xb + (size_t)row * 1024 + lane * 4 + 256 * j) = o;
          }
        }
        if (xb && lane == 0) rs[row] = rsqrtf(sx * (1.f / 1024.f) + EPS);
      }
    }
  }
}

DI float gelu_tanh(float x) {
  const float u = 0.7978845608028654f * (x + 0.044715f * x * x * x);
  const float e = __expf(2.f * u);
  const float th = 1.f - 2.f / (e + 1.f);
  return 0.5f * x * (1.f + th);
}
struct EpiStore {
  bf16* out0; bf16* out1; int split; int ldc; const float* rs; const float* cw;
  DI void store4(int m, int n, f32x4 v) const {
    bf16* o = out0; if (n >= split) { o = out1; n -= split; }
    u32x2 w; w.x = pk_bf16(v.x, v.y); w.y = pk_bf16(v.z, v.w);
    *(u32x2*)(o + (size_t)m * ldc + n) = w;
  }
};

#define GL_LAS __attribute__((address_space(3)))
DI int g8_lds_byte(int r, int c) { const int st = (r >> 4) * 2 + (c >> 5), rr = r & 15, cc = c & 31, ob = rr * 64 + cc * 2; return st * 1024 + (ob ^ (((ob >> 9) & 1) << 5)); }
DI void g8_stage_rc(int b, int& R, int& C) { const int st = b / 1024, sb = b % 1024, swz = sb ^ (((sb >> 9) & 1) << 5); R = (st >> 1) * 16 + swz / 64; C = (st & 1) * 32 + (swz % 64) / 2; }
template <bool ACT>
DI void gemm_phase(const bf16* __restrict__ A, int lda, const bf16* __restrict__ Bt, int ldb, int K, int MT, int NT, const EpiStore& epi, unsigned char* lds, int tid) {
  constexpr int HTB = 128 * 64 * 2;
  const int nt_k = K / 64;
  const int xcd = blockIdx.x & 7, jb = blockIdx.x >> 3, nbx = (gridDim.x + 7 - xcd) >> 3;
  const int band = MT / 8, per_x = band * NT;
  for (int lt = jb; lt < per_x; lt += nbx) {
    const int mg = lt / (8 * NT), rem = lt % (8 * NT), gs = min(8, band - 8 * mg);
    const int mt = xcd * band + mg * 8 + rem % gs, nt = rem / gs, n0 = nt * 256;
    int m0 = mt * 256, seq0 = 0;
    if (ACT) { const int bs = mt / 34, ti = mt % 34; if (ti == 33) continue; seq0 = bs * S_; m0 = seq0 + 254 * ti - 2; }
    __syncthreads();
    asm volatile("" : "+v"(tid));
    const int wid = tid >> 6, lane = tid & 63, wr = wid >> 2, wc = wid & 3, fr = lane & 15, fq = lane >> 4;
    const int obs = (fr * 64 + fq * 16) ^ ((((fr * 64 + fq * 16) >> 9) & 1) << 5);
    const int a_rd = obs + wr * 8192, b_rd = obs + wc * 4096;
#define SA8(b, h) (lds + ((b) * 2 + (h)) * HTB)
#define SB8(b, h) (lds + (4 + (b) * 2 + (h)) * HTB)
    unsigned aofs[2][2], bofs[2];
#pragma unroll
    for (int i = 0; i < 2; ++i) {
      int sr_, sc_; g8_stage_rc(tid * 16 + i * 8192, sr_, sc_);
      bofs[i] = ((unsigned)(n0 + sr_) * (unsigned)ldb + (unsigned)sc_) * 2u;
#pragma unroll
      for (int hf = 0; hf < 2; ++hf) {
        int row = m0 + sr_ + (ACT ? hf * 128 : 0); if (ACT) row = min(max(row, seq0), seq0 + S_ - 1);
        aofs[hf][i] = ((unsigned)row * (unsigned)lda + (unsigned)sc_) * 2u;
      }
    }
#define STAGE_A(P, half_, kt) do { const unsigned char* ub_ = (const unsigned char*)A + (size_t)(kt) * 128 + (ACT ? (size_t)0 : (size_t)(half_) * 256 * (size_t)lda); _Pragma("unroll") for (int _i = 0; _i < 2; ++_i) \
      __builtin_amdgcn_global_load_lds((const unsigned*)(ub_ + aofs[half_][_i]), (GL_LAS unsigned*)((P) + tid * 16 + _i * 8192), 16, 0, 0); } while (0)
#define STAGE_B(P, half_, kt) do { const unsigned char* ub_ = (const unsigned char*)Bt + (size_t)(kt) * 128 + (size_t)(half_) * 256 * (size_t)ldb; _Pragma("unroll") for (int _i = 0; _i < 2; ++_i) \
      __builtin_amdgcn_global_load_lds((const unsigned*)(ub_ + bofs[_i]), (GL_LAS unsigned*)((P) + tid * 16 + _i * 8192), 16, 0, 0); } while (0)
#define LDA8(dst, b, h) _Pragma("unroll") for (int m = 0; m < 4; ++m) _Pragma("unroll") for (int k = 0; k < 2; ++k) \
      dst[m][k] = *(const bf16x8*)(SA8(b, h) + a_rd + m * 2048 + k * 1024)
#define LDB8(dst, b, h) _Pragma("unroll") for (int n = 0; n < 2; ++n) _Pragma("unroll") for (int k = 0; k < 2; ++k) \
      dst[n][k] = *(const bf16x8*)(SB8(b, h) + b_rd + n * 2048 + k * 1024)
#define MMA8(ai, bj, At_, Bt_) do { __builtin_amdgcn_s_setprio(1); \
      _Pragma("unroll") for (int m = 0; m < 4; ++m) _Pragma("unroll") for (int n = 0; n < 2; ++n) _Pragma("unroll") for (int k = 0; k < 2; ++k) \
        acc[ai][bj][m][n] = __builtin_amdgcn_mfma_f32_16x16x32_bf16(Bt_[n][k], At_[m][k], acc[ai][bj][m][n], 0, 0, 0); \
      __builtin_amdgcn_s_setprio(0); } while (0)
#define WAIT_V(n) asm volatile("s_waitcnt vmcnt(" #n ")" ::: "memory")
#define WAIT_L(n) asm volatile("s_waitcnt lgkmcnt(" #n ")" ::: "memory")
#define BAR8 __builtin_amdgcn_s_barrier()
#define SCHED8 __builtin_amdgcn_sched_barrier(0)
    f32x4 acc[2][2][4][2];
#pragma unroll
    for (int i0 = 0; i0 < 2; ++i0)
#pragma unroll
      for (int i1 = 0; i1 < 2; ++i1)
#pragma unroll
        for (int i2 = 0; i2 < 4; ++i2)
#pragma unroll
          for (int i3 = 0; i3 < 2; ++i3) acc[i0][i1][i2][i3] = (f32x4){0.f, 0.f, 0.f, 0.f};
    bf16x8 At[4][2], B0[2][2], B1[2][2];
    STAGE_B(SB8(0, 0), 0, 0); STAGE_A(SA8(0, 0), 0, 0);
    STAGE_B(SB8(0, 1), 1, 0); STAGE_A(SA8(0, 1), 1, 0);
    if (wr == 1) BAR8;
    WAIT_V(4); BAR8;
    STAGE_B(SB8(1, 0), 0, 1); STAGE_A(SA8(1, 0), 0, 1); STAGE_B(SB8(1, 1), 1, 1);
    WAIT_V(6); BAR8;
    for (int t = 0; t < nt_k - 2; t += 2) {
      LDB8(B0, 0, 0); SCHED8; LDA8(At, 0, 0); STAGE_A(SA8(1, 1), 1, t + 1);
      WAIT_L(8); BAR8; WAIT_L(0); MMA8(0, 0, At, B0); BAR8; SCHED8;
      LDB8(B1, 0, 1); STAGE_B(SB8(0, 0), 0, t + 2);
      BAR8; WAIT_L(0); MMA8(0, 1, At, B1); BAR8;
      LDA8(At, 0, 1); STAGE_A(SA8(0, 0), 0, t + 2);
      BAR8; WAIT_L(0); MMA8(1, 0, At, B0); BAR8; SCHED8;
      STAGE_B(SB8(0, 1), 1, t + 2);
      WAIT_V(6); BAR8; MMA8(1, 1, At, B1); BAR8;
      LDB8(B0, 1, 0); SCHED8; LDA8(At, 1, 0); STAGE_A(SA8(0, 1), 1, t + 2);
      WAIT_L(8); BAR8; WAIT_L(0); MMA8(0, 0, At, B0); BAR8; SCHED8;
      LDB8(B1, 1, 1); STAGE_B(SB8(1, 0), 0, t + 3);
      BAR8; WAIT_L(0); MMA8(0, 1, At, B1); BAR8;
      LDA8(At, 1, 1); STAGE_A(SA8(1, 0), 0, t + 3);
      BAR8; WAIT_L(0); MMA8(1, 0, At, B0); BAR8; SCHED8;
      STAGE_B(SB8(1, 1), 1, t + 3);
      WAIT_V(6); BAR8; MMA8(1, 1, At, B1); BAR8;
    }
    { LDB8(B0, 0, 0); LDA8(At, 0, 0); STAGE_A(SA8(1, 1), 1, nt_k - 1);
      BAR8; WAIT_L(0); MMA8(0, 0, At, B0); BAR8;
      LDB8(B1, 0, 1); BAR8; WAIT_L(0); MMA8(0, 1, At, B1); BAR8;
      LDA8(At, 0, 1); WAIT_V(4); BAR8; WAIT_L(0); MMA8(1, 0, At, B0); MMA8(1, 1, At, B1); BAR8; }
    { LDB8(B0, 1, 0); LDA8(At, 1, 0); WAIT_V(2); BAR8; WAIT_L(0); MMA8(0, 0, At, B0); BAR8;
      LDB8(B1, 1, 1); WAIT_V(0); BAR8; WAIT_L(0); MMA8(0, 1, At, B1); BAR8;
      LDA8(At, 1, 1); BAR8; WAIT_L(0); MMA8(1, 0, At, B0); MMA8(1, 1, At, B1); BAR8; }
    if (wr == 0) BAR8;
    __syncthreads();
    int tid_e = tid; asm volatile("" : "+v"(tid_e));
    const int e_wid = tid_e >> 6, e_lane = tid_e & 63, e_wr = e_wid >> 2, e_wc = e_wid & 3, e_fr = e_lane & 15, e_fq = e_lane >> 4;
    if (!ACT) {
#pragma unroll
      for (int ai = 0; ai < 2; ++ai)
#pragma unroll
        for (int m = 0; m < 4; ++m) {
          const int ml = ai * 128 + e_wr * 64 + m * 16 + e_fr;
          const float sc = epi.rs ? epi.rs[m0 + ml] : 1.f;
#pragma unroll
          for (int bj = 0; bj < 2; ++bj)
#pragma unroll
            for (int n = 0; n < 2; ++n) {
              const f32x4 v = acc[ai][bj][m][n] * sc;
              u32x2 w2; w2.x = pk_bf16(v[0], v[1]); w2.y = pk_bf16(v[2], v[3]);
              *(u32x2*)(lds + ml * 520 + (bj * 128 + e_wc * 32 + n * 16 + e_fq * 4) * 2) = w2;
            }
        }
      __syncthreads();
#pragma unroll 2
      for (int k = 0; k < 16; ++k) {
        const int id = tid_e + 512 * k, row = id >> 5, ch = id & 31;
        const u32x2 lo = *(const u32x2*)(lds + row * 520 + ch * 16), hi = *(const u32x2*)(lds + row * 520 + ch * 16 + 8);
        *(u32x4*)(epi.out0 + (size_t)(m0 + row) * epi.ldc + n0 + ch * 8) = (u32x4){lo.x, lo.y, hi.x, hi.y};
      }
    } else {
      float* G = (float*)lds;
#pragma unroll
      for (int ai = 0; ai < 2; ++ai)
#pragma unroll
        for (int m = 0; m < 4; ++m) {
          const int ml = ai * 128 + e_wr * 64 + m * 16 + e_fr;
          const float sc = epi.rs[min(max(m0 + ml, seq0), seq0 + S_ - 1)];
#pragma unroll
          for (int n = 0; n < 2; ++n) {
            acc[ai][0][m][n] = acc[ai][0][m][n] * sc; acc[ai][1][m][n] = acc[ai][1][m][n] * sc;
#pragma unroll
            for (int j = 0; j < 4; ++j) G[(e_wc * 32 + n * 16 + e_fq * 4 + j) * 256 + ml] = acc[ai][0][m][n][j];
          }
        }
      __syncthreads();
#pragma unroll
      for (int n = 0; n < 2; ++n) {
        const int chl = e_wc * 32 + n * 16 + e_fq * 4, c = nt * 128 + chl;
        const f32x4 w0 = *(const f32x4*)(epi.cw + c), w1 = *(const f32x4*)(epi.cw + FF + c), w2 = *(const f32x4*)(epi.cw + 2 * FF + c);
#pragma unroll
        for (int ai = 0; ai < 2; ++ai)
#pragma unroll
          for (int m = 0; m < 4; ++m) {
            const int ml = ai * 128 + e_wr * 64 + m * 16 + e_fr, t = m0 + ml, sq = t - seq0;
            const int m1 = max(ml - 1, 0), m2 = max(ml - 2, 0);
            float o[4];
#pragma unroll
            for (int j = 0; j < 4; ++j) {
              const float g0 = acc[ai][0][m][n][j];
              const float g1 = (sq >= 1) ? G[(chl + j) * 256 + m1] : 0.f;
              const float g2 = (sq >= 2) ? G[(chl + j) * 256 + m2] : 0.f;
              const float cv = w0[j] * g2 + w1[j] * g1 + w2[j] * g0;
              o[j] = gelu_tanh(cv) * acc[ai][1][m][n][j];
            }
            if (ml >= 2 && sq < S_) {
              u32x2 wv2; wv2.x = pk_bf16(o[0], o[1]); wv2.y = pk_bf16(o[2], o[3]);
              *(u32x2*)(epi.out0 + (size_t)t * FF + c) = wv2;
            }
          }
      }
    }
  }
  __syncthreads();
}

DI void ffn_act_phase(const bf16* __restrict__ gate, bf16* __restrict__ up, const float* __restrict__ cw, int tid) {
  constexpr int CG = FF / 8;
  const int total = (T_ / 16) * CG;
  for (int it = blockIdx.x * 256 + tid; it < total; it += gridDim.x * 256) {
    const int tb = it / CG, cgp = it % CG, t0 = tb * 16, c0 = cgp * 8;
    float w0[8], w1[8], w2[8], g1[8], g2[8];
#pragma unroll
    for (int i = 0; i < 8; ++i) { w0[i] = cw[c0 + i]; w1[i] = cw[FF + c0 + i]; w2[i] = cw[2 * FF + c0 + i]; g1[i] = 0.f; g2[i] = 0.f; }
    if ((t0 & (S_ - 1)) != 0) {
      u32x4 a = *(const u32x4*)(gate + (size_t)(t0 - 2) * FF + c0), b = *(const u32x4*)(gate + (size_t)(t0 - 1) * FF + c0);
#pragma unroll
      for (int i = 0; i < 4; ++i) { g2[2 * i] = bflo(a[i]); g2[2 * i + 1] = bfhi(a[i]); g1[2 * i] = bflo(b[i]); g1[2 * i + 1] = bfhi(b[i]); }
    }
#pragma unroll 4
    for (int t = t0; t < t0 + 16; ++t) {
      u32x4 a = *(const u32x4*)(gate + (size_t)t * FF + c0), u = *(const u32x4*)(up + (size_t)t * FF + c0);
      float g0[8], uu[8], o[8];
#pragma unroll
      for (int i = 0; i < 4; ++i) { g0[2 * i] = bflo(a[i]); g0[2 * i + 1] = bfhi(a[i]); uu[2 * i] = bflo(u[i]); uu[2 * i + 1] = bfhi(u[i]); }
#pragma unroll
      for (int i = 0; i < 8; ++i) { const float c = w0[i] * g2[i] + w1[i] * g1[i] + w2[i] * g0[i]; o[i] = gelu_tanh(c) * uu[i]; g2[i] = g1[i]; g1[i] = g0[i]; }
      u32x4 w; w.x = pk_bf16(o[0], o[1]); w.y = pk_bf16(o[2], o[3]); w.z = pk_bf16(o[4], o[5]); w.w = pk_bf16(o[6], o[7]);
      *(u32x4*)(up + (size_t)t * FF + c0) = w;
    }
  }
}

template <int DK, bool ISA>
DI float gla_lb(const Params& p, int l, int h, int d) {
  if (!ISA || l == 0) return 0.f;
  const float l0 = p.hgrn_lb[h * 64 + d], l1 = p.hgrn_lb[256 + h * 64 + d];
  return 1.f / (1.f + __expf(l0 - l1));
}
template <int DK, bool ISA>
DI void gla_bc(const Params& p, int l, const bf16* __restrict__ z, int t0, int h, float* bcl, int tid) {
  constexpr int NP = 256 / DK, TPP = 64 / NP;
  const int d = tid % DK, part = tid / DK;
  float run = 0.f;
  if (ISA) {
    const float lbv = gla_lb<DK, ISA>(p, l, h, d);
#pragma unroll
    for (int jj = 0; jj < TPP; ++jj) {
      const int j = part * TPP + jj;
      const float zf = bf2f(z[(size_t)(t0 + j) * ZLD + ZA_F + h * 64 + d]);
      const float f = lbv + (1.f - lbv) * sigmoidf_(zf);
      run += __logf(fmaxf(f, 1e-30f));
      bcl[j * DK + d] = run;
    }
  } else {
    float w[16];
#pragma unroll
    for (int rr = 0; rr < 16; ++rr) w[rr] = p.gla_w2[(size_t)l * 16 * 128 + rr * 128 + h * 32 + d];
    const float bias = p.gla_b[l * 128 + h * 32 + d];
#pragma unroll
    for (int jj = 0; jj < TPP; ++jj) {
      const int j = part * TPP + jj;
      const u32x4* cp = (const u32x4*)(z + (size_t)(t0 + j) * ZLD + ZB_CODE);
      u32x4 c0 = cp[0], c1 = cp[1];
      float u = bias;
#pragma unroll
      for (int i = 0; i < 4; ++i) { u += bflo(c0[i]) * w[2 * i] + bfhi(c0[i]) * w[2 * i + 1]; u += bflo(c1[i]) * w[8 + 2 * i] + bfhi(c1[i]) * w[8 + 2 * i + 1]; }
      run += -softplusf_(-u) * (1.f / 16.f);
      bcl[j * DK + d] = run;
    }
  }
  __syncthreads();
  float off = 0.f;
  for (int pp = 0; pp < part; ++pp) off += bcl[(pp * TPP + TPP - 1) * DK + d];
  __syncthreads();
#pragma unroll
  for (int jj = 0; jj < TPP; ++jj) bcl[(part * TPP + jj) * DK + d] += off;
  __syncthreads();
}
template <int DK, bool ISA>
DI float gla_kval(const bf16* __restrict__ z, int t, int h, int d, float lbv) {
  if (ISA) { const float zf = bf2f(z[(size_t)t * ZLD + ZA_F + h * 64 + d]); return (1.f - lbv) * sigmoidf_(-zf); }
  return bf2f(z[(size_t)t * ZLD + ZB_K + h * 32 + d]);
}
template <int DK, bool ISA>
DI float gla_qval(const bf16* __restrict__ z, int t, int h, int d) {
  if (ISA) { const float zq = bf2f(z[(size_t)t * ZLD + ZA_Q + h * 64 + d]); return siluf_(zq) * 0.125f; }
  return bf2f(z[(size_t)t * ZLD + ZB_Q + h * 32 + d]) * 0.17677669529663687f;
}

template <int DK, bool ISA>
DI void gla_local_item(const Params& p, int l, int ci, unsigned char* lds, int tid) {
  const bf16* z = (const bf16*)(p.ws + OFF_AR + AR_Z);
  bf16* UT = (bf16*)(p.ws + OFF_AR + (ISA ? AR_UTA : AR_UTB));
  float* G = (float*)(p.ws + (ISA ? OFF_GA : OFF_GB));
  const int h = ci & 3, t0 = (ci >> 2) * 64;
  float* bcl = (float*)lds;
  bf16* kT = (bf16*)(lds + 16384);
  bf16* vT = (bf16*)(lds + 16384 + 9216);
  bf16 vpre[16];
  {
    const int e = tid & 63, p4 = tid >> 6;
    const int vcol = (ISA ? ZA_I : ZB_V) + h * 64 + e;
#pragma unroll
    for (int jj = 0; jj < 16; ++jj) vpre[jj] = z[(size_t)(t0 + p4 * 16 + jj) * ZLD + vcol];
  }
  gla_bc<DK, ISA>(p, l, z, t0, h, bcl, tid);
  {
    float* bcg = (float*)((unsigned char*)p.out + BC_OFF + (ISA ? 0 : BC_B_OFF)) + (size_t)ci * 64 * DK;
#pragma unroll
    for (int k = 0; k < (64 * DK) / 1024; ++k) *(f32x4*)(bcg + (tid + 256 * k) * 4) = *(const f32x4*)(bcl + (tid + 256 * k) * 4);
  }
  constexpr int NP = 256 / DK, TPP = 64 / NP;
  {
    const int d = tid % DK, part = tid / DK;
    const float lbv = gla_lb<DK, ISA>(p, l, h, d);
    const float bl = bcl[63 * DK + d];
#pragma unroll
    for (int jj = 0; jj < TPP; ++jj) {
      const int j = part * TPP + jj;
      const float kv = gla_kval<DK, ISA>(z, t0 + j, h, d, lbv);
      kT[d * 72 + j] = f2bf(kv * __expf(bl - bcl[j * DK + d]));
    }
    if (part == 0) G[(size_t)ci * DK + d] = __expf(bl);
    const int e = tid & 63, p4 = tid >> 6;
#pragma unroll
    for (int jj = 0; jj < 16; ++jj) { const int j = p4 * 16 + jj; vT[e * 72 + j] = vpre[jj]; }
  }
  __syncthreads();
  const int lane = tid & 63, wv = tid >> 6, wm = wv & 1, wn = wv >> 1, r = lane & 31, hh = lane >> 5;
  if (wm * 32 < DK) {
    f32x16 acc = mm32((const unsigned char*)(kT + wm * 32 * 72), 144, (const unsigned char*)(vT + wn * 32 * 72), 144, 4, zero16(), r, hh);
    const int e = wn * 32 + r;
#pragma unroll
    for (int g = 0; g < 4; ++g) {
      const int d = wm * 32 + 8 * g + 4 * hh;
      u32x2 w; w.x = pk_bf16(acc[4 * g], acc[4 * g + 1]); w.y = pk_bf16(acc[4 * g + 2], acc[4 * g + 3]);
      *(u32x2*)(UT + ((size_t)ci * 64 + e) * DK + d) = w;
    }
  }
  __syncthreads();
}

template <int DK>
DI void gla_scan_item(bf16* __restrict__ UT, const float* __restrict__ G, int b, int h, int slice, int tid) {
  constexpr int GPR = DK / 4, RPS = 256 / GPR;
  const int e = slice * RPS + tid / GPR, d4 = (tid % GPR) * 4;
  f32x4 st = (f32x4){0.f, 0.f, 0.f, 0.f};
  for (int c0 = 0; c0 < 128; c0 += 8) {
    u32x2 u[8]; f32x4 gg[8];
#pragma unroll
    for (int i = 0; i < 8; ++i) {
      const size_t ci = ((size_t)(b * 128 + c0 + i) * 4 + h);
      u[i] = *(const u32x2*)(UT + (ci * 64 + e) * DK + d4);
      gg[i] = *(const f32x4*)(G + ci * DK + d4);
    }
#pragma unroll
    for (int i = 0; i < 8; ++i) {
      const size_t ci = ((size_t)(b * 128 + c0 + i) * 4 + h);
      u32x2 w; w.x = pk_bf16(st.x, st.y); w.y = pk_bf16(st.z, st.w);
      *(u32x2*)(UT + (ci * 64 + e) * DK + d4) = w;
      st = gg[i] * st + (f32x4){bflo(u[i].x), bfhi(u[i].x), bflo(u[i].y), bfhi(u[i].y)};
    }
  }
}

template <bool SIG>
DI void norm_gate_store(const float* obuf, bool has_add, u32x4 a0, u32x4 a1, const float* __restrict__ ng, u32x4 g0, u32x4 g1, bf16* __restrict__ mixo, int tid) {
  const int i = tid >> 2, e0 = (tid & 3) * 16;
  float o[16]; float ss = 0.f;
#pragma unroll
  for (int k = 0; k < 16; ++k) o[k] = obuf[i * 68 + e0 + k];
  if (has_add) {
#pragma unroll
    for (int k = 0; k < 4; ++k) { o[2 * k] += bflo(a0[k]); o[2 * k + 1] += bfhi(a0[k]); o[8 + 2 * k] += bflo(a1[k]); o[8 + 2 * k + 1] += bfhi(a1[k]); }
  }
#pragma unroll
  for (int k = 0; k < 16; ++k) ss += o[k] * o[k];
  ss += __shfl_xor(ss, 1); ss += __shfl_xor(ss, 2);
  const float rsv = rsqrtf(ss * (1.f / 64.f) + EPS);
  float gt[16];
#pragma unroll
  for (int k = 0; k < 4; ++k) { gt[2 * k] = bflo(g0[k]); gt[2 * k + 1] = bfhi(g0[k]); gt[8 + 2 * k] = bflo(g1[k]); gt[8 + 2 * k + 1] = bfhi(g1[k]); }
  unsigned w[8];
#pragma unroll
  for (int k = 0; k < 8; ++k) {
    float a = o[2 * k] * rsv * ng[e0 + 2 * k], b = o[2 * k + 1] * rsv * ng[e0 + 2 * k + 1];
    a *= SIG ? sigmoidf_(gt[2 * k]) : siluf_(gt[2 * k]);
    b *= SIG ? sigmoidf_(gt[2 * k + 1]) : siluf_(gt[2 * k + 1]);
    w[k] = pk_bf16(a, b);
  }
  u32x4* op = (u32x4*)(mixo + (size_t)i * 1024 + e0);
  op[0] = (u32x4){w[0], w[1], w[2], w[3]}; op[1] = (u32x4){w[4], w[5], w[6], w[7]};
}

template <int DK, bool ISA>
DI void gla_out_item(const Params& p, int l, int ci, unsigned char* lds, int tid) {
  const bf16* z = (const bf16*)(p.ws + OFF_AR + AR_Z);
  const bf16* ST = (const bf16*)(p.ws + OFF_AR + (ISA ? AR_UTA : AR_UTB));
  bf16* mix = (bf16*)(p.ws + OFF_AR + AR_MIX);
  const int h = ci & 3, t0 = (ci >> 2) * 64;
  constexpr int LDK = (DK + 8) * 2;
  float* bcl = (float*)lds;
  float* obuf = (float*)lds;
  unsigned char* qh = lds + 17408;
  unsigned char* kt = qh + 9216;
  unsigned char* qc = kt + 9216;
  unsigned char* vT = qc + 9216;
  unsigned char* stl = vT + 9216;
  unsigned char* attn = stl + 9216;
  const u32x4* gpre = (const u32x4*)(z + (size_t)(t0 + (tid >> 2)) * ZLD + (ISA ? ZA_G : ZB_G) + h * 64 + (tid & 3) * 16);
  const u32x4 gq0 = gpre[0], gq1 = gpre[1];
  bf16 vpre[16];
  {
    const int e = tid & 63, p4 = tid >> 6;
    const int vcol = (ISA ? ZA_I : ZB_V) + h * 64 + e;
#pragma unroll
    for (int jj = 0; jj < 16; ++jj) vpre[jj] = z[(size_t)(t0 + p4 * 16 + jj) * ZLD + vcol];
  }
  constexpr int NPq = 256 / DK, TPPq = 64 / NPq;
  bf16 qpre[TPPq], kpre[TPPq];
  {
    const int d = tid % DK, part = tid / DK;
#pragma unroll
    for (int jj = 0; jj < TPPq; ++jj) {
      const size_t t = (size_t)(t0 + part * TPPq + jj);
      qpre[jj] = z[t * ZLD + (ISA ? ZA_Q + h * 64 : ZB_Q + h * 32) + d];
      kpre[jj] = ISA ? (bf16)0 : z[t * ZLD + ZB_K + h * 32 + d];
    }
  }
  constexpr int CPR0 = DK / 8, NST = (64 * CPR0) / 256;
  u32x4 stpre[NST];
#pragma unroll
  for (int k = 0; k < NST; ++k) { const int id = tid + 256 * k; stpre[k] = *(const u32x4*)(ST + ((size_t)ci * 64 + id / CPR0) * DK + (id % CPR0) * 8); }
  {
    const float* bcg = (const float*)((const unsigned char*)p.out + BC_OFF + (ISA ? 0 : BC_B_OFF)) + (size_t)ci * 64 * DK;
#pragma unroll
    for (int k = 0; k < (64 * DK) / 1024; ++k) *(f32x4*)(bcl + (tid + 256 * k) * 4) = *(const f32x4*)(bcg + (tid + 256 * k) * 4);
    __syncthreads();
  }
  constexpr int NP = 256 / DK, TPP = 64 / NP;
  {
    const int d = tid % DK, part = tid / DK;
    const float lbv = gla_lb<DK, ISA>(p, l, h, d);
    const float bref = bcl[31 * DK + d];
#pragma unroll
    for (int jj = 0; jj < TPP; ++jj) {
      const int j = part * TPP + jj;
      const float kv = ISA ? gla_kval<DK, ISA>(z, t0 + j, h, d, lbv) : bf2f(kpre[jj]);
      const float qv = ISA ? siluf_(bf2f(qpre[jj])) * 0.125f : bf2f(qpre[jj]) * 0.17677669529663687f;
      const float bc = bcl[j * DK + d];
      const float dq = fminf(fmaxf(bc - bref, -80.f), 80.f);
      ((bf16*)qh)[j * (DK + 8) + d] = f2bf(qv * __expf(dq));
      ((bf16*)kt)[j * (DK + 8) + d] = f2bf(kv * __expf(-dq));
      ((bf16*)qc)[j * (DK + 8) + d] = f2bf(qv * __expf(bc));
    }
    const int e = tid & 63, p4 = tid >> 6;
#pragma unroll
    for (int jj = 0; jj < 16; ++jj) { const int j = p4 * 16 + jj; ((bf16*)vT)[e * 72 + j] = vpre[jj]; }
#pragma unroll
    for (int k = 0; k < NST; ++k) { const int id = tid + 256 * k; *(u32x4*)(stl + (id / CPR0) * LDK + (id % CPR0) * 16) = stpre[k]; }
  }
  __syncthreads();
  const int lane = tid & 63, wv = tid >> 6, wm = wv & 1, wn = wv >> 1, r = lane & 31, hh = lane >> 5;
  {
    f32x16 acc = mm32(qh + wm * 32 * LDK, LDK, kt + wn * 32 * LDK, LDK, DK / 16, zero16(), r, hh);
    const int jc = wn * 32 + r;
#pragma unroll
    for (int g = 0; g < 4; ++g)
#pragma unroll
      for (int k = 0; k < 4; ++k) {
        const int i = wm * 32 + 8 * g + 4 * hh + k;
        const float v = (jc <= i) ? acc[4 * g + k] : 0.f;
        ((bf16*)attn)[i * 72 + jc] = f2bf(v);
      }
  }
  __syncthreads();
  {
    f32x16 acc = mm32(attn + wm * 32 * 144, 144, vT + wn * 32 * 144, 144, 4, zero16(), r, hh);
    acc = mm32(qc + wm * 32 * LDK, LDK, stl + wn * 32 * LDK, LDK, DK / 16, acc, r, hh);
    const int e = wn * 32 + r;
#pragma unroll
    for (int g = 0; g < 4; ++g)
#pragma unroll
      for (int k = 0; k < 4; ++k) obuf[(wm * 32 + 8 * g + 4 * hh + k) * 68 + e] = acc[4 * g + k];
  }
  __syncthreads();
  norm_gate_store<ISA>(obuf, false, gq0, gq0, (ISA ? p.hgrn_ng : p.gla_ng) + l * 64, gq0, gq1, mix + (size_t)t0 * 1024 + (ISA ? 0 : 256) + h * 64, tid);
  __syncthreads();
}

DI void gdn_local_item(const Params& p, int l, int ci, unsigned char* lds, int tid) {
  const bf16* z = (const bf16*)(p.ws + OFF_AR + AR_Z);
  float* Ac = (float*)(p.ws + OFF_AR + AR_ACD) + (size_t)ci * 4096;
  bf16* BT = (bf16*)(p.ws + OFF_AR + AR_BTD) + (size_t)ci * 4096;
  bf16* Qeff = (bf16*)(p.ws + OFF_AR + AR_QEFF) + (size_t)ci * 4096;
  bf16* Oloc = (bf16*)(p.ws + OFF_AR + AR_OLOC) + (size_t)ci * 4096;
  const int h = ci & 3, t0 = (ci >> 2) * 64, s0 = t0 & (S_ - 1);
  float* Mf = (float*)lds;
  bf16* WT = (bf16*)lds;
  bf16* UT = (bf16*)(lds + 9216);
  float* X = (float*)(lds + 16384);
  bf16* qn = (bf16*)(lds + 16384);
  bf16* kn = qn + 64 * 72;
  bf16* vb = kn + 64 * 72;
  bf16* kbm = (bf16*)(lds + 49152);
  bf16* aqk = kbm;
  bf16* KtT = kbm + 64 * 72;
  float* sm = (float*)(lds + 49152 + 2 * 9216);
  float* betas = sm; float* bcum = sm + 64;
  const int lane = tid & 63, wv = tid >> 6;
  const bf16 zbeta_raw = z[(size_t)(t0 + lane) * ZLD + ZD_BETA + h], za_raw = z[(size_t)(t0 + lane) * ZLD + ZD_A + h];
  {
    const int d = lane, j0 = wv * 16;
    const float* cw = p.gdn_conv + (size_t)l * 4 * 768;
    float qv[16], kv[16];
#pragma unroll
    for (int which = 0; which < 3; ++which) {
      const int cc = which * 256 + h * 64 + d;
      const int zc = (which == 0 ? ZD_Q : (which == 1 ? ZD_K : ZD_V)) + h * 64 + d;
      const float c0 = cw[cc], c1 = cw[768 + cc], c2 = cw[2 * 768 + cc], c3 = cw[3 * 768 + cc];
      float x0 = 0.f, x1 = 0.f, x2 = 0.f;
      if (s0 + j0 >= 3) { x0 = bf2f(z[(size_t)(t0 + j0 - 3) * ZLD + zc]); x1 = bf2f(z[(size_t)(t0 + j0 - 2) * ZLD + zc]); x2 = bf2f(z[(size_t)(t0 + j0 - 1) * ZLD + zc]); }
#pragma unroll
      for (int jj = 0; jj < 16; ++jj) {
        const float x3 = bf2f(z[(size_t)(t0 + j0 + jj) * ZLD + zc]);
        const float o = siluf_(c0 * x0 + c1 * x1 + c2 * x2 + c3 * x3);
        x0 = x1; x1 = x2; x2 = x3;
        if (which == 0) qv[jj] = o; else if (which == 1) kv[jj] = o; else vb[(j0 + jj) * 72 + d] = f2bf(o);
      }
    }
    if (wv == 0) {
      const float be = sigmoidf_(bf2f(zbeta_raw));
      float lg = -__expf(p.gdn_alog[l * 4 + h]) * softplusf_(bf2f(za_raw) + p.gdn_dtb[l * 4 + h]);
#pragma unroll
      for (int o = 1; o < 64; o <<= 1) { const float n = __shfl_up(lg, o); if (lane >= o) lg += n; }
      betas[lane] = be; bcum[lane] = lg;
    }
    __syncthreads();
    const float bl = bcum[63];
#pragma unroll
    for (int jj = 0; jj < 16; ++jj) {
      const int j = j0 + jj;
      const float rq = rsqrtf(wave_sum(qv[jj] * qv[jj]) + EPS) * 0.125f;
      const float rk = rsqrtf(wave_sum(kv[jj] * kv[jj]) + EPS);
      const float qq = qv[jj] * rq, kk = kv[jj] * rk;
      qn[j * 72 + d] = f2bf(qq); kn[j * 72 + d] = f2bf(kk); kbm[j * 72 + d] = f2bf(kk * betas[j]);
      Qeff[j * 64 + d] = f2bf(qq * __expf(bcum[j]));
      KtT[d * 72 + j] = f2bf(kk * __expf(bl - bcum[j]));
    }
  }
  __syncthreads();
  const int wm = wv & 1, wn = wv >> 1, r = lane & 31, hh = lane >> 5;
  {
    f32x16 acc = mm32((const unsigned char*)(kbm + wm * 32 * 72), 144, (const unsigned char*)(kn + wn * 32 * 72), 144, 4, zero16(), r, hh);
    f32x16 acc2 = mm32((const unsigned char*)(qn + wm * 32 * 72), 144, (const unsigned char*)(kn + wn * 32 * 72), 144, 4, zero16(), r, hh);
    const int jc = wn * 32 + r; const float bj = bcum[jc];
    __syncthreads();
#pragma unroll
    for (int g = 0; g < 4; ++g)
#pragma unroll
      for (int k = 0; k < 4; ++k) {
        const int i = wm * 32 + 8 * g + 4 * hh + k;
        const float dec = (jc <= i) ? __expf(bcum[i] - bj) : 0.f;
        Mf[i * 64 + jc] = (jc < i) ? acc[4 * g + k] * dec : 0.f;
        aqk[i * 72 + jc] = f2bf(acc2[4 * g + k] * dec);
      }
  }
  __syncthreads();
  {
    const int c = tid & 127, j0 = (tid >> 7) * 32;
    const bf16* srcp = (c < 64) ? vb : kn;
    float xr[32];
#pragma unroll
    for (int j = 0; j < 32; ++j) { const float f = (c < 64) ? betas[j0 + j] : betas[j0 + j] * __expf(bcum[j0 + j]); xr[j] = bf2f(srcp[(j0 + j) * 72 + (c & 63)]) * f; }
    __syncthreads();
#pragma unroll
    for (int j = 0; j < 32; ++j) X[(j0 + j) * 128 + c] = xr[j];
  }
  __syncthreads();
  {
    const int g4 = lane >> 4, c16 = lane & 15;
#pragma unroll
    for (int I = 0; I < 4; ++I) {
      if (I > 0) {
        f32x4 acc0 = (f32x4){0.f, 0.f, 0.f, 0.f}, acc1 = acc0;
#pragma unroll
        for (int J = 0; J < I; ++J) {
#pragma unroll
          for (int kk = 0; kk < 4; ++kk) {
            const float av = Mf[(16 * I + c16) * 64 + 16 * J + 4 * kk + g4];
            const float b0 = X[(16 * J + 4 * kk + g4) * 128 + (2 * wv) * 16 + c16];
            const float b1 = X[(16 * J + 4 * kk + g4) * 128 + (2 * wv + 1) * 16 + c16];
            acc0 = __builtin_amdgcn_mfma_f32_16x16x4f32(av, b0, acc0, 0, 0, 0);
            acc1 = __builtin_amdgcn_mfma_f32_16x16x4f32(av, b1, acc1, 0, 0, 0);
          }
        }
#pragma unroll
        for (int r4 = 0; r4 < 4; ++r4) {
          X[(16 * I + 4 * g4 + r4) * 128 + (2 * wv) * 16 + c16] -= acc0[r4];
          X[(16 * I + 4 * g4 + r4) * 128 + (2 * wv + 1) * 16 + c16] -= acc1[r4];
        }
        __syncthreads();
      }
      if (tid < 128) {
        float x[16];
#pragma unroll
        for (int r4 = 0; r4 < 16; ++r4) x[r4] = X[(16 * I + r4) * 128 + tid];
#pragma unroll
        for (int r4 = 1; r4 < 16; ++r4) {
          const float* mr = Mf + (16 * I + r4) * 64 + 16 * I;
          float a0 = x[r4];
#pragma unroll
          for (int qb = 0; qb < (r4 + 3) / 4; ++qb) {
            const f32x4 m4 = *(const f32x4*)(mr + 4 * qb);
#pragma unroll
            for (int qq = 0; qq < 4; ++qq) if (4 * qb + qq < r4) a0 -= m4[qq] * x[4 * qb + qq];
          }
          x[r4] = a0;
        }
#pragma unroll
        for (int r4 = 0; r4 < 16; ++r4) X[(16 * I + r4) * 128 + tid] = x[r4];
      }
      __syncthreads();
    }
  }
  {
    float xr[64];
    const int c = tid & 127;
    if (tid < 128) {
#pragma unroll
      for (int j = 0; j < 64; ++j) xr[j] = X[j * 128 + c];
    }
    __syncthreads();
    if (tid < 128) {
      bf16* dst = (tid < 64 ? UT : WT) + (tid & 63) * 72;
#pragma unroll
      for (int j = 0; j < 64; j += 8) {
        u32x4 w; w.x = pk_bf16(xr[j], xr[j + 1]); w.y = pk_bf16(xr[j + 2], xr[j + 3]); w.z = pk_bf16(xr[j + 4], xr[j + 5]); w.w = pk_bf16(xr[j + 6], xr[j + 7]);
        *(u32x4*)(dst + j) = w;
      }
    }
  }
  __syncthreads();
  {
    const float bl = bcum[63];
    u32x2 qpre[4];
#pragma unroll
    for (int g = 0; g < 4; ++g) qpre[g] = *(const u32x2*)(Qeff + (wn * 32 + r) * 64 + wm * 32 + 8 * g + 4 * hh);
    f32x16 a1 = mm32((const unsigned char*)(WT + wm * 32 * 72), 144, (const unsigned char*)(aqk + wn * 32 * 72), 144, 4, zero16(), r, hh);
    f32x16 a2 = mm32((const unsigned char*)(UT + wm * 32 * 72), 144, (const unsigned char*)(aqk + wn * 32 * 72), 144, 4, zero16(), r, hh);
    f32x16 a3 = mm32((const unsigned char*)(WT + wm * 32 * 72), 144, (const unsigned char*)(KtT + wn * 32 * 72), 144, 4, zero16(), r, hh);
    f32x16 a4 = mm32((const unsigned char*)(KtT + wm * 32 * 72), 144, (const unsigned char*)(UT + wn * 32 * 72), 144, 4, zero16(), r, hh);
    const int cidx = wn * 32 + r;
    const float ebl = __expf(bl);
#pragma unroll
    for (int g = 0; g < 4; ++g) {
      const int rb = wm * 32 + 8 * g + 4 * hh;
      const u32x2 qraw = qpre[g];
      u32x2 w;
      w.x = pk_bf16(bflo(qraw.x) - a1[4 * g], bfhi(qraw.x) - a1[4 * g + 1]);
      w.y = pk_bf16(bflo(qraw.y) - a1[4 * g + 2], bfhi(qraw.y) - a1[4 * g + 3]);
      *(u32x2*)(Qeff + cidx * 64 + rb) = w;
      w.x = pk_bf16(a2[4 * g], a2[4 * g + 1]); w.y = pk_bf16(a2[4 * g + 2], a2[4 * g + 3]);
      *(u32x2*)(Oloc + cidx * 64 + rb) = w;
      f32x4 av;
#pragma unroll
      for (int k = 0; k < 4; ++k) av[k] = ((rb + k) == cidx ? ebl : 0.f) - a3[4 * g + k];
      *(f32x4*)(Ac + cidx * 64 + rb) = av;
      w.x = pk_bf16(a4[4 * g], a4[4 * g + 1]); w.y = pk_bf16(a4[4 * g + 2], a4[4 * g + 3]);
      *(u32x2*)(BT + cidx * 64 + rb) = w;
    }
  }
  __syncthreads();
}

DI void gdn_scan_item(const Params& p, int b, int h, int es, unsigned char* lds, int tid) {
  const float* AcB = (const float*)(p.ws + OFF_AR + AR_ACD);
  bf16* BTB = (bf16*)(p.ws + OFF_AR + AR_BTD);
  const int lane = tid & 63, w = tid >> 6, g = lane >> 4, c16 = lane & 15;
  float* stl = (float*)lds;
  for (int i = tid; i < 2 * 16 * 68; i += 256) stl[i] = 0.f;
  __syncthreads();
  f32x4 cur = (f32x4){0.f, 0.f, 0.f, 0.f};
  f32x4 bq[4][4]; bf16 bt[4][4];
  const size_t ci0 = ((size_t)(b * 128) * 4 + h);
  const float* apb = AcB + ci0 * 4096 + (16 * w + c16) * 64 + 16 * g;
  bf16* btb = BTB + ci0 * 4096 + (es * 16 + 4 * g) * 64 + 16 * w + c16;
#pragma unroll
  for (int s4 = 0; s4 < 4; ++s4) {
#pragma unroll
    for (int k = 0; k < 4; ++k) bq[s4][k] = *(const f32x4*)(apb + (size_t)s4 * 4 * 4096 + 4 * k);
#pragma unroll
    for (int k = 0; k < 4; ++k) bt[s4][k] = btb[(size_t)s4 * 4 * 4096 + k * 64];
  }
  for (int c0 = 0; c0 < 128; c0 += 4) {
    const bool pf = (c0 + 4 < 128);
#pragma unroll
    for (int s4 = 0; s4 < 4; ++s4) {
      const int c = c0 + s4;
      const size_t co = (size_t)c * 4 * 4096;
#pragma unroll
      for (int k = 0; k < 4; ++k) btb[co + k * 64] = f2bf(cur[k]);
      const float* sc = stl + (s4 & 1) * 16 * 68;
      f32x4 aq[4];
#pragma unroll
      for (int k = 0; k < 4; ++k) aq[k] = *(const f32x4*)(sc + c16 * 68 + 16 * g + 4 * k);
      f32x4 acc[4];
      acc[0] = (f32x4){bf2f(bt[s4][0]), bf2f(bt[s4][1]), bf2f(bt[s4][2]), bf2f(bt[s4][3])};
      acc[1] = (f32x4){0.f, 0.f, 0.f, 0.f}; acc[2] = acc[1]; acc[3] = acc[1];
#pragma unroll
      for (int q = 0; q < 4; ++q)
#pragma unroll
        for (int k = 0; k < 4; ++k) acc[k] = __builtin_amdgcn_mfma_f32_16x16x4f32(aq[k][q], bq[s4][k][q], acc[k], 0, 0, 0);
      cur = (acc[0] + acc[1]) + (acc[2] + acc[3]);
      if (pf) {
#pragma unroll
        for (int k = 0; k < 4; ++k) bq[s4][k] = *(const f32x4*)(apb + co + (size_t)4 * 4 * 4096 + 4 * k);
#pragma unroll
        for (int k = 0; k < 4; ++k) bt[s4][k] = btb[co + (size_t)4 * 4 * 4096 + k * 64];
      }
      float* sn = stl + ((s4 + 1) & 1) * 16 * 68;
#pragma unroll
      for (int k = 0; k < 4; ++k) sn[(4 * g + k) * 68 + 16 * w + c16] = cur[k];
      __syncthreads();
    }
  }
}

DI void gdn_out_item(const Params& p, int l, int ci, unsigned char* lds, int tid) {
  const bf16* z = (const bf16*)(p.ws + OFF_AR + AR_Z);
  const bf16* ST = (const bf16*)(p.ws + OFF_AR + AR_BTD) + (size_t)ci * 4096;
  const bf16* Qeff = (const bf16*)(p.ws + OFF_AR + AR_QEFF) + (size_t)ci * 4096;
  const bf16* Oloc = (const bf16*)(p.ws + OFF_AR + AR_OLOC) + (size_t)ci * 4096;
  bf16* mix = (bf16*)(p.ws + OFF_AR + AR_MIX);
  const int h = ci & 3, t0 = (ci >> 2) * 64;
  float* obuf = (float*)lds;
  unsigned char* ql = lds + 17408;
  unsigned char* sl = ql + 9216;
  const u32x4* gpre = (const u32x4*)(z + (size_t)(t0 + (tid >> 2)) * ZLD + ZD_Z + h * 64 + (tid & 3) * 16);
  const u32x4 gq0 = gpre[0], gq1 = gpre[1];
  const u32x4* apre = (const u32x4*)(Oloc + (tid >> 2) * 64 + (tid & 3) * 16);
  const u32x4 aq0 = apre[0], aq1 = apre[1];
#pragma unroll
  for (int id = tid; id < 512; id += 256) {
    const int rr = id >> 3, ch = id & 7;
    *(u32x4*)(ql + rr * 144 + ch * 16) = *(const u32x4*)(Qeff + rr * 64 + ch * 8);
    *(u32x4*)(sl + rr * 144 + ch * 16) = *(const u32x4*)(ST + rr * 64 + ch * 8);
  }
  __syncthreads();
  const int lane = tid & 63, wv = tid >> 6, wm = wv & 1, wn = wv >> 1, r = lane & 31, hh = lane >> 5;
  {
    f32x16 acc = mm32(ql + wm * 32 * 144, 144, sl + wn * 32 * 144, 144, 4, zero16(), r, hh);
    const int e = wn * 32 + r;
#pragma unroll
    for (int g = 0; g < 4; ++g)
#pragma unroll
      for (int k = 0; k < 4; ++k) obuf[(wm * 32 + 8 * g + 4 * hh + k) * 68 + e] = acc[4 * g + k];
  }
  __syncthreads();
  norm_gate_store<false>(obuf, true, aq0, aq1, p.gdn_ng + l * 64, gq0, gq1, mix + (size_t)t0 * 1024 + 768 + h * 64, tid);
  __syncthreads();
}

DI void mla_proj_item(const Params& p, int l, int tile, unsigned char* lds, int tid) {
  const bf16* z = (const bf16*)(p.ws + OFF_AR + AR_Z);
  const bf16* Wl = (const bf16*)(p.ws + OFF_W) + (size_t)l * WL_E;
  const bf16* Wuq = Wl + WO_UQ;
  const bf16* Wukv = Wl + WO_UKV;
  bf16* Qg = (bf16*)(p.ws + OFF_AR + AR_Q);
  bf16* Kg = (bf16*)(p.ws + OFF_AR + AR_K);
  bf16* Vt = (bf16*)(p.ws + OFF_AR + AR_VT);
  const int t0 = tile * 64, b = t0 / S_, s0 = t0 % S_;
  unsigned char* Aq = lds;
  unsigned char* Akv = lds + 33792;
  float* rsq = (float*)(lds + 33792 + 17408);
  float* rskv = rsq + 64;
#pragma unroll
  for (int id = tid; id < 64 * 32; id += 256) { const int rr = id >> 5, ch = id & 31; *(u32x4*)(Aq + rr * 528 + ch * 16) = *(const u32x4*)(z + (size_t)(t0 + rr) * ZLD + ZC_Q + ch * 8); }
#pragma unroll
  for (int id = tid; id < 64 * 16; id += 256) { const int rr = id >> 4, ch = id & 15; *(u32x4*)(Akv + rr * 272 + ch * 16) = *(const u32x4*)(z + (size_t)(t0 + rr) * ZLD + ZC_KV + ch * 8); }
  bf16 kr1[4], kr2[4];
#pragma unroll
  for (int k = 0; k < 4; ++k) { const int id = tid + 256 * k, m = id >> 4, i2 = id & 15; kr1[k] = z[(size_t)(t0 + m) * ZLD + ZC_KR + i2]; kr2[k] = z[(size_t)(t0 + m) * ZLD + ZC_KR + 16 + i2]; }
  __syncthreads();
  {
    const int rr = tid >> 2, qd = tid & 3;
    float s1 = 0.f, s2 = 0.f;
#pragma unroll
    for (int k = 0; k < 8; ++k) { const u32x4 u = *(const u32x4*)(Aq + rr * 528 + qd * 128 + k * 16);
#pragma unroll
      for (int i = 0; i < 4; ++i) { const float a = bflo(u[i]), b = bfhi(u[i]); s1 += a * a + b * b; } }
#pragma unroll
    for (int k = 0; k < 4; ++k) { const u32x4 u = *(const u32x4*)(Akv + rr * 272 + qd * 64 + k * 16);
#pragma unroll
      for (int i = 0; i < 4; ++i) { const float a = bflo(u[i]), b = bfhi(u[i]); s2 += a * a + b * b; } }
    s1 += __shfl_xor(s1, 1); s1 += __shfl_xor(s1, 2); s2 += __shfl_xor(s2, 1); s2 += __shfl_xor(s2, 2);
    if (qd == 0) { rsq[rr] = rsqrtf(s1 * (1.f / 256.f) + EPS); rskv[rr] = rsqrtf(s2 * (1.f / 128.f) + EPS); }
#pragma unroll
    for (int id = tid; id < 1024; id += 256) {
      const int m = id >> 4, i = id & 15;
      const float inv = __builtin_amdgcn_exp2f(-(float)i * (13.287712379549449f / 16.f));
      const float ang = (float)(s0 + m) * inv;
      const double rev = (double)ang * 0.15915494309189535;
      const float fr = (float)(rev - floor(rev));
      const float sn = __builtin_amdgcn_sinf(fr), cs = __builtin_amdgcn_cosf(fr);
      const float x1 = bf2f(kr1[id >> 8]), x2 = bf2f(kr2[id >> 8]);
      const bf16 o1 = f2bf(x1 * cs - x2 * sn), o2 = f2bf(x2 * cs + x1 * sn);
      { bf16* krl = (bf16*)(lds + 51712); krl[m * 32 + i] = o1; krl[m * 32 + 16 + i] = o2; }
    }
  }
  __syncthreads();
  const int lane = tid & 63, hd = tid >> 6, r = lane & 31, hh = lane >> 5;
  const float QS = 0.10206207261596575f * 1.4426950408889634f;
  {
    f32x16 acc[3][2];
#pragma unroll
    for (int i = 0; i < 3; ++i) { acc[i][0] = zero16(); acc[i][1] = zero16(); }
#pragma unroll 8
    for (int kk = 0; kk < 16; ++kk) {
      bf16x8 af[2], bw[3];
#pragma unroll
      for (int mi = 0; mi < 2; ++mi) af[mi] = *(const bf16x8*)(Aq + (mi * 32 + r) * 528 + kk * 32 + hh * 16);
#pragma unroll
      for (int ni = 0; ni < 3; ++ni) bw[ni] = *(const bf16x8*)(Wuq + ((size_t)(((hd * 16 + kk) * 3 + ni) * 64 + lane)) * 8);
#pragma unroll
      for (int ni = 0; ni < 3; ++ni)
#pragma unroll
        for (int mi = 0; mi < 2; ++mi) acc[ni][mi] = MFMA32(bw[ni], af[mi], acc[ni][mi]);
    }
    __syncthreads();
    unsigned char* wbuf = lds + hd * 6400;
#pragma unroll
    for (int mi = 0; mi < 2; ++mi) {
      const int m = mi * 32 + r;
      const float sc = rsq[m] * QS;
      bf16* qp = (bf16*)(wbuf + r * 200);
#pragma unroll
      for (int ni = 0; ni < 2; ++ni)
#pragma unroll
        for (int g = 0; g < 4; ++g) {
          u32x2 w; w.x = pk_bf16(acc[ni][mi][4 * g] * sc, acc[ni][mi][4 * g + 1] * sc); w.y = pk_bf16(acc[ni][mi][4 * g + 2] * sc, acc[ni][mi][4 * g + 3] * sc);
          *(u32x2*)(qp + ni * 32 + 8 * g + 4 * hh) = w;
        }
#pragma unroll
      for (int g = 0; g < 2; ++g) {
        float o1[4], o2[4];
#pragma unroll
        for (int k = 0; k < 4; ++k) {
          const int i = 8 * g + 4 * hh + k;
          const float inv = __builtin_amdgcn_exp2f(-(float)i * (13.287712379549449f / 16.f));
          const float ang = (float)(s0 + m) * inv;
          const double rev = (double)ang * 0.15915494309189535;
          const float fr = (float)(rev - floor(rev));
          const float sn = __builtin_amdgcn_sinf(fr), cs = __builtin_amdgcn_cosf(fr);
          const float x1 = acc[2][mi][4 * g + k] * sc, x2 = acc[2][mi][4 * (g + 2) + k] * sc;
          o1[k] = x1 * cs - x2 * sn; o2[k] = x2 * cs + x1 * sn;
        }
        u32x2 w; w.x = pk_bf16(o1[0], o1[1]); w.y = pk_bf16(o1[2], o1[3]);
        *(u32x2*)(qp + 64 + 8 * g + 4 * hh) = w;
        w.x = pk_bf16(o2[0], o2[1]); w.y = pk_bf16(o2[2], o2[3]);
        *(u32x2*)(qp + 80 + 8 * g + 4 * hh) = w;
      }
#pragma unroll
      for (int k = 0; k < 6; ++k) {
        const int id = lane + 64 * k, row = id / 12, ch = id % 12;
        const u32x2 lo = *(const u32x2*)(wbuf + row * 200 + ch * 16), hi = *(const u32x2*)(wbuf + row * 200 + ch * 16 + 8);
        *(u32x4*)(Qg + ((size_t)(b * 4 + hd) * S_ + s0 + mi * 32 + row) * 96 + ch * 8) = (u32x4){lo.x, lo.y, hi.x, hi.y};
      }
    }
  }
  {
    f32x16 acc[2][2];
#pragma unroll
    for (int i = 0; i < 2; ++i) { acc[i][0] = zero16(); acc[i][1] = zero16(); }
#pragma unroll
    for (int kk = 0; kk < 8; ++kk) {
      bf16x8 af[2], bw[2];
#pragma unroll
      for (int mi = 0; mi < 2; ++mi) af[mi] = *(const bf16x8*)(Akv + (mi * 32 + r) * 272 + kk * 32 + hh * 16);
#pragma unroll
      for (int ni = 0; ni < 2; ++ni) bw[ni] = *(const bf16x8*)(Wukv + ((size_t)((((hd * 2 + 0) * 8 + kk) * 2 + ni) * 64 + lane)) * 8);
#pragma unroll
      for (int ni = 0; ni < 2; ++ni)
#pragma unroll
        for (int mi = 0; mi < 2; ++mi) acc[ni][mi] = MFMA32(bw[ni], af[mi], acc[ni][mi]);
    }
    unsigned char* wbuf = lds + hd * 6400;
    const unsigned char* krl = lds + 51712;
#pragma unroll
    for (int mi = 0; mi < 2; ++mi) {
      const int m = mi * 32 + r;
      const float sc = rskv[m];
      bf16* kp = (bf16*)(wbuf + r * 200);
#pragma unroll
      for (int ni = 0; ni < 2; ++ni)
#pragma unroll
        for (int g = 0; g < 4; ++g) {
          u32x2 w; w.x = pk_bf16(acc[ni][mi][4 * g] * sc, acc[ni][mi][4 * g + 1] * sc); w.y = pk_bf16(acc[ni][mi][4 * g + 2] * sc, acc[ni][mi][4 * g + 3] * sc);
          *(u32x2*)(kp + ni * 32 + 8 * g + 4 * hh) = w;
        }
#pragma unroll
      for (int k = 0; k < 6; ++k) {
        const int id = lane + 64 * k, row = id / 12, ch = id % 12;
        const unsigned char* src = (ch < 8) ? (wbuf + row * 200 + ch * 16) : (krl + (mi * 32 + row) * 64 + (ch - 8) * 16);
        const u32x2 lo = *(const u32x2*)src, hi = *(const u32x2*)(src + 8);
        *(u32x4*)(Kg + ((size_t)(b * 4 + hd) * S_ + s0 + mi * 32 + row) * 96 + ch * 8) = (u32x4){lo.x, lo.y, hi.x, hi.y};
      }
    }
  }
  {
    f32x16 acc[2][2];
#pragma unroll
    for (int i = 0; i < 2; ++i) { acc[i][0] = zero16(); acc[i][1] = zero16(); }
#pragma unroll
    for (int kk = 0; kk < 8; ++kk) {
      bf16x8 af[2], bw[2];
#pragma unroll
      for (int mi = 0; mi < 2; ++mi) af[mi] = *(const bf16x8*)(Akv + (mi * 32 + r) * 272 + kk * 32 + hh * 16);
#pragma unroll
      for (int ni = 0; ni < 2; ++ni) bw[ni] = *(const bf16x8*)(Wukv + ((size_t)((((hd * 2 + 1) * 8 + kk) * 2 + ni) * 64 + lane)) * 8);
#pragma unroll
      for (int mi = 0; mi < 2; ++mi)
#pragma unroll
        for (int ni = 0; ni < 2; ++ni) acc[mi][ni] = MFMA32(af[mi], bw[ni], acc[mi][ni]);
    }
#pragma unroll
    for (int ni = 0; ni < 2; ++ni) {
      unsigned char* wbuf = lds + hd * 6400;
      bf16* vp = (bf16*)(wbuf + r * 136);
#pragma unroll
      for (int mi = 0; mi < 2; ++mi)
#pragma unroll
        for (int g = 0; g < 4; ++g) {
          const int m = mi * 32 + 8 * g + 4 * hh;
          u32x2 w; w.x = pk_bf16(acc[mi][ni][4 * g] * rskv[m], acc[mi][ni][4 * g + 1] * rskv[m + 1]); w.y = pk_bf16(acc[mi][ni][4 * g + 2] * rskv[m + 2], acc[mi][ni][4 * g + 3] * rskv[m + 3]);
          *(u32x2*)(vp + m) = w;
        }
#pragma unroll
      for (int k = 0; k < 4; ++k) {
        const int id = lane + 64 * k, row = id >> 3, ch = id & 7;
        const u32x2 lo = *(const u32x2*)(wbuf + row * 136 + ch * 16), hi = *(const u32x2*)(wbuf + row * 136 + ch * 16 + 8);
        *(u32x4*)(Vt + ((size_t)(b * 4 + hd) * 64 + ni * 32 + row) * S_ + s0 + ch * 8) = (u32x4){lo.x, lo.y, hi.x, hi.y};
      }
    }
  }
  __syncthreads();
}

DI void attn_item(const Params& p, int bh, int qb, unsigned char* lds, int tid) {
  const bf16* Qg = (const bf16*)(p.ws + OFF_AR + AR_Q) + (size_t)bh * S_ * 96;
  const bf16* Kg = (const bf16*)(p.ws + OFF_AR + AR_K) + (size_t)bh * S_ * 96;
  const bf16* Vt = (const bf16*)(p.ws + OFF_AR + AR_VT) + (size_t)bh * 64 * S_;
  bf16* mix = (bf16*)(p.ws + OFF_AR + AR_MIX);
  const int lane = tid & 63, w = tid >> 6, r = lane & 31, hh = lane >> 5;
  const int q0 = qb * 128, qrow = q0 + 32 * w + r;
  const int ntiles = 2 * qb + 2;
  constexpr int STG = 64 * 208 + 64 * 144;
  bf16x8 qf[6];
#pragma unroll
  for (int kk = 0; kk < 6; ++kk) qf[kk] = *(const bf16x8*)(Qg + (size_t)qrow * 96 + kk * 16 + hh * 8);
  f32x16 ot[2] = {zero16(), zero16()};
  float mrun = -1e30f, lrun = 0.f;
  u32x4 rk[3], rv[2];
  int krow[3], kch[3];
#pragma unroll
  for (int i = 0; i < 3; ++i) { const int id = tid + 256 * i; krow[i] = id / 12; kch[i] = id % 12; }
  const int vrow0 = tid >> 3, vch = tid & 7;
#pragma unroll
  for (int i = 0; i < 3; ++i) rk[i] = *(const u32x4*)(Kg + (size_t)krow[i] * 96 + kch[i] * 8);
#pragma unroll
  for (int i = 0; i < 2; ++i) rv[i] = *(const u32x4*)(Vt + (size_t)(vrow0 + 32 * i) * S_ + vch * 8);
  __syncthreads();
#pragma unroll
  for (int i = 0; i < 3; ++i) *(u32x4*)(lds + krow[i] * 208 + kch[i] * 16) = rk[i];
#pragma unroll
  for (int i = 0; i < 2; ++i) *(u32x4*)(lds + 13312 + (vrow0 + 32 * i) * 144 + vch * 16) = rv[i];
  __syncthreads();
  for (int kt = 0; kt < ntiles; ++kt) {
    const unsigned char* Ks = lds + (kt & 1) * STG;
    const unsigned char* Vs = Ks + 13312;
    if (kt + 1 < ntiles) {
#pragma unroll
      for (int i = 0; i < 3; ++i) rk[i] = *(const u32x4*)(Kg + (size_t)((kt + 1) * 64 + krow[i]) * 96 + kch[i] * 8);
#pragma unroll
      for (int i = 0; i < 2; ++i) rv[i] = *(const u32x4*)(Vt + (size_t)(vrow0 + 32 * i) * S_ + (kt + 1) * 64 + vch * 8);
    }
    if (kt * 64 <= q0 + 32 * w + 31) {
      f32x16 st[2];
#pragma unroll
      for (int k2 = 0; k2 < 2; ++k2) {
        st[k2] = zero16();
#pragma unroll
        for (int kk = 0; kk < 6; ++kk) {
          bf16x8 kf = *(const bf16x8*)(Ks + (k2 * 32 + r) * 208 + kk * 32 + hh * 16);
          st[k2] = MFMA32(kf, qf[kk], st[k2]);
        }
      }
      if (kt * 64 + 63 > q0 + 32 * w) {
#pragma unroll
        for (int k2 = 0; k2 < 2; ++k2)
#pragma unroll
          for (int g = 0; g < 4; ++g)
#pragma unroll
            for (int k = 0; k < 4; ++k) {
              const int key = kt * 64 + k2 * 32 + 8 * g + 4 * hh + k;
              if (key > qrow) st[k2][4 * g + k] = -1e30f;
            }
      }
      float mt = st[0][0];
#pragma unroll
      for (int k2 = 0; k2 < 2; ++k2)
#pragma unroll
        for (int i = 0; i < 16; ++i) mt = fmaxf(mt, st[k2][i]);
      mt = fmaxf(mt, __shfl_xor(mt, 32));
      const float mnew = fmaxf(mrun, mt);
      const float alpha = __builtin_amdgcn_exp2f(mrun - mnew);
      mrun = mnew;
      float ls = 0.f;
#pragma unroll
      for (int k2 = 0; k2 < 2; ++k2)
#pragma unroll
        for (int i = 0; i < 16; ++i) { const float pv = __builtin_amdgcn_exp2f(st[k2][i] - mnew); st[k2][i] = pv; ls += pv; }
      lrun = lrun * alpha + ls;
      if (__any(alpha != 1.f)) {
#pragma unroll
        for (int dt = 0; dt < 2; ++dt)
#pragma unroll
          for (int i = 0; i < 16; ++i) ot[dt][i] *= alpha;
      }
#pragma unroll
      for (int k2 = 0; k2 < 2; ++k2)
#pragma unroll
        for (int s = 0; s < 2; ++s) {
          u32x4 pw;
          pw.x = pk_bf16(st[k2][8 * s], st[k2][8 * s + 1]); pw.y = pk_bf16(st[k2][8 * s + 2], st[k2][8 * s + 3]);
          pw.z = pk_bf16(st[k2][8 * s + 4], st[k2][8 * s + 5]); pw.w = pk_bf16(st[k2][8 * s + 6], st[k2][8 * s + 7]);
          const bf16x8 pf = __builtin_bit_cast(bf16x8, pw);
#pragma unroll
          for (int dt = 0; dt < 2; ++dt) {
            const unsigned char* vp = Vs + (dt * 32 + r) * 144 + (k2 * 32 + s * 16 + 4 * hh) * 2;
            u32x2 v0 = *(const u32x2*)vp, v1 = *(const u32x2*)(vp + 16);
            u32x4 vw = (u32x4){v0.x, v0.y, v1.x, v1.y};
            ot[dt] = MFMA32(__builtin_bit_cast(bf16x8, vw), pf, ot[dt]);
          }
        }
    }
    if (kt + 1 < ntiles) {
      unsigned char* Kw = lds + ((kt + 1) & 1) * STG;
#pragma unroll
      for (int i = 0; i < 3; ++i) *(u32x4*)(Kw + krow[i] * 208 + kch[i] * 16) = rk[i];
#pragma unroll
      for (int i = 0; i < 2; ++i) *(u32x4*)(Kw + 13312 + (vrow0 + 32 * i) * 144 + vch * 16) = rv[i];
    }
    __syncthreads();
  }
  const float lt = lrun + __shfl_xor(lrun, 32);
  const float inv = 1.f / lt;
  const int b = bh >> 2, hd = bh & 3;
  bf16* op = mix + ((size_t)b * S_ + qrow) * 1024 + 512 + hd * 64;
#pragma unroll
  for (int dt = 0; dt < 2; ++dt)
#pragma unroll
    for (int g = 0; g < 4; ++g) {
      u32x2 wv; wv.x = pk_bf16(ot[dt][4 * g] * inv, ot[dt][4 * g + 1] * inv); wv.y = pk_bf16(ot[dt][4 * g + 2] * inv, ot[dt][4 * g + 3] * inv);
      *(u32x2*)(op + dt * 32 + 8 * g + 4 * hh) = wv;
    }
}

DI void grid_bar(unsigned* flags, unsigned k) {
  asm volatile("s_waitcnt vmcnt(0) lgkmcnt(0)" ::: "memory");
  __syncthreads();
  if (threadIdx.x == 0) { __threadfence(); __hip_atomic_store(flags + blockIdx.x, k, __ATOMIC_RELAXED, __HIP_MEMORY_SCOPE_AGENT); }
  const unsigned nb = gridDim.x;
  for (;;) {
    int ok = 1;
    for (unsigned i = threadIdx.x; i < nb; i += blockDim.x) ok &= (__hip_atomic_load(flags + i, __ATOMIC_RELAXED, __HIP_MEMORY_SCOPE_AGENT) >= k) ? 1 : 0;
    if (__syncthreads_and(ok)) break;
    __builtin_amdgcn_s_sleep(1);
  }
  if (threadIdx.x == 0) __threadfence();
  __syncthreads();
}
__global__ void __launch_bounds__(512, 2) fwd_megakernel(Params p0) {
  extern __shared__ __attribute__((aligned(16))) unsigned char lds_all[];
  __shared__ int s_item;
  cg::grid_group grid = cg::this_grid();
  unsigned nbar = 0;
  const int nvb = gridDim.x * 2;
#define GBAR() do { nbar += 1; grid_bar((unsigned*)(p0.ws + OFF_CTL) + 256, nbar); } while (0)
#define PH_BEGIN() Params q = p0; { unsigned long long w_ = (unsigned long long)q.ws; asm volatile("" : "+s"(w_)); q.ws = (unsigned char*)w_; } int tid5 = threadIdx.x; asm volatile("" : "+v"(tid5)); const int tid = tid5 & 255, half = tid5 >> 8, vb = blockIdx.x * 2 + half; unsigned char* lds = lds_all + half * LDS_HALF; (void)vb; (void)lds; \
  unsigned char* ws = q.ws; bf16* W = (bf16*)(ws + OFF_W); float* rs = (float*)(ws + OFF_RS); bf16* zb = (bf16*)(ws + OFF_AR + AR_Z); bf16* yb = (bf16*)(ws + OFF_AR + AR_Y); \
  bf16* up = (bf16*)(ws + OFF_AR + AR_UP); bf16* mix = (bf16*)(ws + OFF_AR + AR_MIX); bf16* xb = mix; unsigned* ctl = (unsigned*)(ws + OFF_CTL); \
  const bf16* Wl = W + (size_t)l * WL_E; (void)rs; (void)zb; (void)yb; (void)up; (void)mix; (void)xb; (void)ctl; (void)Wl; (void)tid; (void)tid5;
  { const int l = 0; PH_BEGIN(); phase0(q, lds, tid, half); }
  { const int l = 0; PH_BEGIN(); resid_phase(q.x, nullptr, nullptr, nullptr, nullptr, xb, rs, tid, vb, nvb); }
  if (p0.ws == nullptr) grid.sync();
  GBAR();

  for (int l = 0; l < 2; ++l) {
    { PH_BEGIN(); EpiStore e{zb, zb, 1 << 30, ZLD, rs, nullptr}; gemm_phase<false>(l == 0 ? xb : (const bf16*)q.out, 1024, Wl + WO_IN, 1024, 1024, 128, 13, e, lds_all, tid5); }
    GBAR();
    for (int pi = blockIdx.x; pi < (2048 * 3 + 512) / 2; pi += gridDim.x) {
      PH_BEGIN();
      const int it = 2 * pi + half;
      if (it < 2048) gdn_local_item(q, l, it, lds, tid);
      else if (it < 4096) gla_local_item<64, true>(q, l, it - 2048, lds, tid);
      else if (it < 6144) gla_local_item<32, false>(q, l, it - 4096, lds, tid);
      else mla_proj_item(q, l, it - 6144, lds, tid);
    }
    GBAR();
    for (;;) {
      PH_BEGIN();
      if (tid5 == 0) s_item = (int)atomicAdd(&ctl[l], 1u);
      __syncthreads();
      const int pit = s_item;
      __syncthreads();
      if (pit >= 80 + 512) break;
      if (pit < 32) { const int it = 2 * pit + half; gdn_scan_item(q, it >> 4, (it >> 2) & 3, it & 3, lds, tid); }
      else if (pit < 64) { const int j = 2 * (pit - 32) + half; gla_scan_item<64>((bf16*)(ws + OFF_AR + AR_UTA), (const float*)(ws + OFF_GA), j >> 4, (j >> 2) & 3, j & 3, tid); }
      else if (pit < 80) { const int j = 2 * (pit - 64) + half; gla_scan_item<32>((bf16*)(ws + OFF_AR + AR_UTB), (const float*)(ws + OFF_GB), j >> 3, (j >> 1) & 3, j & 1, tid); }
      else { const int a = pit - 80; attn_item(q, 2 * (a & 7) + half, 63 - (a >> 3), lds, tid); }
    }
    GBAR();
    for (int pi = blockIdx.x; pi < 2048 * 3 / 2; pi += gridDim.x) {
      PH_BEGIN();
      const int it = 2 * pi + half;
      if (it < 2048) gdn_out_item(q, l, it, lds, tid);
      else if (it < 4096) gla_out_item<64, true>(q, l, it - 2048, lds, tid);
      else gla_out_item<32, false>(q, l, it - 4096, lds, tid);
    }
    GBAR();
    { PH_BEGIN(); EpiStore e{yb, yb, 1 << 30, 1024, nullptr, nullptr}; gemm_phase<false>(mix, 1024, Wl + WO_OUT, 1024, 1024, 128, 4, e, lds_all, tid5); }
    GBAR();
    { PH_BEGIN(); resid_phase(l == 0 ? q.x : nullptr, (const bf16*)q.out, yb, q.post_mix_g + l * 1024, nullptr, xb, rs, tid, vb, nvb); }
    GBAR();
    { PH_BEGIN(); EpiStore e{up, up, 1 << 30, FF, rs, q.ffn_conv + (size_t)l * 3 * FF}; gemm_phase<true>(xb, 1024, Wl + WO_GU, 1024, 1024, 136, 22, e, lds_all, tid5); }
    GBAR();
    { PH_BEGIN(); EpiStore e{yb, yb, 1 << 30, 1024, nullptr, nullptr}; gemm_phase<false>(up, FF, Wl + WO_DN, FF, FF, 128, 4, e, lds_all, tid5); }
    GBAR();
    { PH_BEGIN(); resid_phase(nullptr, xb, yb, q.post_ffn_g + l * 1024, l == 1 ? q.out : nullptr, l == 1 ? nullptr : (bf16*)q.out, rs, tid, vb, nvb); }
    GBAR();
  }
}

extern "C" void kernel_launch(void* const* d_in, const int* in_sizes, int n_in, void* d_out, int out_size, void* d_ws, size_t ws_size, hipStream_t stream) {
  static int grid_blocks = 0;
  if (!grid_blocks) {
    int dev = 0, cus = 0, per_cu = 0;
    hipGetDevice(&dev);
    hipDeviceGetAttribute(&cus, hipDeviceAttributeMultiprocessorCount, dev);
    hipFuncSetAttribute((const void*)fwd_megakernel, hipFuncAttributeMaxDynamicSharedMemorySize, LDS_BYTES);
    hipOccupancyMaxActiveBlocksPerMultiprocessor(&per_cu, (const void*)fwd_megakernel, 512, LDS_BYTES);
    if (per_cu < 1) per_cu = 1;
    if (per_cu > 1) per_cu = 1;
    grid_blocks = cus * per_cu;
    if (ws_size < WS_END) fprintf(stderr, "kernel_launch: workspace too small: %zu < %zu\n", ws_size, (size_t)WS_END);
  }
  Params p{};
  const float** pp = (const float**)&p;
  for (int i = 0; i < 24; ++i) pp[i] = (const float*)d_in[i];
  p.out = (float*)d_out; p.ws = (unsigned char*)d_ws;
  hipMemsetAsync((unsigned char*)d_ws + OFF_CTL, 0, 8192, stream);
  void* args[] = {&p};
  hipError_t e = hipLaunchCooperativeKernel((const void*)fwd_megakernel, dim3(grid_blocks), dim3(512), args, LDS_BYTES, stream);
  if (e != hipSuccess) fprintf(stderr, "cooperative launch failed: %s (grid %d)\n", hipGetErrorString(e), grid_blocks);
}
```

```cpp
#include <hip/hip_runtime.h>
#include <hip/hip_cooperative_groups.h>
#include <cstdio>
#include <cstdint>
namespace cg = cooperative_groups;

#define DI __device__ __forceinline__
typedef unsigned short bf16;
typedef __attribute__((ext_vector_type(8))) short bf16x8;
typedef __attribute__((ext_vector_type(4))) short bf16x4;
typedef __attribute__((ext_vector_type(16))) float f32x16;
typedef __attribute__((ext_vector_type(4))) float f32x4;
typedef __attribute__((ext_vector_type(4))) unsigned u32x4;
typedef __attribute__((ext_vector_type(2))) unsigned u32x2;

constexpr int T_ = 32768, S_ = 8192, D_ = 1024, ZLD = 3328, FF = 2816, DIN = 3256;
constexpr float EPS = 1e-6f;
constexpr int ZA_Q = 0, ZA_F = 256, ZA_I = 512, ZA_G = 768, ZB_Q = 1024, ZB_K = 1152, ZB_V = 1280, ZB_G = 1536, ZC_Q = 1792, ZC_KV = 2048,
              ZD_Q = 2176, ZD_K = 2432, ZD_V = 2688, ZD_Z = 2944, ZC_KR = 3200, ZB_CODE = 3232, ZD_BETA = 3248, ZD_A = 3252;
constexpr size_t WIN_E = (size_t)ZLD * 1024, WOUT_E = 1024 * 1024, WGU_E = (size_t)2 * FF * 1024, WDN_E = (size_t)1024 * FF, WUQ_E = 384 * 256, WUKV_E = 512 * 128;
constexpr size_t WO_IN = 0, WO_OUT = WO_IN + WIN_E, WO_GU = WO_OUT + WOUT_E, WO_DN = WO_GU + WGU_E, WO_UQ = WO_DN + WDN_E, WO_UKV = WO_UQ + WUQ_E, WL_E = WO_UKV + WUKV_E;
constexpr size_t OFF_W = 0;
constexpr size_t OFF_CTL = OFF_W + 2 * WL_E * 2;
constexpr size_t OFF_RS = OFF_CTL + 8192;
constexpr size_t OFF_GA = OFF_RS + (size_t)T_ * 4;
constexpr size_t OFF_GB = OFF_GA + (size_t)2048 * 64 * 4;
constexpr size_t OFF_AR = OFF_GB + (size_t)2048 * 32 * 4;
constexpr size_t AR_Z = 0, AR_Y = 0, AR_GATE = 0, AR_UP = (size_t)T_ * FF * 2;
constexpr size_t AR_SCAN = (size_t)T_ * ZLD * 2;
constexpr size_t AR_UTA = AR_SCAN, AR_UTB = AR_UTA + (size_t)2048 * 64 * 64 * 2, AR_ACD = AR_UTB + (size_t)2048 * 64 * 32 * 2, AR_BTD = AR_ACD + (size_t)2048 * 4096 * 4,
                 AR_QEFF = AR_BTD + (size_t)2048 * 4096 * 2, AR_OLOC = AR_QEFF + (size_t)2048 * 4096 * 2, AR_MLA = AR_OLOC + (size_t)2048 * 4096 * 2;
constexpr size_t AR_Q = AR_MLA, AR_K = AR_Q + (size_t)T_ * 4 * 96 * 2, AR_VT = AR_K + (size_t)T_ * 4 * 96 * 2, AR_MIX = AR_VT + (size_t)T_ * 4 * 64 * 2;
constexpr size_t AR_END = AR_MIX + (size_t)T_ * 1024 * 2;
constexpr size_t WS_END = OFF_AR + AR_END;
static_assert(WS_END <= (size_t)512 * 1024 * 1024, "workspace too large");
static_assert(AR_UP + (size_t)T_ * FF * 2 <= AR_MIX, "gate/up overlaps xb");

constexpr size_t BC_OFF = (size_t)T_ * 1024 * 2, BC_B_OFF = (size_t)2048 * 64 * 64 * 4;
static_assert(BC_OFF + BC_B_OFF + (size_t)2048 * 64 * 32 * 4 <= (size_t)T_ * 1024 * 4, "decay tables exceed the output buffer");
constexpr int LDS_HALF = 73728, LDS_BYTES = 2 * LDS_HALF;
#ifndef PROBE_DUP
#define PROBE_DUP 0
#endif

struct Params {
  const float* x; const float* w_in; const float* w_out; const float* pre_mix_g; const float* post_mix_g; const float* pre_ffn_g; const float* post_ffn_g;
  const float* hgrn_lb; const float* hgrn_ng; const float* gla_w2; const float* gla_b; const float* gla_ng;
  const float* mla_qg; const float* mla_wuq; const float* mla_kvg; const float* mla_wukv;
  const float* gdn_conv; const float* gdn_alog; const float* gdn_dtb; const float* gdn_ng;
  const float* ffn_wg; const float* ffn_wu; const float* ffn_conv; const float* ffn_wd;
  float* out; unsigned char* ws;
};

typedef __bf16 bf16v2_t __attribute__((ext_vector_type(2)));
typedef float f32v2_t __attribute__((ext_vector_type(2)));
DI unsigned pk_bf16(float lo, float hi) { f32v2_t v = {lo, hi}; bf16v2_t b = __builtin_convertvector(v, bf16v2_t); return __builtin_bit_cast(unsigned, b); }
DI float bf2f(bf16 v) { return __uint_as_float(((unsigned)v) << 16); }
DI bf16 f2bf(float x) { return (bf16)(pk_bf16(x, 0.f) & 0xffffu); }
DI float bflo(unsigned u) { return __uint_as_float(u << 16); }
DI float bfhi(unsigned u) { return __uint_as_float(u & 0xffff0000u); }
DI float sigmoidf_(float x) { return 1.f / (1.f + __expf(-x)); }
DI float siluf_(float x) { return x * sigmoidf_(x); }
DI float softplusf_(float x) { return fmaxf(x, 0.f) + __logf(1.f + __expf(-fabsf(x))); }
DI float wave_sum(float v) {
#pragma unroll
  for (int o = 1; o < 64; o <<= 1) v += __shfl_xor(v, o);
  return v;
}
#define MFMA32(a, b, c) __builtin_amdgcn_mfma_f32_32x32x16_bf16((a), (b), (c), 0, 0, 0)

DI f32x16 mm32(const unsigned char* A, int lda, const unsigned char* B, int ldb, int ks, f32x16 acc, int r, int h) {
  const unsigned char* pa = A + r * lda + h * 16;
  const unsigned char* pb = B + r * ldb + h * 16;
  for (int kk = 0; kk < ks; ++kk) {
    bf16x8 a = *(const bf16x8*)(pa + kk * 32);
    bf16x8 b = *(const bf16x8*)(pb + kk * 32);
    acc = MFMA32(a, b, acc);
  }
  return acc;
}
DI f32x16 zero16() { f32x16 z; for (int i = 0; i < 16; ++i) z[i] = 0.f; return z; }

DI int win_srccol(int n) {
  if (n < 1536) return n;
  if (n < 1792) return 1552 + (n - 1536);
  if (n < 2048) return 1808 + (n - 1792);
  if (n < 2176) return 2064 + (n - 2048);
  if (n < 2432) return 2224 + (n - 2176);
  if (n < 2688) return 2480 + (n - 2432);
  if (n < 2944) return 2736 + (n - 2688);
  if (n < 3200) return 3000 + (n - 2944);
  if (n < 3232) return 2192 + (n - 3200);
  if (n < 3248) return 1536 + (n - 3232);
  if (n < 3252) return 2992 + (n - 3248);
  if (n < 3256) return 2996 + (n - 3252);
  return -1;
}
DI int gu_rowmap(int c, int mode) { return mode == 0 ? c : ((c >> 7) * 256 + (c & 127) + (mode == 2 ? 128 : 0)); }
DI void transpose_tile(const float* __restrict__ src, int ldsrc, int K, bool perm, const float* __restrict__ gain, bf16* __restrict__ dst, int n0, int k0, unsigned char* lds, int tid, int rowmode = 0) {
  bf16* t = (bf16*)lds;
  const int nl = tid & 63, kq = tid >> 6;
  const int sc = perm ? win_srccol(n0 + nl) : (n0 + nl);
  float tv[16];
#pragma unroll
  for (int i = 0; i < 16; ++i) {
    const int k = k0 + kq + 4 * i;
    float v = 0.f;
    if (sc >= 0) { v = src[(size_t)k * ldsrc + sc]; if (gain) v *= gain[k]; }
    tv[i] = v;
  }
#pragma unroll
  for (int i = 0; i < 16; ++i) t[nl * 72 + kq + 4 * i] = f2bf(tv[i]);
  __syncthreads();
  const int r = tid >> 2, c = (tid & 3) * 16;
  u32x4 a = *(const u32x4*)(t + r * 72 + c), b = *(const u32x4*)(t + r * 72 + c + 8);
  bf16* o = dst + (size_t)gu_rowmap(n0 + r, rowmode) * K + k0 + c;
  *(u32x4*)o = a; *(u32x4*)(o + 8) = b;
  __syncthreads();
}

DI void frag_tile(const float* __restrict__ src, int ldsrc, bool isq, const float* __restrict__ gain, bf16* __restrict__ dst, int n0, int k0, int tid) {
  const int n = n0 + (tid & 63), kq = tid >> 6;
#pragma unroll
  for (int gi = 0; gi < 2; ++gi) {
    const int kg = k0 + (kq * 2 + gi) * 8;
    float v[8];
#pragma unroll
    for (int j = 0; j < 8; ++j) v[j] = src[(size_t)(kg + j) * ldsrc + n] * gain[kg + j];
    const int kk = kg >> 4, hh = (kg >> 3) & 1, r = n & 31;
    size_t off;
    if (isq) { const int hd = n / 96, nl = n % 96; off = ((size_t)(((hd * 16 + kk) * 3 + (nl >> 5)) * 64 + hh * 32 + r)) * 8; }
    else { const int hd = n >> 7, nl = n & 127; off = ((size_t)((((hd * 2 + (nl >> 6)) * 8 + kk) * 2 + ((nl >> 5) & 1)) * 64 + hh * 32 + r)) * 8; }
    u32x4 w; w.x = pk_bf16(v[0], v[1]); w.y = pk_bf16(v[2], v[3]); w.z = pk_bf16(v[4], v[5]); w.w = pk_bf16(v[6], v[7]);
    *(u32x4*)(dst + off) = w;
  }
  __syncthreads();
  __syncthreads();
}
DI void phase0(const Params& p, unsigned char* lds, int tid, int half) {
  bf16* W = (bf16*)(p.ws + OFF_W);
  constexpr int NT_L = 832 + 256 + 704 + 704 + 704 + 24 + 16;
  for (int pi = blockIdx.x; pi < NT_L; pi += gridDim.x) {
    const int it = 2 * pi + half;
    const int l = it / NT_L; int r = it % NT_L;
    bf16* Wl = W + (size_t)l * WL_E;
    if (r < 832) { transpose_tile(p.w_in + (size_t)l * 1024 * DIN, DIN, 1024, true, p.pre_mix_g + l * 1024, Wl + WO_IN, (r / 16) * 64, (r % 16) * 64, lds, tid); continue; } r -= 832;
    if (r < 256) { transpose_tile(p.w_out + (size_t)l * 1024 * 1024, 1024, 1024, false, nullptr, Wl + WO_OUT, (r / 16) * 64, (r % 16) * 64, lds, tid); continue; } r -= 256;
    if (r < 704) { transpose_tile(p.ffn_wg + (size_t)l * 1024 * FF, FF, 1024, false, p.pre_ffn_g + l * 1024, Wl + WO_GU, (r / 16) * 64, (r % 16) * 64, lds, tid, 1); continue; } r -= 704;
    if (r < 704) { transpose_tile(p.ffn_wu + (size_t)l * 1024 * FF, FF, 1024, false, p.pre_ffn_g + l * 1024, Wl + WO_GU, (r / 16) * 64, (r % 16) * 64, lds, tid, 2); continue; } r -= 704;
    if (r < 704) { transpose_tile(p.ffn_wd + (size_t)l * FF * 1024, 1024, FF, false, nullptr, Wl + WO_DN, (r / 44) * 64, (r % 44) * 64, lds, tid); continue; } r -= 704;
    if (r < 24) { frag_tile(p.mla_wuq + (size_t)l * 256 * 384, 384, true, p.mla_qg + l * 256, Wl + WO_UQ, (r / 4) * 64, (r % 4) * 64, tid); continue; } r -= 24;
    frag_tile(p.mla_wukv + (size_t)l * 128 * 512, 512, false, p.mla_kvg + l * 128, Wl + WO_UKV, (r / 2) * 64, (r % 2) * 64, tid);
  }
}

DI void resid_phase(const float* __restrict__ xin, const bf16* __restrict__ xinb, const bf16* __restrict__ y, const float* __restrict__ g, float* __restrict__ xout, bf16* __restrict__ xb, float* __restrict__ rs, int tid, int vb, int nvb) {
  const int lane = tid & 63, wv = tid >> 6;
  const int stride = nvb * 4;
  for (int row0 = vb * 4 + wv; row0 < T_; row0 += 2 * stride) {
    f32x4 v[2][4]; u32x2 yu[2][4];
#pragma unroll
    for (int q = 0; q < 2; ++q) {
      const int row = min(row0 + q * stride, T_ - 1);
      if (xin) {
#pragma unroll
        for (int j = 0; j < 4; ++j) v[q][j] = *(const f32x4*)(xin + (size_t)row * 1024 + lane * 4 + 256 * j);
      } else {
#pragma unroll
        for (int j = 0; j < 4; ++j) { const u32x2 u = *(const u32x2*)(xinb + (size_t)row * 1024 + lane * 4 + 256 * j); v[q][j] = (f32x4){bflo(u.x), bfhi(u.x), bflo(u.y), bfhi(u.y)}; }
      }
      if (y) {
#pragma unroll
        for (int j = 0; j < 4; ++j) yu[q][j] = *(const u32x2*)(y + (size_t)row * 1024 + lane * 4 + 256 * j);
      }
    }
#pragma unroll
    for (int q = 0; q < 2; ++q) {
      const int row = row0 + q * stride;
      if (y) {
        f32x4 yv[4]; float ss = 0.f;
#pragma unroll
        for (int j = 0; j < 4; ++j) {
          yv[j] = (f32x4){bflo(yu[q][j].x), bfhi(yu[q][j].x), bflo(yu[q][j].y), bfhi(yu[q][j].y)};
          ss += yv[j].x * yv[j].x + yv[j].y * yv[j].y + yv[j].z * yv[j].z + yv[j].w * yv[j].w;
        }
        const float ry = rsqrtf(wave_sum(ss) * (1.f / 1024.f) + EPS);
#pragma unroll
        for (int j = 0; j < 4; ++j) { f32x4 gg = *(const f32x4*)(g + lane * 4 + 256 * j); v[q][j] = v[q][j] + yv[j] * ry * gg; }
      }
      float sx = 0.f;
#pragma unroll
      for (int j = 0; j < 4; ++j) sx += v[q][j].x * v[q][j].x + v[q][j].y * v[q][j].y + v[q][j].z * v[q][j].z + v[q][j].w * v[q][j].w;
      sx = wave_sum(sx);
      if (row < T_) {
#pragma unroll
        for (int j = 0; j < 4; ++j) {
          if (xout) *(f32x4*)(xout + (size_t)row * 1024 + lane * 4 + 256 * j) = v[q][j];
          if (xb) {
            u32x2 o; o.x = pk_bf16(v[q][j].x, v[q][j].y); o.y = pk_bf16(v[q][j].z, v[q][j].w);
            *(u32x2*)(xb + (size_t)row * 1024 + lane * 4 + 256 * j) = o;
          }
        }
        if (xb && lane == 0) rs[row] = rsqrtf(sx * (1.f / 1024.f) + EPS);
      }
    }
  }
}

DI float gelu_tanh(float x) {
  const float u = 0.7978845608028654f * (x + 0.044715f * x * x * x);
  const float e = __expf(2.f * u);
  const float th = 1.f - 2.f / (e + 1.f);
  return 0.5f * x * (1.f + th);
}
struct EpiStore {
  bf16* out0; bf16* out1; int split; int ldc; const float* rs; const float* cw;
  DI void store4(int m, int n, f32x4 v) const {
    bf16* o = out0; if (n >= split) { o = out1; n -= split; }
    u32x2 w; w.x = pk_bf16(v.x, v.y); w.y = pk_bf16(v.z, v.w);
    *(u32x2*)(o + (size_t)m * ldc + n) = w;
  }
};

#define GL_LAS __attribute__((address_space(3)))
DI int g8_lds_byte(int r, int c) { const int st = (r >> 4) * 2 + (c >> 5), rr = r & 15, cc = c & 31, ob = rr * 64 + cc * 2; return st * 1024 + (ob ^ (((ob >> 9) & 1) << 5)); }
DI void g8_stage_rc(int b, int& R, int& C) { const int st = b / 1024, sb = b % 1024, swz = sb ^ (((sb >> 9) & 1) << 5); R = (st >> 1) * 16 + swz / 64; C = (st & 1) * 32 + (swz % 64) / 2; }
template <bool ACT>
DI void gemm_phase(const bf16* __restrict__ A, int lda, const bf16* __restrict__ Bt, int ldb, int K, int MT, int NT, const EpiStore& epi, unsigned char* lds, int tid) {
  constexpr int HTB = 128 * 64 * 2;
  const int nt_k = K / 64;
  const int xcd = blockIdx.x & 7, jb = blockIdx.x >> 3, nbx = (gridDim.x + 7 - xcd) >> 3;
  const int band = MT / 8, per_x = band * NT;
  for (int lt = jb; lt < per_x; lt += nbx) {
    const int mg = lt / (8 * NT), rem = lt % (8 * NT), gs = min(8, band - 8 * mg);
    const int mt = xcd * band + mg * 8 + rem % gs, nt = rem / gs, n0 = nt * 256;
    int m0 = mt * 256, seq0 = 0;
    if (ACT) { const int bs = mt / 34, ti = mt % 34; if (ti == 33) continue; seq0 = bs * S_; m0 = seq0 + 254 * ti - 2; }
    __syncthreads();
    asm volatile("" : "+v"(tid));
    const int wid = tid >> 6, lane = tid & 63, wr = wid >> 2, wc = wid & 3, fr = lane & 15, fq = lane >> 4;
    const int obs = (fr * 64 + fq * 16) ^ ((((fr * 64 + fq * 16) >> 9) & 1) << 5);
    const int a_rd = obs + wr * 8192, b_rd = obs + wc * 4096;
#define SA8(b, h) (lds + ((b) * 2 + (h)) * HTB)
#define SB8(b, h) (lds + (4 + (b) * 2 + (h)) * HTB)
    unsigned aofs[2][2], bofs[2];
#pragma unroll
    for (int i = 0; i < 2; ++i) {
      int sr_, sc_; g8_stage_rc(tid * 16 + i * 8192, sr_, sc_);
      bofs[i] = ((unsigned)(n0 + sr_) * (unsigned)ldb + (unsigned)sc_) * 2u;
#pragma unroll
      for (int hf = 0; hf < 2; ++hf) {
        int row = m0 + sr_ + (ACT ? hf * 128 : 0); if (ACT) row = min(max(row, seq0), seq0 + S_ - 1);
        aofs[hf][i] = ((unsigned)row * (unsigned)lda + (unsigned)sc_) * 2u;
      }
    }
#define STAGE_A(P, half_, kt) do { const unsigned char* ub_ = (const unsigned char*)A + (size_t)(kt) * 128 + (ACT ? (size_t)0 : (size_t)(half_) * 256 * (size_t)lda); _Pragma("unroll") for (int _i = 0; _i < 2; ++_i) \
      __builtin_amdgcn_global_load_lds((const unsigned*)(ub_ + aofs[half_][_i]), (GL_LAS unsigned*)((P) + tid * 16 + _i * 8192), 16, 0, 0); } while (0)
#define STAGE_B(P, half_, kt) do { const unsigned char* ub_ = (const unsigned char*)Bt + (size_t)(kt) * 128 + (size_t)(half_) * 256 * (size_t)ldb; _Pragma("unroll") for (int _i = 0; _i < 2; ++_i) \
      __builtin_amdgcn_global_load_lds((const unsigned*)(ub_ + bofs[_i]), (GL_LAS unsigned*)((P) + tid * 16 + _i * 8192), 16, 0, 0); } while (0)
#define LDA8(dst, b, h) _Pragma("unroll") for (int m = 0; m < 4; ++m) _Pragma("unroll") for (int k = 0; k < 2; ++k) \
      dst[m][k] = *(const bf16x8*)(SA8(b, h) + a_rd + m * 2048 + k * 1024)
#define LDB8(dst, b, h) _Pragma("unroll") for (int n = 0; n < 2; ++n) _Pragma("unroll") for (int k = 0; k < 2; ++k) \
      dst[n][k] = *(const bf16x8*)(SB8(b, h) + b_rd + n * 2048 + k * 1024)
#define MMA8(ai, bj, At_, Bt_) do { __builtin_amdgcn_s_setprio(1); \
      _Pragma("unroll") for (int m = 0; m < 4; ++m) _Pragma("unroll") for (int n = 0; n < 2; ++n) _Pragma("unroll") for (int k = 0; k < 2; ++k) \
        acc[ai][bj][m][n] = __builtin_amdgcn_mfma_f32_16x16x32_bf16(Bt_[n][k], At_[m][k], acc[ai][bj][m][n], 0, 0, 0); \
      __builtin_amdgcn_s_setprio(0); } while (0)
#define WAIT_V(n) asm volatile("s_waitcnt vmcnt(" #n ")" ::: "memory")
#define WAIT_L(n) asm volatile("s_waitcnt lgkmcnt(" #n ")" ::: "memory")
#define BAR8 __builtin_amdgcn_s_barrier()
#define SCHED8 __builtin_amdgcn_sched_barrier(0)
    f32x4 acc[2][2][4][2];
#pragma unroll
    for (int i0 = 0; i0 < 2; ++i0)
#pragma unroll
      for (int i1 = 0; i1 < 2; ++i1)
#pragma unroll
        for (int i2 = 0; i2 < 4; ++i2)
#pragma unroll
          for (int i3 = 0; i3 < 2; ++i3) acc[i0][i1][i2][i3] = (f32x4){0.f, 0.f, 0.f, 0.f};
    bf16x8 At[4][2], B0[2][2], B1[2][2];
    STAGE_B(SB8(0, 0), 0, 0); STAGE_A(SA8(0, 0), 0, 0);
    STAGE_B(SB8(0, 1), 1, 0); STAGE_A(SA8(0, 1), 1, 0);
    if (wr == 1) BAR8;
    WAIT_V(4); BAR8;
    STAGE_B(SB8(1, 0), 0, 1); STAGE_A(SA8(1, 0), 0, 1); STAGE_B(SB8(1, 1), 1, 1);
    WAIT_V(6); BAR8;
    for (int t = 0; t < nt_k - 2; t += 2) {
      LDB8(B0, 0, 0); SCHED8; LDA8(At, 0, 0); STAGE_A(SA8(1, 1), 1, t + 1);
      WAIT_L(8); BAR8; WAIT_L(0); MMA8(0, 0, At, B0); BAR8; SCHED8;
      LDB8(B1, 0, 1); STAGE_B(SB8(0, 0), 0, t + 2);
      BAR8; WAIT_L(0); MMA8(0, 1, At, B1); BAR8;
      LDA8(At, 0, 1); STAGE_A(SA8(0, 0), 0, t + 2);
      BAR8; WAIT_L(0); MMA8(1, 0, At, B0); BAR8; SCHED8;
      STAGE_B(SB8(0, 1), 1, t + 2);
      WAIT_V(6); BAR8; MMA8(1, 1, At, B1); BAR8;
      LDB8(B0, 1, 0); SCHED8; LDA8(At, 1, 0); STAGE_A(SA8(0, 1), 1, t + 2);
      WAIT_L(8); BAR8; WAIT_L(0); MMA8(0, 0, At, B0); BAR8; SCHED8;
      LDB8(B1, 1, 1); STAGE_B(SB8(1, 0), 0, t + 3);
      BAR8; WAIT_L(0); MMA8(0, 1, At, B1); BAR8;
      LDA8(At, 1, 1); STAGE_A(SA8(1, 0), 0, t + 3);
      BAR8; WAIT_L(0); MMA8(1, 0, At, B0); BAR8; SCHED8;
      STAGE_B(SB8(1, 1), 1, t + 3);
      WAIT_V(6); BAR8; MMA8(1, 1, At, B1); BAR8;
    }
    { LDB8(B0, 0, 0); LDA8(At, 0, 0); STAGE_A(SA8(1, 1), 1, nt_k - 1);
      BAR8; WAIT_L(0); MMA8(0, 0, At, B0); BAR8;
      LDB8(B1, 0, 1); BAR8; WAIT_L(0); MMA8(0, 1, At, B1); BAR8;
      LDA8(At, 0, 1); WAIT_V(4); BAR8; WAIT_L(0); MMA8(1, 0, At, B0); MMA8(1, 1, At, B1); BAR8; }
    { LDB8(B0, 1, 0); LDA8(At, 1, 0); WAIT_V(2); BAR8; WAIT_L(0); MMA8(0, 0, At, B0); BAR8;
      LDB8(B1, 1, 1); WAIT_V(0); BAR8; WAIT_L(0); MMA8(0, 1, At, B1); BAR8;
      LDA8(At, 1, 1); BAR8; WAIT_L(0); MMA8(1, 0, At, B0); MMA8(1, 1, At, B1); BAR8; }
    if (wr == 0) BAR8;
    __syncthreads();
    int tid_e = tid; asm volatile("" : "+v"(tid_e));
    const int e_wid = tid_e >> 6, e_lane = tid_e & 63, e_wr = e_wid >> 2, e_wc = e_wid & 3, e_fr = e_lane & 15, e_fq = e_lane >> 4;
    if (!ACT) {
#pragma unroll
      for (int ai = 0; ai < 2; ++ai)
#pragma unroll
        for (int m = 0; m < 4; ++m) {
          const int ml = ai * 128 + e_wr * 64 + m * 16 + e_fr;
          const float sc = epi.rs ? epi.rs[m0 + ml] : 1.f;
#pragma unroll
          for (int bj = 0; bj < 2; ++bj)
#pragma unroll
            for (int n = 0; n < 2; ++n) {
              const f32x4 v = acc[ai][bj][m][n] * sc;
              u32x2 w2; w2.x = pk_bf16(v[0], v[1]); w2.y = pk_bf16(v[2], v[3]);
              *(u32x2*)(lds + ml * 520 + (bj * 128 + e_wc * 32 + n * 16 + e_fq * 4) * 2) = w2;
            }
        }
      __syncthreads();
#pragma unroll 2
      for (int k = 0; k < 16; ++k) {
        const int id = tid_e + 512 * k, row = id >> 5, ch = id & 31;
        const u32x2 lo = *(const u32x2*)(lds + row * 520 + ch * 16), hi = *(const u32x2*)(lds + row * 520 + ch * 16 + 8);
        *(u32x4*)(epi.out0 + (size_t)(m0 + row) * epi.ldc + n0 + ch * 8) = (u32x4){lo.x, lo.y, hi.x, hi.y};
      }
    } else {
      float* G = (float*)lds;
#pragma unroll
      for (int ai = 0; ai < 2; ++ai)
#pragma unroll
        for (int m = 0; m < 4; ++m) {
          const int ml = ai * 128 + e_wr * 64 + m * 16 + e_fr;
          const float sc = epi.rs[min(max(m0 + ml, seq0), seq0 + S_ - 1)];
#pragma unroll
          for (int n = 0; n < 2; ++n) {
            acc[ai][0][m][n] = acc[ai][0][m][n] * sc; acc[ai][1][m][n] = acc[ai][1][m][n] * sc;
#pragma unroll
            for (int j = 0; j < 4; ++j) G[(e_wc * 32 + n * 16 + e_fq * 4 + j) * 256 + ml] = acc[ai][0][m][n][j];
          }
        }
      __syncthreads();
#pragma unroll
      for (int n = 0; n < 2; ++n) {
        const int chl = e_wc * 32 + n * 16 + e_fq * 4, c = nt * 128 + chl;
        const f32x4 w0 = *(const f32x4*)(epi.cw + c), w1 = *(const f32x4*)(epi.cw + FF + c), w2 = *(const f32x4*)(epi.cw + 2 * FF + c);
#pragma unroll
        for (int ai = 0; ai < 2; ++ai)
#pragma unroll
          for (int m = 0; m < 4; ++m) {
            const int ml = ai * 128 + e_wr * 64 + m * 16 + e_fr, t = m0 + ml, sq = t - seq0;
            const int m1 = max(ml - 1, 0), m2 = max(ml - 2, 0);
            float o[4];
#pragma unroll
            for (int j = 0; j < 4; ++j) {
              const float g0 = acc[ai][0][m][n][j];
              const float g1 = (sq >= 1) ? G[(chl + j) * 256 + m1] : 0.f;
              const float g2 = (sq >= 2) ? G[(chl + j) * 256 + m2] : 0.f;
              const float cv = w0[j] * g2 + w1[j] * g1 + w2[j] * g0;
              o[j] = gelu_tanh(cv) * acc[ai][1][m][n][j];
            }
            if (ml >= 2 && sq < S_) {
              u32x2 wv2; wv2.x = pk_bf16(o[0], o[1]); wv2.y = pk_bf16(o[2], o[3]);
              *(u32x2*)(epi.out0 + (size_t)t * FF + c) = wv2;
            }
          }
      }
    }
  }
  __syncthreads();
}

DI void ffn_act_phase(const bf16* __restrict__ gate, bf16* __restrict__ up, const float* __restrict__ cw, int tid) {
  constexpr int CG = FF / 8;
  const int total = (T_ / 16) * CG;
  for (int it = blockIdx.x * 256 + tid; it < total; it += gridDim.x * 256) {
    const int tb = it / CG, cgp = it % CG, t0 = tb * 16, c0 = cgp * 8;
    float w0[8], w1[8], w2[8], g1[8], g2[8];
#pragma unroll
    for (int i = 0; i < 8; ++i) { w0[i] = cw[c0 + i]; w1[i] = cw[FF + c0 + i]; w2[i] = cw[2 * FF + c0 + i]; g1[i] = 0.f; g2[i] = 0.f; }
    if ((t0 & (S_ - 1)) != 0) {
      u32x4 a = *(const u32x4*)(gate + (size_t)(t0 - 2) * FF + c0), b = *(const u32x4*)(gate + (size_t)(t0 - 1) * FF + c0);
#pragma unroll
      for (int i = 0; i < 4; ++i) { g2[2 * i] = bflo(a[i]); g2[2 * i + 1] = bfhi(a[i]); g1[2 * i] = bflo(b[i]); g1[2 * i + 1] = bfhi(b[i]); }
    }
#pragma unroll 4
    for (int t = t0; t < t0 + 16; ++t) {
      u32x4 a = *(const u32x4*)(gate + (size_t)t * FF + c0), u = *(const u32x4*)(up + (size_t)t * FF + c0);
      float g0[8], uu[8], o[8];
#pragma unroll
      for (int i = 0; i < 4; ++i) { g0[2 * i] = bflo(a[i]); g0[2 * i + 1] = bfhi(a[i]); uu[2 * i] = bflo(u[i]); uu[2 * i + 1] = bfhi(u[i]); }
#pragma unroll
      for (int i = 0; i < 8; ++i) { const float c = w0[i] * g2[i] + w1[i] * g1[i] + w2[i] * g0[i]; o[i] = gelu_tanh(c) * uu[i]; g2[i] = g1[i]; g1[i] = g0[i]; }
      u32x4 w; w.x = pk_bf16(o[0], o[1]); w.y = pk_bf16(o[2], o[3]); w.z = pk_bf16(o[4], o[5]); w.w = pk_bf16(o[6], o[7]);
      *(u32x4*)(up + (size_t)t * FF + c0) = w;
    }
  }
}

template <int DK, bool ISA>
DI float gla_lb(const Params& p, int l, int h, int d) {
  if (!ISA || l == 0) return 0.f;
  const float l0 = p.hgrn_lb[h * 64 + d], l1 = p.hgrn_lb[256 + h * 64 + d];
  return 1.f / (1.f + __expf(l0 - l1));
}
template <int DK, bool ISA>
DI void gla_bc(const Params& p, int l, const bf16* __restrict__ z, int t0, int h, float* bcl, int tid) {
  constexpr int NP = 256 / DK, TPP = 64 / NP;
  const int d = tid % DK, part = tid / DK;
  float run = 0.f;
  if (ISA) {
    const float lbv = gla_lb<DK, ISA>(p, l, h, d);
#pragma unroll
    for (int jj = 0; jj < TPP; ++jj) {
      const int j = part * TPP + jj;
      const float zf = bf2f(z[(size_t)(t0 + j) * ZLD + ZA_F + h * 64 + d]);
      const float f = lbv + (1.f - lbv) * sigmoidf_(zf);
      run += __logf(fmaxf(f, 1e-30f));
      bcl[j * DK + d] = run;
    }
  } else {
    float w[16];
#pragma unroll
    for (int rr = 0; rr < 16; ++rr) w[rr] = p.gla_w2[(size_t)l * 16 * 128 + rr * 128 + h * 32 + d];
    const float bias = p.gla_b[l * 128 + h * 32 + d];
#pragma unroll
    for (int jj = 0; jj < TPP; ++jj) {
      const int j = part * TPP + jj;
      const u32x4* cp = (const u32x4*)(z + (size_t)(t0 + j) * ZLD + ZB_CODE);
      u32x4 c0 = cp[0], c1 = cp[1];
      float u = bias;
#pragma unroll
      for (int i = 0; i < 4; ++i) { u += bflo(c0[i]) * w[2 * i] + bfhi(c0[i]) * w[2 * i + 1]; u += bflo(c1[i]) * w[8 + 2 * i] + bfhi(c1[i]) * w[8 + 2 * i + 1]; }
      run += -softplusf_(-u) * (1.f / 16.f);
      bcl[j * DK + d] = run;
    }
  }
  __syncthreads();
  float off = 0.f;
  for (int pp = 0; pp < part; ++pp) off += bcl[(pp * TPP + TPP - 1) * DK + d];
  __syncthreads();
#pragma unroll
  for (int jj = 0; jj < TPP; ++jj) bcl[(part * TPP + jj) * DK + d] += off;
  __syncthreads();
}
template <int DK, bool ISA>
DI float gla_kval(const bf16* __restrict__ z, int t, int h, int d, float lbv) {
  if (ISA) { const float zf = bf2f(z[(size_t)t * ZLD + ZA_F + h * 64 + d]); return (1.f - lbv) * sigmoidf_(-zf); }
  return bf2f(z[(size_t)t * ZLD + ZB_K + h * 32 + d]);
}
template <int DK, bool ISA>
DI float gla_qval(const bf16* __restrict__ z, int t, int h, int d) {
  if (ISA) { const float zq = bf2f(z[(size_t)t * ZLD + ZA_Q + h * 64 + d]); return siluf_(zq) * 0.125f; }
  return bf2f(z[(size_t)t * ZLD + ZB_Q + h * 32 + d]) * 0.17677669529663687f;
}

template <int DK, bool ISA>
DI void gla_local_item(const Params& p, int l, int ci, unsigned char* lds, int tid) {
  const bf16* z = (const bf16*)(p.ws + OFF_AR + AR_Z);
  bf16* UT = (bf16*)(p.ws + OFF_AR + (ISA ? AR_UTA : AR_UTB));
  float* G = (float*)(p.ws + (ISA ? OFF_GA : OFF_GB));
  const int h = ci & 3, t0 = (ci >> 2) * 64;
  float* bcl = (float*)lds;
  bf16* kT = (bf16*)(lds + 16384);
  bf16* vT = (bf16*)(lds + 16384 + 9216);
  bf16 vpre[16];
  {
    const int e = tid & 63, p4 = tid >> 6;
    const int vcol = (ISA ? ZA_I : ZB_V) + h * 64 + e;
#pragma unroll
    for (int jj = 0; jj < 16; ++jj) vpre[jj] = z[(size_t)(t0 + p4 * 16 + jj) * ZLD + vcol];
  }
  constexpr int NPk = 256 / DK, TPPk = 64 / NPk;
  bf16 kpre[TPPk];
  {
    const int d = tid % DK, part = tid / DK;
#pragma unroll
    for (int jj = 0; jj < TPPk; ++jj) kpre[jj] = z[(size_t)(t0 + part * TPPk + jj) * ZLD + (ISA ? ZA_F + h * 64 : ZB_K + h * 32) + d];
  }
  gla_bc<DK, ISA>(p, l, z, t0, h, bcl, tid);
  {
    float* bcg = (float*)((unsigned char*)p.out + BC_OFF + (ISA ? 0 : BC_B_OFF)) + (size_t)ci * 64 * DK;
#pragma unroll
    for (int k = 0; k < (64 * DK) / 1024; ++k) *(f32x4*)(bcg + (tid + 256 * k) * 4) = *(const f32x4*)(bcl + (tid + 256 * k) * 4);
  }
  constexpr int NP = 256 / DK, TPP = 64 / NP;
  {
    const int d = tid % DK, part = tid / DK;
    const float lbv = gla_lb<DK, ISA>(p, l, h, d);
    const float bl = bcl[63 * DK + d];
#pragma unroll
    for (int jj = 0; jj < TPP; ++jj) {
      const int j = part * TPP + jj;
      const float kv = ISA ? (1.f - lbv) * sigmoidf_(-bf2f(kpre[jj])) : bf2f(kpre[jj]);
      kT[d * 72 + j] = f2bf(kv * __expf(bl - bcl[j * DK + d]));
    }
    if (part == 0) G[(size_t)ci * DK + d] = __expf(bl);
    const int e = tid & 63, p4 = tid >> 6;
#pragma unroll
    for (int jj = 0; jj < 16; ++jj) { const int j = p4 * 16 + jj; vT[e * 72 + j] = vpre[jj]; }
  }
  __syncthreads();
  const int lane = tid & 63, wv = tid >> 6, wm = wv & 1, wn = wv >> 1, r = lane & 31, hh = lane >> 5;
  if (wm * 32 < DK) {
    f32x16 acc = mm32((const unsigned char*)(kT + wm * 32 * 72), 144, (const unsigned char*)(vT + wn * 32 * 72), 144, 4, zero16(), r, hh);
    const int e = wn * 32 + r;
#pragma unroll
    for (int g = 0; g < 4; ++g) {
      const int d = wm * 32 + 8 * g + 4 * hh;
      u32x2 w; w.x = pk_bf16(acc[4 * g], acc[4 * g + 1]); w.y = pk_bf16(acc[4 * g + 2], acc[4 * g + 3]);
      *(u32x2*)(UT + ((size_t)ci * 64 + e) * DK + d) = w;
    }
  }
  __syncthreads();
}

template <int DK>
DI void gla_scan_item(bf16* __restrict__ UT, const float* __restrict__ G, int b, int h, int slice, int tid) {
  constexpr int GPR = DK / 4, RPS = 256 / GPR;
  const int e = slice * RPS + tid / GPR, d4 = (tid % GPR) * 4;
  f32x4 st = (f32x4){0.f, 0.f, 0.f, 0.f};
  for (int c0 = 0; c0 < 128; c0 += 8) {
    u32x2 u[8]; f32x4 gg[8];
#pragma unroll
    for (int i = 0; i < 8; ++i) {
      const size_t ci = ((size_t)(b * 128 + c0 + i) * 4 + h);
      u[i] = *(const u32x2*)(UT + (ci * 64 + e) * DK + d4);
      gg[i] = *(const f32x4*)(G + ci * DK + d4);
    }
#pragma unroll
    for (int i = 0; i < 8; ++i) {
      const size_t ci = ((size_t)(b * 128 + c0 + i) * 4 + h);
      u32x2 w; w.x = pk_bf16(st.x, st.y); w.y = pk_bf16(st.z, st.w);
      *(u32x2*)(UT + (ci * 64 + e) * DK + d4) = w;
      st = gg[i] * st + (f32x4){bflo(u[i].x), bfhi(u[i].x), bflo(u[i].y), bfhi(u[i].y)};
    }
  }
}

template <bool SIG>
DI void norm_gate_store(const float* obuf, bool has_add, u32x4 a0, u32x4 a1, const float* __restrict__ ng, u32x4 g0, u32x4 g1, bf16* __restrict__ mixo, int tid) {
  const int i = tid >> 2, e0 = (tid & 3) * 16;
  float o[16]; float ss = 0.f;
#pragma unroll
  for (int k = 0; k < 16; ++k) o[k] = obuf[i * 68 + e0 + k];
  if (has_add) {
#pragma unroll
    for (int k = 0; k < 4; ++k) { o[2 * k] += bflo(a0[k]); o[2 * k + 1] += bfhi(a0[k]); o[8 + 2 * k] += bflo(a1[k]); o[8 + 2 * k + 1] += bfhi(a1[k]); }
  }
#pragma unroll
  for (int k = 0; k < 16; ++k) ss += o[k] * o[k];
  ss += __shfl_xor(ss, 1); ss += __shfl_xor(ss, 2);
  const float rsv = rsqrtf(ss * (1.f / 64.f) + EPS);
  float gt[16];
#pragma unroll
  for (int k = 0; k < 4; ++k) { gt[2 * k] = bflo(g0[k]); gt[2 * k + 1] = bfhi(g0[k]); gt[8 + 2 * k] = bflo(g1[k]); gt[8 + 2 * k + 1] = bfhi(g1[k]); }
  unsigned w[8];
#pragma unroll
  for (int k = 0; k < 8; ++k) {
    float a = o[2 * k] * rsv * ng[e0 + 2 * k], b = o[2 * k + 1] * rsv * ng[e0 + 2 * k + 1];
    a *= SIG ? sigmoidf_(gt[2 * k]) : siluf_(gt[2 * k]);
    b *= SIG ? sigmoidf_(gt[2 * k + 1]) : siluf_(gt[2 * k + 1]);
    w[k] = pk_bf16(a, b);
  }
  u32x4* op = (u32x4*)(mixo + (size_t)i * 1024 + e0);
  op[0] = (u32x4){w[0], w[1], w[2], w[3]}; op[1] = (u32x4){w[4], w[5], w[6], w[7]};
}

template <int DK, bool ISA>
DI void gla_out_item(const Params& p, int l, int ci, unsigned char* lds, int tid) {
  const bf16* z = (const bf16*)(p.ws + OFF_AR + AR_Z);
  const bf16* ST = (const bf16*)(p.ws + OFF_AR + (ISA ? AR_UTA : AR_UTB));
  bf16* mix = (bf16*)(p.ws + OFF_AR + AR_MIX);
  const int h = ci & 3, t0 = (ci >> 2) * 64;
  constexpr int LDK = (DK + 8) * 2;
  float* bcl = (float*)lds;
  float* obuf = (float*)lds;
  unsigned char* qh = lds + 17408;
  unsigned char* kt = qh + 9216;
  unsigned char* qc = kt + 9216;
  unsigned char* vT = qc + 9216;
  unsigned char* stl = vT + 9216;
  unsigned char* attn = stl + 9216;
  const u32x4* gpre = (const u32x4*)(z + (size_t)(t0 + (tid >> 2)) * ZLD + (ISA ? ZA_G : ZB_G) + h * 64 + (tid & 3) * 16);
  const u32x4 gq0 = gpre[0], gq1 = gpre[1];
  bf16 vpre[16];
  {
    const int e = tid & 63, p4 = tid >> 6;
    const int vcol = (ISA ? ZA_I : ZB_V) + h * 64 + e;
#pragma unroll
    for (int jj = 0; jj < 16; ++jj) vpre[jj] = z[(size_t)(t0 + p4 * 16 + jj) * ZLD + vcol];
  }
  constexpr int NPq = 256 / DK, TPPq = 64 / NPq;
  bf16 qpre[TPPq], kpre[TPPq];
  {
    const int d = tid % DK, part = tid / DK;
#pragma unroll
    for (int jj = 0; jj < TPPq; ++jj) {
      const size_t t = (size_t)(t0 + part * TPPq + jj);
      qpre[jj] = z[t * ZLD + (ISA ? ZA_Q + h * 64 : ZB_Q + h * 32) + d];
      kpre[jj] = ISA ? z[t * ZLD + ZA_F + h * 64 + d] : z[t * ZLD + ZB_K + h * 32 + d];
    }
  }
  constexpr int CPR0 = DK / 8, NST = (64 * CPR0) / 256;
  u32x4 stpre[NST];
#pragma unroll
  for (int k = 0; k < NST; ++k) { const int id = tid + 256 * k; stpre[k] = *(const u32x4*)(ST + ((size_t)ci * 64 + id / CPR0) * DK + (id % CPR0) * 8); }
  {
    const float* bcg = (const float*)((const unsigned char*)p.out + BC_OFF + (ISA ? 0 : BC_B_OFF)) + (size_t)ci * 64 * DK;
#pragma unroll
    for (int k = 0; k < (64 * DK) / 1024; ++k) *(f32x4*)(bcl + (tid + 256 * k) * 4) = *(const f32x4*)(bcg + (tid + 256 * k) * 4);
    __syncthreads();
  }
  constexpr int NP = 256 / DK, TPP = 64 / NP;
  {
    const int d = tid % DK, part = tid / DK;
    const float lbv = gla_lb<DK, ISA>(p, l, h, d);
    const float bref = bcl[31 * DK + d];
#pragma unroll
    for (int jj = 0; jj < TPP; ++jj) {
      const int j = part * TPP + jj;
      const float kv = ISA ? (1.f - lbv) * sigmoidf_(-bf2f(kpre[jj])) : bf2f(kpre[jj]);
      const float qv = ISA ? siluf_(bf2f(qpre[jj])) * 0.125f : bf2f(qpre[jj]) * 0.17677669529663687f;
      const float bc = bcl[j * DK + d];
      const float dq = fminf(fmaxf(bc - bref, -80.f), 80.f);
      ((bf16*)qh)[j * (DK + 8) + d] = f2bf(qv * __expf(dq));
      ((bf16*)kt)[j * (DK + 8) + d] = f2bf(kv * __expf(-dq));
      ((bf16*)qc)[j * (DK + 8) + d] = f2bf(qv * __expf(bc));
    }
    const int e = tid & 63, p4 = tid >> 6;
#pragma unroll
    for (int jj = 0; jj < 16; ++jj) { const int j = p4 * 16 + jj; ((bf16*)vT)[e * 72 + j] = vpre[jj]; }
#pragma unroll
    for (int k = 0; k < NST; ++k) { const int id = tid + 256 * k; *(u32x4*)(stl + (id / CPR0) * LDK + (id % CPR0) * 16) = stpre[k]; }
  }
  __syncthreads();
  const int lane = tid & 63, wv = tid >> 6, wm = wv & 1, wn = wv >> 1, r = lane & 31, hh = lane >> 5;
  {
    f32x16 acc = mm32(qh + wm * 32 * LDK, LDK, kt + wn * 32 * LDK, LDK, DK / 16, zero16(), r, hh);
    const int jc = wn * 32 + r;
#pragma unroll
    for (int g = 0; g < 4; ++g)
#pragma unroll
      for (int k = 0; k < 4; ++k) {
        const int i = wm * 32 + 8 * g + 4 * hh + k;
        const float v = (jc <= i) ? acc[4 * g + k] : 0.f;
        ((bf16*)attn)[i * 72 + jc] = f2bf(v);
      }
  }
  __syncthreads();
  {
    f32x16 acc = mm32(attn + wm * 32 * 144, 144, vT + wn * 32 * 144, 144, 4, zero16(), r, hh);
    acc = mm32(qc + wm * 32 * LDK, LDK, stl + wn * 32 * LDK, LDK, DK / 16, acc, r, hh);
    const int e = wn * 32 + r;
#pragma unroll
    for (int g = 0; g < 4; ++g)
#pragma unroll
      for (int k = 0; k < 4; ++k) obuf[(wm * 32 + 8 * g + 4 * hh + k) * 68 + e] = acc[4 * g + k];
  }
  __syncthreads();
  norm_gate_store<ISA>(obuf, false, gq0, gq0, (ISA ? p.hgrn_ng : p.gla_ng) + l * 64, gq0, gq1, mix + (size_t)t0 * 1024 + (ISA ? 0 : 256) + h * 64, tid);
  __syncthreads();
}

DI void gdn_local_item(const Params& p, int l, int ci, unsigned char* lds, int tid) {
  const bf16* z = (const bf16*)(p.ws + OFF_AR + AR_Z);
  float* Ac = (float*)(p.ws + OFF_AR + AR_ACD) + (size_t)ci * 4096;
  bf16* BT = (bf16*)(p.ws + OFF_AR + AR_BTD) + (size_t)ci * 4096;
  bf16* Qeff = (bf16*)(p.ws + OFF_AR + AR_QEFF) + (size_t)ci * 4096;
  bf16* Oloc = (bf16*)(p.ws + OFF_AR + AR_OLOC) + (size_t)ci * 4096;
  const int h = ci & 3, t0 = (ci >> 2) * 64, s0 = t0 & (S_ - 1);
  float* Mf = (float*)lds;
  bf16* WT = (bf16*)lds;
  bf16* UT = (bf16*)(lds + 9216);
  float* X = (float*)(lds + 16384);
  bf16* qn = (bf16*)(lds + 16384);
  bf16* kn = qn + 64 * 72;
  bf16* vb = kn + 64 * 72;
  bf16* kbm = (bf16*)(lds + 49152);
  bf16* aqk = kbm;
  bf16* KtT = kbm + 64 * 72;
  float* sm = (float*)(lds + 49152 + 2 * 9216);
  float* betas = sm; float* bcum = sm + 64;
  const int lane = tid & 63, wv = tid >> 6;
  const bf16 zbeta_raw = z[(size_t)(t0 + lane) * ZLD + ZD_BETA + h], za_raw = z[(size_t)(t0 + lane) * ZLD + ZD_A + h];
  {
    const int d = lane, j0 = wv * 16;
    const float* cw = p.gdn_conv + (size_t)l * 4 * 768;
    float qv[16], kv[16];
#pragma unroll
    for (int which = 0; which < 3; ++which) {
      const int cc = which * 256 + h * 64 + d;
      const int zc = (which == 0 ? ZD_Q : (which == 1 ? ZD_K : ZD_V)) + h * 64 + d;
      const float c0 = cw[cc], c1 = cw[768 + cc], c2 = cw[2 * 768 + cc], c3 = cw[3 * 768 + cc];
      float x0 = 0.f, x1 = 0.f, x2 = 0.f;
      if (s0 + j0 >= 3) { x0 = bf2f(z[(size_t)(t0 + j0 - 3) * ZLD + zc]); x1 = bf2f(z[(size_t)(t0 + j0 - 2) * ZLD + zc]); x2 = bf2f(z[(size_t)(t0 + j0 - 1) * ZLD + zc]); }
#pragma unroll
      for (int jj = 0; jj < 16; ++jj) {
        const float x3 = bf2f(z[(size_t)(t0 + j0 + jj) * ZLD + zc]);
        const float o = siluf_(c0 * x0 + c1 * x1 + c2 * x2 + c3 * x3);
        x0 = x1; x1 = x2; x2 = x3;
        if (which == 0) qv[jj] = o; else if (which == 1) kv[jj] = o; else vb[(j0 + jj) * 72 + d] = f2bf(o);
      }
    }
    if (wv == 0) {
      const float be = sigmoidf_(bf2f(zbeta_raw));
      float lg = -__expf(p.gdn_alog[l * 4 + h]) * softplusf_(bf2f(za_raw) + p.gdn_dtb[l * 4 + h]);
#pragma unroll
      for (int o = 1; o < 64; o <<= 1) { const float n = __shfl_up(lg, o); if (lane >= o) lg += n; }
      betas[lane] = be; bcum[lane] = lg;
    }
    __syncthreads();
    const float bl = bcum[63];
#pragma unroll
    for (int jj = 0; jj < 16; ++jj) {
      const int j = j0 + jj;
      const float rq = rsqrtf(wave_sum(qv[jj] * qv[jj]) + EPS) * 0.125f;
      const float rk = rsqrtf(wave_sum(kv[jj] * kv[jj]) + EPS);
      const float qq = qv[jj] * rq, kk = kv[jj] * rk;
      qn[j * 72 + d] = f2bf(qq); kn[j * 72 + d] = f2bf(kk); kbm[j * 72 + d] = f2bf(kk * betas[j]);
      Qeff[j * 64 + d] = f2bf(qq * __expf(bcum[j]));
      KtT[d * 72 + j] = f2bf(kk * __expf(bl - bcum[j]));
    }
  }
  __syncthreads();
  const int wm = wv & 1, wn = wv >> 1, r = lane & 31, hh = lane >> 5;
  {
    f32x16 acc = mm32((const unsigned char*)(kbm + wm * 32 * 72), 144, (const unsigned char*)(kn + wn * 32 * 72), 144, 4, zero16(), r, hh);
    f32x16 acc2 = mm32((const unsigned char*)(qn + wm * 32 * 72), 144, (const unsigned char*)(kn + wn * 32 * 72), 144, 4, zero16(), r, hh);
    const int jc = wn * 32 + r; const float bj = bcum[jc];
    __syncthreads();
#pragma unroll
    for (int g = 0; g < 4; ++g)
#pragma unroll
      for (int k = 0; k < 4; ++k) {
        const int i = wm * 32 + 8 * g + 4 * hh + k;
        const float dec = (jc <= i) ? __expf(bcum[i] - bj) : 0.f;
        Mf[i * 64 + jc] = (jc < i) ? acc[4 * g + k] * dec : 0.f;
        aqk[i * 72 + jc] = f2bf(acc2[4 * g + k] * dec);
      }
  }
  __syncthreads();
  {
    const int c = tid & 127, j0 = (tid >> 7) * 32;
    const bf16* srcp = (c < 64) ? vb : kn;
    float xr[32];
#pragma unroll
    for (int j = 0; j < 32; ++j) { const float f = (c < 64) ? betas[j0 + j] : betas[j0 + j] * __expf(bcum[j0 + j]); xr[j] = bf2f(srcp[(j0 + j) * 72 + (c & 63)]) * f; }
    __syncthreads();
#pragma unroll
    for (int j = 0; j < 32; ++j) X[(j0 + j) * 128 + c] = xr[j];
  }
  __syncthreads();
  {
    const int g4 = lane >> 4, c16 = lane & 15;
#pragma unroll
    for (int I = 0; I < 4; ++I) {
      if (I > 0) {
        f32x4 acc0 = (f32x4){0.f, 0.f, 0.f, 0.f}, acc1 = acc0;
#pragma unroll
        for (int J = 0; J < I; ++J) {
#pragma unroll
          for (int kk = 0; kk < 4; ++kk) {
            const float av = Mf[(16 * I + c16) * 64 + 16 * J + 4 * kk + g4];
            const float b0 = X[(16 * J + 4 * kk + g4) * 128 + (2 * wv) * 16 + c16];
            const float b1 = X[(16 * J + 4 * kk + g4) * 128 + (2 * wv + 1) * 16 + c16];
            acc0 = __builtin_amdgcn_mfma_f32_16x16x4f32(av, b0, acc0, 0, 0, 0);
            acc1 = __builtin_amdgcn_mfma_f32_16x16x4f32(av, b1, acc1, 0, 0, 0);
          }
        }
#pragma unroll
        for (int r4 = 0; r4 < 4; ++r4) {
          X[(16 * I + 4 * g4 + r4) * 128 + (2 * wv) * 16 + c16] -= acc0[r4];
          X[(16 * I + 4 * g4 + r4) * 128 + (2 * wv + 1) * 16 + c16] -= acc1[r4];
        }
        __syncthreads();
      }
      if (tid < 128) {
        float x[16];
#pragma unroll
        for (int r4 = 0; r4 < 16; ++r4) x[r4] = X[(16 * I + r4) * 128 + tid];
#pragma unroll
        for (int r4 = 1; r4 < 16; ++r4) {
          const float* mr = Mf + (16 * I + r4) * 64 + 16 * I;
          float a0 = x[r4];
#pragma unroll
          for (int qb = 0; qb < (r4 + 3) / 4; ++qb) {
            const f32x4 m4 = *(const f32x4*)(mr + 4 * qb);
#pragma unroll
            for (int qq = 0; qq < 4; ++qq) if (4 * qb + qq < r4) a0 -= m4[qq] * x[4 * qb + qq];
          }
          x[r4] = a0;
        }
#pragma unroll
        for (int r4 = 0; r4 < 16; ++r4) X[(16 * I + r4) * 128 + tid] = x[r4];
      }
      __syncthreads();
    }
  }
  {
    float xr[64];
    const int c = tid & 127;
    if (tid < 128) {
#pragma unroll
      for (int j = 0; j < 64; ++j) xr[j] = X[j * 128 + c];
    }
    __syncthreads();
    if (tid < 128) {
      bf16* dst = (tid < 64 ? UT : WT) + (tid & 63) * 72;
#pragma unroll
      for (int j = 0; j < 64; j += 8) {
        u32x4 w; w.x = pk_bf16(xr[j], xr[j + 1]); w.y = pk_bf16(xr[j + 2], xr[j + 3]); w.z = pk_bf16(xr[j + 4], xr[j + 5]); w.w = pk_bf16(xr[j + 6], xr[j + 7]);
        *(u32x4*)(dst + j) = w;
      }
    }
  }
  __syncthreads();
  {
    const float bl = bcum[63];
    u32x2 qpre[4];
#pragma unroll
    for (int g = 0; g < 4; ++g) qpre[g] = *(const u32x2*)(Qeff + (wn * 32 + r) * 64 + wm * 32 + 8 * g + 4 * hh);
    f32x16 a1 = mm32((const unsigned char*)(WT + wm * 32 * 72), 144, (const unsigned char*)(aqk + wn * 32 * 72), 144, 4, zero16(), r, hh);
    f32x16 a2 = mm32((const unsigned char*)(UT + wm * 32 * 72), 144, (const unsigned char*)(aqk + wn * 32 * 72), 144, 4, zero16(), r, hh);
    f32x16 a3 = mm32((const unsigned char*)(WT + wm * 32 * 72), 144, (const unsigned char*)(KtT + wn * 32 * 72), 144, 4, zero16(), r, hh);
    f32x16 a4 = mm32((const unsigned char*)(KtT + wm * 32 * 72), 144, (const unsigned char*)(UT + wn * 32 * 72), 144, 4, zero16(), r, hh);
    const int cidx = wn * 32 + r;
    const float ebl = __expf(bl);
#pragma unroll
    for (int g = 0; g < 4; ++g) {
      const int rb = wm * 32 + 8 * g + 4 * hh;
      const u32x2 qraw = qpre[g];
      u32x2 w;
      w.x = pk_bf16(bflo(qraw.x) - a1[4 * g], bfhi(qraw.x) - a1[4 * g + 1]);
      w.y = pk_bf16(bflo(qraw.y) - a1[4 * g + 2], bfhi(qraw.y) - a1[4 * g + 3]);
      *(u32x2*)(Qeff + cidx * 64 + rb) = w;
      w.x = pk_bf16(a2[4 * g], a2[4 * g + 1]); w.y = pk_bf16(a2[4 * g + 2], a2[4 * g + 3]);
      *(u32x2*)(Oloc + cidx * 64 + rb) = w;
      f32x4 av;
#pragma unroll
      for (int k = 0; k < 4; ++k) av[k] = ((rb + k) == cidx ? ebl : 0.f) - a3[4 * g + k];
      *(f32x4*)(Ac + cidx * 64 + rb) = av;
      w.x = pk_bf16(a4[4 * g], a4[4 * g + 1]); w.y = pk_bf16(a4[4 * g + 2], a4[4 * g + 3]);
      *(u32x2*)(BT + cidx * 64 + rb) = w;
    }
  }
  __syncthreads();
}

DI void gdn_scan_item(const Params& p, int b, int h, int es, unsigned char* lds, int tid) {
  const float* AcB = (const float*)(p.ws + OFF_AR + AR_ACD);
  bf16* BTB = (bf16*)(p.ws + OFF_AR + AR_BTD);
  const int lane = tid & 63, w = tid >> 6, g = lane >> 4, c16 = lane & 15;
  float* stl = (float*)lds;
  for (int i = tid; i < 2 * 16 * 68; i += 256) stl[i] = 0.f;
  __syncthreads();
  f32x4 cur = (f32x4){0.f, 0.f, 0.f, 0.f};
  f32x4 bq[4][4]; bf16 bt[4][4];
  const size_t ci0 = ((size_t)(b * 128) * 4 + h);
  const float* apb = AcB + ci0 * 4096 + (16 * w + c16) * 64 + 16 * g;
  bf16* btb = BTB + ci0 * 4096 + (es * 16 + 4 * g) * 64 + 16 * w + c16;
#pragma unroll
  for (int s4 = 0; s4 < 4; ++s4) {
#pragma unroll
    for (int k = 0; k < 4; ++k) bq[s4][k] = *(const f32x4*)(apb + (size_t)s4 * 4 * 4096 + 4 * k);
#pragma unroll
    for (int k = 0; k < 4; ++k) bt[s4][k] = btb[(size_t)s4 * 4 * 4096 + k * 64];
  }
  for (int c0 = 0; c0 < 128; c0 += 4) {
    const bool pf = (c0 + 4 < 128);
#pragma unroll
    for (int s4 = 0; s4 < 4; ++s4) {
      const int c = c0 + s4;
      const size_t co = (size_t)c * 4 * 4096;
#pragma unroll
      for (int k = 0; k < 4; ++k) btb[co + k * 64] = f2bf(cur[k]);
      const float* sc = stl + (s4 & 1) * 16 * 68;
      f32x4 aq[4];
#pragma unroll
      for (int k = 0; k < 4; ++k) aq[k] = *(const f32x4*)(sc + c16 * 68 + 16 * g + 4 * k);
      f32x4 acc[4];
      acc[0] = (f32x4){bf2f(bt[s4][0]), bf2f(bt[s4][1]), bf2f(bt[s4][2]), bf2f(bt[s4][3])};
      acc[1] = (f32x4){0.f, 0.f, 0.f, 0.f}; acc[2] = acc[1]; acc[3] = acc[1];
#pragma unroll
      for (int q = 0; q < 4; ++q)
#pragma unroll
        for (int k = 0; k < 4; ++k) acc[k] = __builtin_amdgcn_mfma_f32_16x16x4f32(aq[k][q], bq[s4][k][q], acc[k], 0, 0, 0);
      cur = (acc[0] + acc[1]) + (acc[2] + acc[3]);
      if (pf) {
#pragma unroll
        for (int k = 0; k < 4; ++k) bq[s4][k] = *(const f32x4*)(apb + co + (size_t)4 * 4 * 4096 + 4 * k);
#pragma unroll
        for (int k = 0; k < 4; ++k) bt[s4][k] = btb[co + (size_t)4 * 4 * 4096 + k * 64];
      }
      float* sn = stl + ((s4 + 1) & 1) * 16 * 68;
#pragma unroll
      for (int k = 0; k < 4; ++k) sn[(4 * g + k) * 68 + 16 * w + c16] = cur[k];
      __syncthreads();
    }
  }
}

DI void gdn_out_item(const Params& p, int l, int ci, unsigned char* lds, int tid) {
  const bf16* z = (const bf16*)(p.ws + OFF_AR + AR_Z);
  const bf16* ST = (const bf16*)(p.ws + OFF_AR + AR_BTD) + (size_t)ci * 4096;
  const bf16* Qeff = (const bf16*)(p.ws + OFF_AR + AR_QEFF) + (size_t)ci * 4096;
  const bf16* Oloc = (const bf16*)(p.ws + OFF_AR + AR_OLOC) + (size_t)ci * 4096;
  bf16* mix = (bf16*)(p.ws + OFF_AR + AR_MIX);
  const int h = ci & 3, t0 = (ci >> 2) * 64;
  float* obuf = (float*)lds;
  unsigned char* ql = lds + 17408;
  unsigned char* sl = ql + 9216;
  const u32x4* gpre = (const u32x4*)(z + (size_t)(t0 + (tid >> 2)) * ZLD + ZD_Z + h * 64 + (tid & 3) * 16);
  const u32x4 gq0 = gpre[0], gq1 = gpre[1];
  const u32x4* apre = (const u32x4*)(Oloc + (tid >> 2) * 64 + (tid & 3) * 16);
  const u32x4 aq0 = apre[0], aq1 = apre[1];
#pragma unroll
  for (int id = tid; id < 512; id += 256) {
    const int rr = id >> 3, ch = id & 7;
    *(u32x4*)(ql + rr * 144 + ch * 16) = *(const u32x4*)(Qeff + rr * 64 + ch * 8);
    *(u32x4*)(sl + rr * 144 + ch * 16) = *(const u32x4*)(ST + rr * 64 + ch * 8);
  }
  __syncthreads();
  const int lane = tid & 63, wv = tid >> 6, wm = wv & 1, wn = wv >> 1, r = lane & 31, hh = lane >> 5;
  {
    f32x16 acc = mm32(ql + wm * 32 * 144, 144, sl + wn * 32 * 144, 144, 4, zero16(), r, hh);
    const int e = wn * 32 + r;
#pragma unroll
    for (int g = 0; g < 4; ++g)
#pragma unroll
      for (int k = 0; k < 4; ++k) obuf[(wm * 32 + 8 * g + 4 * hh + k) * 68 + e] = acc[4 * g + k];
  }
  __syncthreads();
  norm_gate_store<false>(obuf, true, aq0, aq1, p.gdn_ng + l * 64, gq0, gq1, mix + (size_t)t0 * 1024 + 768 + h * 64, tid);
  __syncthreads();
}

DI void mla_proj_item(const Params& p, int l, int tile, unsigned char* lds, int tid) {
  const bf16* z = (const bf16*)(p.ws + OFF_AR + AR_Z);
  const bf16* Wl = (const bf16*)(p.ws + OFF_W) + (size_t)l * WL_E;
  const bf16* Wuq = Wl + WO_UQ;
  const bf16* Wukv = Wl + WO_UKV;
  bf16* Qg = (bf16*)(p.ws + OFF_AR + AR_Q);
  bf16* Kg = (bf16*)(p.ws + OFF_AR + AR_K);
  bf16* Vt = (bf16*)(p.ws + OFF_AR + AR_VT);
  const int t0 = tile * 64, b = t0 / S_, s0 = t0 % S_;
  unsigned char* Aq = lds;
  unsigned char* Akv = lds + 33792;
  float* rsq = (float*)(lds + 33792 + 17408);
  float* rskv = rsq + 64;
#pragma unroll
  for (int id = tid; id < 64 * 32; id += 256) { const int rr = id >> 5, ch = id & 31; *(u32x4*)(Aq + rr * 528 + ch * 16) = *(const u32x4*)(z + (size_t)(t0 + rr) * ZLD + ZC_Q + ch * 8); }
#pragma unroll
  for (int id = tid; id < 64 * 16; id += 256) { const int rr = id >> 4, ch = id & 15; *(u32x4*)(Akv + rr * 272 + ch * 16) = *(const u32x4*)(z + (size_t)(t0 + rr) * ZLD + ZC_KV + ch * 8); }
  bf16 kr1[4], kr2[4];
#pragma unroll
  for (int k = 0; k < 4; ++k) { const int id = tid + 256 * k, m = id >> 4, i2 = id & 15; kr1[k] = z[(size_t)(t0 + m) * ZLD + ZC_KR + i2]; kr2[k] = z[(size_t)(t0 + m) * ZLD + ZC_KR + 16 + i2]; }
  __syncthreads();
  {
    const int rr = tid >> 2, qd = tid & 3;
    float s1 = 0.f, s2 = 0.f;
#pragma unroll
    for (int k = 0; k < 8; ++k) { const u32x4 u = *(const u32x4*)(Aq + rr * 528 + qd * 128 + k * 16);
#pragma unroll
      for (int i = 0; i < 4; ++i) { const float a = bflo(u[i]), b = bfhi(u[i]); s1 += a * a + b * b; } }
#pragma unroll
    for (int k = 0; k < 4; ++k) { const u32x4 u = *(const u32x4*)(Akv + rr * 272 + qd * 64 + k * 16);
#pragma unroll
      for (int i = 0; i < 4; ++i) { const float a = bflo(u[i]), b = bfhi(u[i]); s2 += a * a + b * b; } }
    s1 += __shfl_xor(s1, 1); s1 += __shfl_xor(s1, 2); s2 += __shfl_xor(s2, 1); s2 += __shfl_xor(s2, 2);
    if (qd == 0) { rsq[rr] = rsqrtf(s1 * (1.f / 256.f) + EPS); rskv[rr] = rsqrtf(s2 * (1.f / 128.f) + EPS); }
#pragma unroll
    for (int id = tid; id < 1024; id += 256) {
      const int m = id >> 4, i = id & 15;
      const float inv = __builtin_amdgcn_exp2f(-(float)i * (13.287712379549449f / 16.f));
      const float ang = (float)(s0 + m) * inv;
      const double rev = (double)ang * 0.15915494309189535;
      const float fr = (float)(rev - floor(rev));
      const float sn = __builtin_amdgcn_sinf(fr), cs = __builtin_amdgcn_cosf(fr);
      const float x1 = bf2f(kr1[id >> 8]), x2 = bf2f(kr2[id >> 8]);
      const bf16 o1 = f2bf(x1 * cs - x2 * sn), o2 = f2bf(x2 * cs + x1 * sn);
      { bf16* krl = (bf16*)(lds + 51712); krl[m * 32 + i] = o1; krl[m * 32 + 16 + i] = o2; }
    }
  }
  __syncthreads();
  const int lane = tid & 63, hd = tid >> 6, r = lane & 31, hh = lane >> 5;
  const float QS = 0.10206207261596575f * 1.4426950408889634f;
  {
    f32x16 acc[3][2];
#pragma unroll
    for (int i = 0; i < 3; ++i) { acc[i][0] = zero16(); acc[i][1] = zero16(); }
#pragma unroll 8
    for (int kk = 0; kk < 16; ++kk) {
      bf16x8 af[2], bw[3];
#pragma unroll
      for (int mi = 0; mi < 2; ++mi) af[mi] = *(const bf16x8*)(Aq + (mi * 32 + r) * 528 + kk * 32 + hh * 16);
#pragma unroll
      for (int ni = 0; ni < 3; ++ni) bw[ni] = *(const bf16x8*)(Wuq + ((size_t)(((hd * 16 + kk) * 3 + ni) * 64 + lane)) * 8);
#pragma unroll
      for (int ni = 0; ni < 3; ++ni)
#pragma unroll
        for (int mi = 0; mi < 2; ++mi) acc[ni][mi] = MFMA32(bw[ni], af[mi], acc[ni][mi]);
    }
    __syncthreads();
    unsigned char* wbuf = lds + hd * 6400;
#pragma unroll
    for (int mi = 0; mi < 2; ++mi) {
      const int m = mi * 32 + r;
      const float sc = rsq[m] * QS;
      bf16* qp = (bf16*)(wbuf + r * 200);
#pragma unroll
      for (int ni = 0; ni < 2; ++ni)
#pragma unroll
        for (int g = 0; g < 4; ++g) {
          u32x2 w; w.x = pk_bf16(acc[ni][mi][4 * g] * sc, acc[ni][mi][4 * g + 1] * sc); w.y = pk_bf16(acc[ni][mi][4 * g + 2] * sc, acc[ni][mi][4 * g + 3] * sc);
          *(u32x2*)(qp + ni * 32 + 8 * g + 4 * hh) = w;
        }
#pragma unroll
      for (int g = 0; g < 2; ++g) {
        float o1[4], o2[4];
#pragma unroll
        for (int k = 0; k < 4; ++k) {
          const int i = 8 * g + 4 * hh + k;
          const float inv = __builtin_amdgcn_exp2f(-(float)i * (13.287712379549449f / 16.f));
          const float ang = (float)(s0 + m) * inv;
          const double rev = (double)ang * 0.15915494309189535;
          const float fr = (float)(rev - floor(rev));
          const float sn = __builtin_amdgcn_sinf(fr), cs = __builtin_amdgcn_cosf(fr);
          const float x1 = acc[2][mi][4 * g + k] * sc, x2 = acc[2][mi][4 * (g + 2) + k] * sc;
          o1[k] = x1 * cs - x2 * sn; o2[k] = x2 * cs + x1 * sn;
        }
        u32x2 w; w.x = pk_bf16(o1[0], o1[1]); w.y = pk_bf16(o1[2], o1[3]);
        *(u32x2*)(qp + 64 + 8 * g + 4 * hh) = w;
        w.x = pk_bf16(o2[0], o2[1]); w.y = pk_bf16(o2[2], o2[3]);
        *(u32x2*)(qp + 80 + 8 * g + 4 * hh) = w;
      }
#pragma unroll
      for (int k = 0; k < 6; ++k) {
        const int id = lane + 64 * k, row = id / 12, ch = id % 12;
        const u32x2 lo = *(const u32x2*)(wbuf + row * 200 + ch * 16), hi = *(const u32x2*)(wbuf + row * 200 + ch * 16 + 8);
        *(u32x4*)(Qg + ((size_t)(b * 4 + hd) * S_ + s0 + mi * 32 + row) * 96 + ch * 8) = (u32x4){lo.x, lo.y, hi.x, hi.y};
      }
    }
  }
  {
    f32x16 acc[2][2];
#pragma unroll
    for (int i = 0; i < 2; ++i) { acc[i][0] = zero16(); acc[i][1] = zero16(); }
#pragma unroll
    for (int kk = 0; kk < 8; ++kk) {
      bf16x8 af[2], bw[2];
#pragma unroll
      for (int mi = 0; mi < 2; ++mi) af[mi] = *(const bf16x8*)(Akv + (mi * 32 + r) * 272 + kk * 32 + hh * 16);
#pragma unroll
      for (int ni = 0; ni < 2; ++ni) bw[ni] = *(const bf16x8*)(Wukv + ((size_t)((((hd * 2 + 0) * 8 + kk) * 2 + ni) * 64 + lane)) * 8);
#pragma unroll
      for (int ni = 0; ni < 2; ++ni)
#pragma unroll
        for (int mi = 0; mi < 2; ++mi) acc[ni][mi] = MFMA32(bw[ni], af[mi], acc[ni][mi]);
    }
    unsigned char* wbuf = lds + hd * 6400;
    const unsigned char* krl = lds + 51712;
#pragma unroll
    for (int mi = 0; mi < 2; ++mi) {
      const int m = mi * 32 + r;
      const float sc = rskv[m];
      bf16* kp = (bf16*)(wbuf + r * 200);
#pragma unroll
      for (int ni = 0; ni < 2; ++ni)
#pragma unroll
        for (int g = 0; g < 4; ++g) {
          u32x2 w; w.x = pk_bf16(acc[ni][mi][4 * g] * sc, acc[ni][mi][4 * g + 1] * sc); w.y = pk_bf16(acc[ni][mi][4 * g + 2] * sc, acc[ni][mi][4 * g + 3] * sc);
          *(u32x2*)(kp + ni * 32 + 8 * g + 4 * hh) = w;
        }
#pragma unroll
      for (int k = 0; k < 6; ++k) {
        const int id = lane + 64 * k, row = id / 12, ch = id % 12;
        const unsigned char* src = (ch < 8) ? (wbuf + row * 200 + ch * 16) : (krl + (mi * 32 + row) * 64 + (ch - 8) * 16);
        const u32x2 lo = *(const u32x2*)src, hi = *(const u32x2*)(src + 8);
        *(u32x4*)(Kg + ((size_t)(b * 4 + hd) * S_ + s0 + mi * 32 + row) * 96 + ch * 8) = (u32x4){lo.x, lo.y, hi.x, hi.y};
      }
    }
  }
  {
    f32x16 acc[2][2];
#pragma unroll
    for (int i = 0; i < 2; ++i) { acc[i][0] = zero16(); acc[i][1] = zero16(); }
#pragma unroll
    for (int kk = 0; kk < 8; ++kk) {
      bf16x8 af[2], bw[2];
#pragma unroll
      for (int mi = 0; mi < 2; ++mi) af[mi] = *(const bf16x8*)(Akv + (mi * 32 + r) * 272 + kk * 32 + hh * 16);
#pragma unroll
      for (int ni = 0; ni < 2; ++ni) bw[ni] = *(const bf16x8*)(Wukv + ((size_t)((((hd * 2 + 1) * 8 + kk) * 2 + ni) * 64 + lane)) * 8);
#pragma unroll
      for (int mi = 0; mi < 2; ++mi)
#pragma unroll
        for (int ni = 0; ni < 2; ++ni) acc[mi][ni] = MFMA32(af[mi], bw[ni], acc[mi][ni]);
    }
#pragma unroll
    for (int ni = 0; ni < 2; ++ni) {
      unsigned char* wbuf = lds + hd * 6400;
      bf16* vp = (bf16*)(wbuf + r * 136);
#pragma unroll
      for (int mi = 0; mi < 2; ++mi)
#pragma unroll
        for (int g = 0; g < 4; ++g) {
          const int m = mi * 32 + 8 * g + 4 * hh;
          u32x2 w; w.x = pk_bf16(acc[mi][ni][4 * g] * rskv[m], acc[mi][ni][4 * g + 1] * rskv[m + 1]); w.y = pk_bf16(acc[mi][ni][4 * g + 2] * rskv[m + 2], acc[mi][ni][4 * g + 3] * rskv[m + 3]);
          *(u32x2*)(vp + m) = w;
        }
#pragma unroll
      for (int k = 0; k < 4; ++k) {
        const int id = lane + 64 * k, row = id >> 3, ch = id & 7;
        const u32x2 lo = *(const u32x2*)(wbuf + row * 136 + ch * 16), hi = *(const u32x2*)(wbuf + row * 136 + ch * 16 + 8);
        *(u32x4*)(Vt + ((size_t)(b * 4 + hd) * 64 + ni * 32 + row) * S_ + s0 + ch * 8) = (u32x4){lo.x, lo.y, hi.x, hi.y};
      }
    }
  }
  __syncthreads();
}

DI void attn_item(const Params& p, int bh, int qb, unsigned char* lds, int tid) {
  const bf16* Qg = (const bf16*)(p.ws + OFF_AR + AR_Q) + (size_t)bh * S_ * 96;
  const bf16* Kg = (const bf16*)(p.ws + OFF_AR + AR_K) + (size_t)bh * S_ * 96;
  const bf16* Vt = (const bf16*)(p.ws + OFF_AR + AR_VT) + (size_t)bh * 64 * S_;
  bf16* mix = (bf16*)(p.ws + OFF_AR + AR_MIX);
  const int lane = tid & 63, w = tid >> 6, r = lane & 31, hh = lane >> 5;
  const int q0 = qb * 128, qrow = q0 + 32 * w + r;
  const int ntiles = 2 * qb + 2;
  constexpr int STG = 64 * 208 + 64 * 144;
  bf16x8 qf[6];
#pragma unroll
  for (int kk = 0; kk < 6; ++kk) qf[kk] = *(const bf16x8*)(Qg + (size_t)qrow * 96 + kk * 16 + hh * 8);
  f32x16 ot[2] = {zero16(), zero16()};
  float mrun = -1e30f, lrun = 0.f;
  u32x4 rk[3], rv[2];
  int krow[3], kch[3];
#pragma unroll
  for (int i = 0; i < 3; ++i) { const int id = tid + 256 * i; krow[i] = id / 12; kch[i] = id % 12; }
  const int vrow0 = tid >> 3, vch = tid & 7;
#pragma unroll
  for (int i = 0; i < 3; ++i) rk[i] = *(const u32x4*)(Kg + (size_t)krow[i] * 96 + kch[i] * 8);
#pragma unroll
  for (int i = 0; i < 2; ++i) rv[i] = *(const u32x4*)(Vt + (size_t)(vrow0 + 32 * i) * S_ + vch * 8);
  __syncthreads();
#pragma unroll
  for (int i = 0; i < 3; ++i) *(u32x4*)(lds + krow[i] * 208 + kch[i] * 16) = rk[i];
#pragma unroll
  for (int i = 0; i < 2; ++i) *(u32x4*)(lds + 13312 + (vrow0 + 32 * i) * 144 + vch * 16) = rv[i];
  __syncthreads();
  for (int kt = 0; kt < ntiles; ++kt) {
    const unsigned char* Ks = lds + (kt & 1) * STG;
    const unsigned char* Vs = Ks + 13312;
    if (kt + 1 < ntiles) {
#pragma unroll
      for (int i = 0; i < 3; ++i) rk[i] = *(const u32x4*)(Kg + (size_t)((kt + 1) * 64 + krow[i]) * 96 + kch[i] * 8);
#pragma unroll
      for (int i = 0; i < 2; ++i) rv[i] = *(const u32x4*)(Vt + (size_t)(vrow0 + 32 * i) * S_ + (kt + 1) * 64 + vch * 8);
    }
    if (kt * 64 <= q0 + 32 * w + 31) {
      f32x16 st[2];
#pragma unroll
      for (int k2 = 0; k2 < 2; ++k2) {
        st[k2] = zero16();
#pragma unroll
        for (int kk = 0; kk < 6; ++kk) {
          bf16x8 kf = *(const bf16x8*)(Ks + (k2 * 32 + r) * 208 + kk * 32 + hh * 16);
          st[k2] = MFMA32(kf, qf[kk], st[k2]);
        }
      }
      if (kt * 64 + 63 > q0 + 32 * w) {
#pragma unroll
        for (int k2 = 0; k2 < 2; ++k2)
#pragma unroll
          for (int g = 0; g < 4; ++g)
#pragma unroll
            for (int k = 0; k < 4; ++k) {
              const int key = kt * 64 + k2 * 32 + 8 * g + 4 * hh + k;
              if (key > qrow) st[k2][4 * g + k] = -1e30f;
            }
      }
      float mt = st[0][0];
#pragma unroll
      for (int k2 = 0; k2 < 2; ++k2)
#pragma unroll
        for (int i = 0; i < 16; ++i) mt = fmaxf(mt, st[k2][i]);
      mt = fmaxf(mt, __shfl_xor(mt, 32));
      const float mnew = fmaxf(mrun, mt);
      const float alpha = __builtin_amdgcn_exp2f(mrun - mnew);
      mrun = mnew;
      float ls = 0.f;
#pragma unroll
      for (int k2 = 0; k2 < 2; ++k2)
#pragma unroll
        for (int i = 0; i < 16; ++i) { const float pv = __builtin_amdgcn_exp2f(st[k2][i] - mnew); st[k2][i] = pv; ls += pv; }
      lrun = lrun * alpha + ls;
      if (__any(alpha != 1.f)) {
#pragma unroll
        for (int dt = 0; dt < 2; ++dt)
#pragma unroll
          for (int i = 0; i < 16; ++i) ot[dt][i] *= alpha;
      }
#pragma unroll
      for (int k2 = 0; k2 < 2; ++k2)
#pragma unroll
        for (int s = 0; s < 2; ++s) {
          u32x4 pw;
          pw.x = pk_bf16(st[k2][8 * s], st[k2][8 * s + 1]); pw.y = pk_bf16(st[k2][8 * s + 2], st[k2][8 * s + 3]);
          pw.z = pk_bf16(st[k2][8 * s + 4], st[k2][8 * s + 5]); pw.w = pk_bf16(st[k2][8 * s + 6], st[k2][8 * s + 7]);
          const bf16x8 pf = __builtin_bit_cast(bf16x8, pw);
#pragma unroll
          for (int dt = 0; dt < 2; ++dt) {
            const unsigned char* vp = Vs + (dt * 32 + r) * 144 + (k2 * 32 + s * 16 + 4 * hh) * 2;
            u32x2 v0 = *(const u32x2*)vp, v1 = *(const u32x2*)(vp + 16);
            u32x4 vw = (u32x4){v0.x, v0.y, v1.x, v1.y};
            ot[dt] = MFMA32(__builtin_bit_cast(bf16x8, vw), pf, ot[dt]);
          }
        }
    }
    if (kt + 1 < ntiles) {
      unsigned char* Kw = lds + ((kt + 1) & 1) * STG;
#pragma unroll
      for (int i = 0; i < 3; ++i) *(u32x4*)(Kw + krow[i] * 208 + kch[i] * 16) = rk[i];
#pragma unroll
      for (int i = 0; i < 2; ++i) *(u32x4*)(Kw + 13312 + (vrow0 + 32 * i) * 144 + vch * 16) = rv[i];
    }
    __syncthreads();
  }
  const float lt = lrun + __shfl_xor(lrun, 32);
  const float inv = 1.f / lt;
  const int b = bh >> 2, hd = bh & 3;
  bf16* op = mix + ((size_t)b * S_ + qrow) * 1024 + 512 + hd * 64;
#pragma unroll
  for (int dt = 0; dt < 2; ++dt)
#pragma unroll
    for (int g = 0; g < 4; ++g) {
      u32x2 wv; wv.x = pk_bf16(ot[dt][4 * g] * inv, ot[dt][4 * g + 1] * inv); wv.y = pk_bf16(ot[dt][4 * g + 2] * inv, ot[dt][4 * g + 3] * inv);
      *(u32x2*)(op + dt * 32 + 8 * g + 4 * hh) = wv;
    }
}

DI void grid_bar(unsigned* flags, unsigned k) {
  asm volatile("s_waitcnt vmcnt(0) lgkmcnt(0)" ::: "memory");
  __syncthreads();
  if (threadIdx.x == 0) { __threadfence(); __hip_atomic_store(flags + blockIdx.x, k, __ATOMIC_RELAXED, __HIP_MEMORY_SCOPE_AGENT); }
  const unsigned nb = gridDim.x;
  for (;;) {
    int ok = 1;
    for (unsigned i = threadIdx.x; i < nb; i += blockDim.x) ok &= (__hip_atomic_load(flags + i, __ATOMIC_RELAXED, __HIP_MEMORY_SCOPE_AGENT) >= k) ? 1 : 0;
    if (__syncthreads_and(ok)) break;
    __builtin_amdgcn_s_sleep(1);
  }
  if (threadIdx.x == 0) __threadfence();
  __syncthreads();
}
__global__ void __launch_bounds__(512, 2) fwd_megakernel(Params p0) {
  extern __shared__ __attribute__((aligned(16))) unsigned char lds_all[];
  __shared__ int s_item;
  cg::grid_group grid = cg::this_grid();
  unsigned nbar = 0;
  const int nvb = gridDim.x * 2;
#define GBAR() do { nbar += 1; grid_bar((unsigned*)(p0.ws + OFF_CTL) + 256, nbar); } while (0)
#define PH_BEGIN() Params q = p0; { unsigned long long w_ = (unsigned long long)q.ws; asm volatile("" : "+s"(w_)); q.ws = (unsigned char*)w_; } int tid5 = threadIdx.x; asm volatile("" : "+v"(tid5)); const int tid = tid5 & 255, half = tid5 >> 8, vb = blockIdx.x * 2 + half; unsigned char* lds = lds_all + half * LDS_HALF; (void)vb; (void)lds; \
  unsigned char* ws = q.ws; bf16* W = (bf16*)(ws + OFF_W); float* rs = (float*)(ws + OFF_RS); bf16* zb = (bf16*)(ws + OFF_AR + AR_Z); bf16* yb = (bf16*)(ws + OFF_AR + AR_Y); \
  bf16* up = (bf16*)(ws + OFF_AR + AR_UP); bf16* mix = (bf16*)(ws + OFF_AR + AR_MIX); bf16* xb = mix; unsigned* ctl = (unsigned*)(ws + OFF_CTL); \
  const bf16* Wl = W + (size_t)l * WL_E; (void)rs; (void)zb; (void)yb; (void)up; (void)mix; (void)xb; (void)ctl; (void)Wl; (void)tid; (void)tid5;
  { const int l = 0; PH_BEGIN(); phase0(q, lds, tid, half); }
  { const int l = 0; PH_BEGIN(); resid_phase(q.x, nullptr, nullptr, nullptr, nullptr, xb, rs, tid, vb, nvb); }
  if (p0.ws == nullptr) grid.sync();
  GBAR();

  for (int l = 0; l < 2; ++l) {
    { PH_BEGIN(); EpiStore e{zb, zb, 1 << 30, ZLD, rs, nullptr}; gemm_phase<false>(l == 0 ? xb : (const bf16*)q.out, 1024, Wl + WO_IN, 1024, 1024, 128, 13, e, lds_all, tid5); }
    GBAR();
    for (int pi = blockIdx.x; pi < (2048 * 3 + 512) / 2; pi += gridDim.x) {
      PH_BEGIN();
      const int it = 2 * pi + half;
      if (it < 2048) gdn_local_item(q, l, it, lds, tid);
      else if (it < 4096) gla_local_item<64, true>(q, l, it - 2048, lds, tid);
      else if (it < 6144) gla_local_item<32, false>(q, l, it - 4096, lds, tid);
      else mla_proj_item(q, l, it - 6144, lds, tid);
    }
    GBAR();
    for (;;) {
      PH_BEGIN();
      if (tid5 == 0) s_item = (int)atomicAdd(&ctl[l], 1u);
      __syncthreads();
      const int pit = s_item;
      __syncthreads();
      if (pit >= 80 + 512) break;
      if (pit < 32) { const int it = 2 * pit + half; gdn_scan_item(q, it >> 4, (it >> 2) & 3, it & 3, lds, tid); }
      else if (pit < 64) { const int j = 2 * (pit - 32) + half; gla_scan_item<64>((bf16*)(ws + OFF_AR + AR_UTA), (const float*)(ws + OFF_GA), j >> 4, (j >> 2) & 3, j & 3, tid); }
      else if (pit < 80) { const int j = 2 * (pit - 64) + half; gla_scan_item<32>((bf16*)(ws + OFF_AR + AR_UTB), (const float*)(ws + OFF_GB), j >> 3, (j >> 1) & 3, j & 1, tid); }
      else { const int a = pit - 80; attn_item(q, 2 * (a & 7) + half, 63 - (a >> 3), lds, tid); }
    }
    GBAR();
    for (int pi = blockIdx.x; pi < 2048 * 3 / 2; pi += gridDim.x) {
      PH_BEGIN();
      const int it = 2 * pi + half;
      if (it < 2048) gdn_out_item(q, l, it, lds, tid);
      else if (it < 4096) gla_out_item<64, true>(q, l, it - 2048, lds, tid);
      else gla_out_item<32, false>(q, l, it - 4096, lds, tid);
    }
    GBAR();
    { PH_BEGIN(); EpiStore e{yb, yb, 1 << 30, 1024, nullptr, nullptr}; gemm_phase<false>(mix, 1024, Wl + WO_OUT, 1024, 1024, 128, 4, e, lds_all, tid5); }
    GBAR();
    { PH_BEGIN(); resid_phase(l == 0 ? q.x : nullptr, (const bf16*)q.out, yb, q.post_mix_g + l * 1024, nullptr, xb, rs, tid, vb, nvb); }
    GBAR();
    { PH_BEGIN(); EpiStore e{up, up, 1 << 30, FF, rs, q.ffn_conv + (size_t)l * 3 * FF}; gemm_phase<true>(xb, 1024, Wl + WO_GU, 1024, 1024, 136, 22, e, lds_all, tid5); }
    GBAR();
    { PH_BEGIN(); EpiStore e{yb, yb, 1 << 30, 1024, nullptr, nullptr}; gemm_phase<false>(up, FF, Wl + WO_DN, FF, FF, 128, 4, e, lds_all, tid5); }
    GBAR();
    { PH_BEGIN(); resid_phase(nullptr, xb, yb, q.post_ffn_g + l * 1024, l == 1 ? q.out : nullptr, l == 1 ? nullptr : (bf16*)q.out, rs, tid, vb, nvb); }
    GBAR();
  }
}

extern "C" void kernel_launch(void* const* d_in, const int* in_sizes, int n_in, void* d_out, int out_size, void* d_ws, size_t ws_size, hipStream_t stream) {
  static int grid_blocks = 0;
  if (!grid_blocks) {
    int dev = 0, cus = 0, per_cu = 0;
    hipGetDevice(&dev);
    hipDeviceGetAttribute(&cus, hipDeviceAttributeMultiprocessorCount, dev);
    hipFuncSetAttribute((const void*)fwd_megakernel, hipFuncAttributeMaxDynamicSharedMemorySize, LDS_BYTES);
    hipOccupancyMaxActiveBlocksPerMultiprocessor(&per_cu, (const void*)fwd_megakernel, 512, LDS_BYTES);
    if (per_cu < 1) per_cu = 1;
    if (per_cu > 1) per_cu = 1;
    grid_blocks = cus * per_cu;
    if (ws_size < WS_END) fprintf(stderr, "kernel_launch: workspace too small: %zu < %zu\n", ws_size, (size_t)WS_END);
  }
  Params p{};
  const float** pp = (const float**)&p;
  for (int i = 0; i < 24; ++i) pp[i] = (const float*)d_in[i];
  p.out = (float*)d_out; p.ws = (unsigned char*)d_ws;
  hipMemsetAsync((unsigned char*)d_ws + OFF_CTL, 0, 8192, stream);
  void* args[] = {&p};
  hipError_t e = hipLaunchCooperativeKernel((const void*)fwd_megakernel, dim3(grid_blocks), dim3(512), args, LDS_BYTES, stream);
  if (e != hipSuccess) fprintf(stderr, "cooperative launch failed: %s (grid %d)\n", hipGetErrorString(e), grid_blocks);
}
```

```cpp
#include <hip/hip_runtime.h>
#include <hip/hip_cooperative_groups.h>
#include <cstdio>
#include <cstdint>
namespace cg = cooperative_groups;

#define DI __device__ __forceinline__
typedef unsigned short bf16;
typedef __attribute__((ext_vector_type(8))) short bf16x8;
typedef __attribute__((ext_vector_type(4))) short bf16x4;
typedef __attribute__((ext_vector_type(16))) float f32x16;
typedef __attribute__((ext_vector_type(4))) float f32x4;
typedef __attribute__((ext_vector_type(4))) unsigned u32x4;
typedef __attribute__((ext_vector_type(2))) unsigned u32x2;

constexpr int T_ = 32768, S_ = 8192, D_ = 1024, ZLD = 3328, FF = 2816, DIN = 3256;
constexpr float EPS = 1e-6f;
constexpr int ZA_Q = 0, ZA_F = 256, ZA_I = 512, ZA_G = 768, ZB_Q = 1024, ZB_K = 1152, ZB_V = 1280, ZB_G = 1536, ZC_Q = 1792, ZC_KV = 2048,
              ZD_Q = 2176, ZD_K = 2432, ZD_V = 2688, ZD_Z = 2944, ZC_KR = 3200, ZB_CODE = 3232, ZD_BETA = 3248, ZD_A = 3252;
constexpr size_t WIN_E = (size_t)ZLD * 1024, WOUT_E = 1024 * 1024, WGU_E = (size_t)2 * FF * 1024, WDN_E = (size_t)1024 * FF, WUQ_E = 384 * 256, WUKV_E = 512 * 128;
constexpr size_t WO_IN = 0, WO_OUT = WO_IN + WIN_E, WO_GU = WO_OUT + WOUT_E, WO_DN = WO_GU + WGU_E, WO_UQ = WO_DN + WDN_E, WO_UKV = WO_UQ + WUQ_E, WL_E = WO_UKV + WUKV_E;
constexpr size_t OFF_W = 0;
constexpr size_t OFF_CTL = OFF_W + 2 * WL_E * 2;
constexpr size_t OFF_RS = OFF_CTL + 8192;
constexpr size_t OFF_GA = OFF_RS + (size_t)T_ * 4;
constexpr size_t OFF_GB = OFF_GA + (size_t)2048 * 64 * 4;
constexpr size_t OFF_AR = OFF_GB + (size_t)2048 * 32 * 4;
constexpr size_t AR_Z = 0, AR_Y = 0, AR_GATE = 0, AR_UP = (size_t)T_ * FF * 2;
constexpr size_t AR_SCAN = (size_t)T_ * ZLD * 2;
constexpr size_t AR_UTA = AR_SCAN, AR_UTB = AR_UTA + (size_t)2048 * 64 * 64 * 2, AR_ACD = AR_UTB + (size_t)2048 * 64 * 32 * 2, AR_BTD = AR_ACD + (size_t)2048 * 4096 * 4,
                 AR_QEFF = AR_BTD + (size_t)2048 * 4096 * 2, AR_OLOC = AR_QEFF + (size_t)2048 * 4096 * 2, AR_MLA = AR_OLOC + (size_t)2048 * 4096 * 2;
constexpr size_t AR_Q = AR_MLA, AR_K = AR_Q + (size_t)T_ * 4 * 96 * 2, AR_VT = AR_K + (size_t)T_ * 4 * 96 * 2, AR_MIX = AR_VT + (size_t)T_ * 4 * 64 * 2;
constexpr size_t AR_END = AR_MIX + (size_t)T_ * 1024 * 2;
constexpr size_t WS_END = OFF_AR + AR_END;
static_assert(WS_END <= (size_t)512 * 1024 * 1024, "workspace too large");
static_assert(AR_UP + (size_t)T_ * FF * 2 <= AR_MIX, "gate/up overlaps xb");

constexpr size_t BC_OFF = (size_t)T_ * 1024 * 2, BC_B_OFF = (size_t)2048 * 64 * 64 * 4;
static_assert(BC_OFF + BC_B_OFF + (size_t)2048 * 64 * 32 * 4 <= (size_t)T_ * 1024 * 4, "decay tables exceed the output buffer");
constexpr int LDS_HALF = 73728, LDS_BYTES = 2 * LDS_HALF;
#ifndef PROBE_DUP
#define PROBE_DUP 0
#endif

struct Params {
  const float* x; const float* w_in; const float* w_out; const float* pre_mix_g; const float* post_mix_g; const float* pre_ffn_g; const float* post_ffn_g;
  const float* hgrn_lb; const float* hgrn_ng; const float* gla_w2; const float* gla_b; const float* gla_ng;
  const float* mla_qg; const float* mla_wuq; const float* mla_kvg; const float* mla_wukv;
  const float* gdn_conv; const float* gdn_alog; const float* gdn_dtb; const float* gdn_ng;
  const float* ffn_wg; const float* ffn_wu; const float* ffn_conv; const float* ffn_wd;
  float* out; unsigned char* ws;
};

typedef __bf16 bf16v2_t __attribute__((ext_vector_type(2)));
typedef float f32v2_t __attribute__((ext_vector_type(2)));
DI unsigned pk_bf16(float lo, float hi) { f32v2_t v = {lo, hi}; bf16v2_t b = __builtin_convertvector(v, bf16v2_t); return __builtin_bit_cast(unsigned, b); }
DI float bf2f(bf16 v) { return __uint_as_float(((unsigned)v) << 16); }
DI bf16 f2bf(float x) { return (bf16)(pk_bf16(x, 0.f) & 0xffffu); }
DI float bflo(unsigned u) { return __uint_as_float(u << 16); }
DI float bfhi(unsigned u) { return __uint_as_float(u & 0xffff0000u); }
DI float sigmoidf_(float x) { return 1.f / (1.f + __expf(-x)); }
DI float siluf_(float x) { return x * sigmoidf_(x); }
DI float softplusf_(float x) { return fmaxf(x, 0.f) + __logf(1.f + __expf(-fabsf(x))); }
DI float wave_sum(float v) {
#pragma unroll
  for (int o = 1; o < 64; o <<= 1) v += __shfl_xor(v, o);
  return v;
}
#define MFMA32(a, b, c) __builtin_amdgcn_mfma_f32_32x32x16_bf16((a), (b), (c), 0, 0, 0)

DI f32x16 mm32(const unsigned char* A, int lda, const unsigned char* B, int ldb, int ks, f32x16 acc, int r, int h) {
  const unsigned char* pa = A + r * lda + h * 16;
  const unsigned char* pb = B + r * ldb + h * 16;
  for (int kk = 0; kk < ks; ++kk) {
    bf16x8 a = *(const bf16x8*)(pa + kk * 32);
    bf16x8 b = *(const bf16x8*)(pb + kk * 32);
    acc = MFMA32(a, b, acc);
  }
  return acc;
}
DI f32x16 zero16() { f32x16 z; for (int i = 0; i < 16; ++i) z[i] = 0.f; return z; }

DI int win_srccol(int n) {
  if (n < 1536) return n;
  if (n < 1792) return 1552 + (n - 1536);
  if (n < 2048) return 1808 + (n - 1792);
  if (n < 2176) return 2064 + (n - 2048);
  if (n < 2432) return 2224 + (n - 2176);
  if (n < 2688) return 2480 + (n - 2432);
  if (n < 2944) return 2736 + (n - 2688);
  if (n < 3200) return 3000 + (n - 2944);
  if (n < 3232) return 2192 + (n - 3200);
  if (n < 3248) return 1536 + (n - 3232);
  if (n < 3252) return 2992 + (n - 3248);
  if (n < 3256) return 2996 + (n - 3252);
  return -1;
}
DI int gu_rowmap(int c, int mode) { return mode == 0 ? c : ((c >> 7) * 256 + (c & 127) + (mode == 2 ? 128 : 0)); }
DI void transpose_tile(const float* __restrict__ src, int ldsrc, int K, bool perm, const float* __restrict__ gain, bf16* __restrict__ dst, int n0, int k0, unsigned char* lds, int tid, int rowmode = 0) {
  bf16* t = (bf16*)lds;
  const int nl = tid & 63, kq = tid >> 6;
  const int sc = perm ? win_srccol(n0 + nl) : (n0 + nl);
  float tv[16];
#pragma unroll
  for (int i = 0; i < 16; ++i) {
    const int k = k0 + kq + 4 * i;
    float v = 0.f;
    if (sc >= 0) { v = src[(size_t)k * ldsrc + sc]; if (gain) v *= gain[k]; }
    tv[i] = v;
  }
#pragma unroll
  for (int i = 0; i < 16; ++i) t[nl * 72 + kq + 4 * i] = f2bf(tv[i]);
  __syncthreads();
  const int r = tid >> 2, c = (tid & 3) * 16;
  u32x4 a = *(const u32x4*)(t + r * 72 + c), b = *(const u32x4*)(t + r * 72 + c + 8);
  bf16* o = dst + (size_t)gu_rowmap(n0 + r, rowmode) * K + k0 + c;
  *(u32x4*)o = a; *(u32x4*)(o + 8) = b;
  __syncthreads();
}

DI void frag_tile(const float* __restrict__ src, int ldsrc, bool isq, const float* __restrict__ gain, bf16* __restrict__ dst, int n0, int k0, int tid) {
  const int n = n0 + (tid & 63), kq = tid >> 6;
#pragma unroll
  for (int gi = 0; gi < 2; ++gi) {
    const int kg = k0 + (kq * 2 + gi) * 8;
    float v[8];
#pragma unroll
    for (int j = 0; j < 8; ++j) v[j] = src[(size_t)(kg + j) * ldsrc + n] * gain[kg + j];
    const int kk = kg >> 4, hh = (kg >> 3) & 1, r = n & 31;
    size_t off;
    if (isq) { const int hd = n / 96, nl = n % 96; off = ((size_t)(((hd * 16 + kk) * 3 + (nl >> 5)) * 64 + hh * 32 + r)) * 8; }
    else { const int hd = n >> 7, nl = n & 127; off = ((size_t)((((hd * 2 + (nl >> 6)) * 8 + kk) * 2 + ((nl >> 5) & 1)) * 64 + hh * 32 + r)) * 8; }
    u32x4 w; w.x = pk_bf16(v[0], v[1]); w.y = pk_bf16(v[2], v[3]); w.z = pk_bf16(v[4], v[5]); w.w = pk_bf16(v[6], v[7]);
    *(u32x4*)(dst + off) = w;
  }
  __syncthreads();
  __syncthreads();
}
DI void phase0(const Params& p, unsigned char* lds, int tid, int half) {
  bf16* W = (bf16*)(p.ws + OFF_W);
  constexpr int NT_L = 832 + 256 + 704 + 704 + 704 + 24 + 16;
  for (int pi = blockIdx.x; pi < NT_L; pi += gridDim.x) {
    const int it = 2 * pi + half;
    const int l = it / NT_L; int r = it % NT_L;
    bf16* Wl = W + (size_t)l * WL_E;
    if (r < 832) { transpose_tile(p.w_in + (size_t)l * 1024 * DIN, DIN, 1024, true, p.pre_mix_g + l * 1024, Wl + WO_IN, (r / 16) * 64, (r % 16) * 64, lds, tid); continue; } r -= 832;
    if (r < 256) { transpose_tile(p.w_out + (size_t)l * 1024 * 1024, 1024, 1024, false, nullptr, Wl + WO_OUT, (r / 16) * 64, (r % 16) * 64, lds, tid); continue; } r -= 256;
    if (r < 704) { transpose_tile(p.ffn_wg + (size_t)l * 1024 * FF, FF, 1024, false, p.pre_ffn_g + l * 1024, Wl + WO_GU, (r / 16) * 64, (r % 16) * 64, lds, tid, 1); continue; } r -= 704;
    if (r < 704) { transpose_tile(p.ffn_wu + (size_t)l * 1024 * FF, FF, 1024, false, p.pre_ffn_g + l * 1024, Wl + WO_GU, (r / 16) * 64, (r % 16) * 64, lds, tid, 2); continue; } r -= 704;
    if (r < 704) { transpose_tile(p.ffn_wd + (size_t)l * FF * 1024, 1024, FF, false, nullptr, Wl + WO_DN, (r / 44) * 64, (r % 44) * 64, lds, tid); continue; } r -= 704;
    if (r < 24) { frag_tile(p.mla_wuq + (size_t)l * 256 * 384, 384, true, p.mla_qg + l * 256, Wl + WO_UQ, (r / 4) * 64, (r % 4) * 64, tid); continue; } r -= 24;
    frag_tile(p.mla_wukv + (size_t)l * 128 * 512, 512, false, p.mla_kvg + l * 128, Wl + WO_UKV, (r / 2) * 64, (r % 2) * 64, tid);
  }
}

DI void resid_phase(const float* __restrict__ xin, const bf16* __restrict__ xinb, const bf16* __restrict__ y, const float* __restrict__ g, float* __restrict__ xout, bf16* __restrict__ xb, float* __restrict__ rs, int tid, int vb, int nvb) {
  const int lane = tid & 63, wv = tid >> 6;
  const int stride = nvb * 4;
  for (int row0 = vb * 4 + wv; row0 < T_; row0 += 2 * stride) {
    f32x4 v[2][4]; u32x2 yu[2][4];
#pragma unroll
    for (int q = 0; q < 2; ++q) {
      const int row = min(row0 + q * stride, T_ - 1);
      if (xin) {
#pragma unroll
        for (int j = 0; j < 4; ++j) v[q][j] = *(const f32x4*)(xin + (size_t)row * 1024 + lane * 4 + 256 * j);
      } else {
#pragma unroll
        for (int j = 0; j < 4; ++j) { const u32x2 u = *(const u32x2*)(xinb + (size_t)row * 1024 + lane * 4 + 256 * j); v[q][j] = (f32x4){bflo(u.x), bfhi(u.x), bflo(u.y), bfhi(u.y)}; }
      }
      if (y) {
#pragma unroll
        for (int j = 0; j < 4; ++j) yu[q][j] = *(const u32x2*)(y + (size_t)row * 1024 + lane * 4 + 256 * j);
      }
    }
#pragma unroll
    for (int q = 0; q < 2; ++q) {
      const int row = row0 + q * stride;
      if (y) {
        f32x4 yv[4]; float ss = 0.f;
#pragma unroll
        for (int j = 0; j < 4; ++j) {
          yv[j] = (f32x4){bflo(yu[q][j].x), bfhi(yu[q][j].x), bflo(yu[q][j].y), bfhi(yu[q][j].y)};
          ss += yv[j].x * yv[j].x + yv[j].y * yv[j].y + yv[j].z * yv[j].z + yv[j].w * yv[j].w;
        }
        const float ry = rsqrtf(wave_sum(ss) * (1.f / 1024.f) + EPS);
#pragma unroll
        for (int j = 0; j < 4; ++j) { f32x4 gg = *(const f32x4*)(g + lane * 4 + 256 * j); v[q][j] = v[q][j] + yv[j] * ry * gg; }
      }
      float sx = 0.f;
#pragma unroll
      for (int j = 0; j < 4; ++j) sx += v[q][j].x * v[q][j].x + v[q][j].y * v[q][j].y + v[q][j].z * v[q][j].z + v[q][j].w * v[q][j].w;
      sx = wave_sum(sx);
      if (row < T_) {
#pragma unroll
        for (int j = 0; j < 4; ++j) {
          if (xout) *(f32x4*)(xout + (size_t)row * 1024 + lane * 4 + 256 * j) = v[q][j];
          if (xb) {
            u32x2 o; o.x = pk_bf16(v[q][j].x, v[q][j].y); o.y = pk_bf16(v[q][j].z, v[q][j].w);
            *(u32x2*)(xb + (size_t)row * 1024 + lane * 4 + 256 * j) = o;
          }
        }
        if (xb && lane == 0) rs[row] = rsqrtf(sx * (1.f / 1024.f) + EPS);
      }
    }
  }
}

DI float gelu_tanh(float x) {
  const float u = 0.7978845608028654f * (x + 0.044715f * x * x * x);
  const float e = __expf(2.f * u);
  const float th = 1.f - 2.f / (e + 1.f);
  return 0.5f * x * (1.f + th);
}
struct EpiStore {
  bf16* out0; bf16* out1; int split; int ldc; const float* rs; const float* cw;
  DI void store4(int m, int n, f32x4 v) const {
    bf16* o = out0; if (n >= split) { o = out1; n -= split; }
    u32x2 w; w.x = pk_bf16(v.x, v.y); w.y = pk_bf16(v.z, v.w);
    *(u32x2*)(o + (size_t)m * ldc + n) = w;
  }
};

#define GL_LAS __attribute__((address_space(3)))
DI int g8_lds_byte(int r, int c) { const int st = (r >> 4) * 2 + (c >> 5), rr = r & 15, cc = c & 31, ob = rr * 64 + cc * 2; return st * 1024 + (ob ^ (((ob >> 9) & 1) << 5)); }
DI void g8_stage_rc(int b, int& R, int& C) { const int st = b / 1024, sb = b % 1024, swz = sb ^ (((sb >> 9) & 1) << 5); R = (st >> 1) * 16 + swz / 64; C = (st & 1) * 32 + (swz % 64) / 2; }
template <bool ACT>
DI void gemm_phase(const bf16* __restrict__ A, int lda, const bf16* __restrict__ Bt, int ldb, int K, int MT, int NT, const EpiStore& epi, unsigned char* lds, int tid) {
  constexpr int HTB = 128 * 64 * 2;
  const int nt_k = K / 64;
  const int xcd = blockIdx.x & 7, jb = blockIdx.x >> 3, nbx = (gridDim.x + 7 - xcd) >> 3;
  const int band = MT / 8, per_x = band * NT;
  for (int lt = jb; lt < per_x; lt += nbx) {
    const int mg = lt / (8 * NT), rem = lt % (8 * NT), gs = min(8, band - 8 * mg);
    const int mt = xcd * band + mg * 8 + rem % gs, nt = rem / gs, n0 = nt * 256;
    int m0 = mt * 256, seq0 = 0;
    if (ACT) { const int bs = mt / 34, ti = mt % 34; if (ti == 33) continue; seq0 = bs * S_; m0 = seq0 + 254 * ti - 2; }
    __syncthreads();
    asm volatile("" : "+v"(tid));
    const int wid = tid >> 6, lane = tid & 63, wr = wid >> 2, wc = wid & 3, fr = lane & 15, fq = lane >> 4;
    const int obs = (fr * 64 + fq * 16) ^ ((((fr * 64 + fq * 16) >> 9) & 1) << 5);
    const int a_rd = obs + wr * 8192, b_rd = obs + wc * 4096;
#define SA8(b, h) (lds + ((b) * 2 + (h)) * HTB)
#define SB8(b, h) (lds + (4 + (b) * 2 + (h)) * HTB)
    unsigned aofs[2][2], bofs[2];
#pragma unroll
    for (int i = 0; i < 2; ++i) {
      int sr_, sc_; g8_stage_rc(tid * 16 + i * 8192, sr_, sc_);
      bofs[i] = ((unsigned)(n0 + sr_) * (unsigned)ldb + (unsigned)sc_) * 2u;
#pragma unroll
      for (int hf = 0; hf < 2; ++hf) {
        int row = m0 + sr_ + (ACT ? hf * 128 : 0); if (ACT) row = min(max(row, seq0), seq0 + S_ - 1);
        aofs[hf][i] = ((unsigned)row * (unsigned)lda + (unsigned)sc_) * 2u;
      }
    }
#define STAGE_A(P, half_, kt) do { const unsigned char* ub_ = (const unsigned char*)A + (size_t)(kt) * 128 + (ACT ? (size_t)0 : (size_t)(half_) * 256 * (size_t)lda); _Pragma("unroll") for (int _i = 0; _i < 2; ++_i) \
      __builtin_amdgcn_global_load_lds((const unsigned*)(ub_ + aofs[half_][_i]), (GL_LAS unsigned*)((P) + tid * 16 + _i * 8192), 16, 0, 0); } while (0)
#define STAGE_B(P, half_, kt) do { const unsigned char* ub_ = (const unsigned char*)Bt + (size_t)(kt) * 128 + (size_t)(half_) * 256 * (size_t)ldb; _Pragma("unroll") for (int _i = 0; _i < 2; ++_i) \
      __builtin_amdgcn_global_load_lds((const unsigned*)(ub_ + bofs[_i]), (GL_LAS unsigned*)((P) + tid * 16 + _i * 8192), 16, 0, 0); } while (0)
#define LDA8(dst, b, h) _Pragma("unroll") for (int m = 0; m < 4; ++m) _Pragma("unroll") for (int k = 0; k < 2; ++k) \
      dst[m][k] = *(const bf16x8*)(SA8(b, h) + a_rd + m * 2048 + k * 1024)
#define LDB8(dst, b, h) _Pragma("unroll") for (int n = 0; n < 2; ++n) _Pragma("unroll") for (int k = 0; k < 2; ++k) \
      dst[n][k] = *(const bf16x8*)(SB8(b, h) + b_rd + n * 2048 + k * 1024)
#define MMA8(ai, bj, At_, Bt_) do { __builtin_amdgcn_s_setprio(1); \
      _Pragma("unroll") for (int m = 0; m < 4; ++m) _Pragma("unroll") for (int n = 0; n < 2; ++n) _Pragma("unroll") for (int k = 0; k < 2; ++k) \
        acc[ai][bj][m][n] = __builtin_amdgcn_mfma_f32_16x16x32_bf16(Bt_[n][k], At_[m][k], acc[ai][bj][m][n], 0, 0, 0); \
      __builtin_amdgcn_s_setprio(0); } while (0)
#define WAIT_V(n) asm volatile("s_waitcnt vmcnt(" #n ")" ::: "memory")
#define WAIT_L(n) asm volatile("s_waitcnt lgkmcnt(" #n ")" ::: "memory")
#define BAR8 __builtin_amdgcn_s_barrier()
#define SCHED8 __builtin_amdgcn_sched_barrier(0)
    f32x4 acc[2][2][4][2];
#pragma unroll
    for (int i0 = 0; i0 < 2; ++i0)
#pragma unroll
      for (int i1 = 0; i1 < 2; ++i1)
#pragma unroll
        for (int i2 = 0; i2 < 4; ++i2)
#pragma unroll
          for (int i3 = 0; i3 < 2; ++i3) acc[i0][i1][i2][i3] = (f32x4){0.f, 0.f, 0.f, 0.f};
    bf16x8 At[4][2], B0[2][2], B1[2][2];
    STAGE_B(SB8(0, 0), 0, 0); STAGE_A(SA8(0, 0), 0, 0);
    STAGE_B(SB8(0, 1), 1, 0); STAGE_A(SA8(0, 1), 1, 0);
    if (wr == 1) BAR8;
    WAIT_V(4); BAR8;
    STAGE_B(SB8(1, 0), 0, 1); STAGE_A(SA8(1, 0), 0, 1); STAGE_B(SB8(1, 1), 1, 1);
    WAIT_V(6); BAR8;
    for (int t = 0; t < nt_k - 2; t += 2) {
      LDB8(B0, 0, 0); SCHED8; LDA8(At, 0, 0); STAGE_A(SA8(1, 1), 1, t + 1);
      WAIT_L(8); BAR8; WAIT_L(0); MMA8(0, 0, At, B0); BAR8; SCHED8;
      LDB8(B1, 0, 1); STAGE_B(SB8(0, 0), 0, t + 2);
      BAR8; WAIT_L(0); MMA8(0, 1, At, B1); BAR8;
      LDA8(At, 0, 1); STAGE_A(SA8(0, 0), 0, t + 2);
      BAR8; WAIT_L(0); MMA8(1, 0, At, B0); BAR8; SCHED8;
      STAGE_B(SB8(0, 1), 1, t + 2);
      WAIT_V(6); BAR8; MMA8(1, 1, At, B1); BAR8;
      LDB8(B0, 1, 0); SCHED8; LDA8(At, 1, 0); STAGE_A(SA8(0, 1), 1, t + 2);
      WAIT_L(8); BAR8; WAIT_L(0); MMA8(0, 0, At, B0); BAR8; SCHED8;
      LDB8(B1, 1, 1); STAGE_B(SB8(1, 0), 0, t + 3);
      BAR8; WAIT_L(0); MMA8(0, 1, At, B1); BAR8;
      LDA8(At, 1, 1); STAGE_A(SA8(1, 0), 0, t + 3);
      BAR8; WAIT_L(0); MMA8(1, 0, At, B0); BAR8; SCHED8;
      STAGE_B(SB8(1, 1), 1, t + 3);
      WAIT_V(6); BAR8; MMA8(1, 1, At, B1); BAR8;
    }
    { LDB8(B0, 0, 0); LDA8(At, 0, 0); STAGE_A(SA8(1, 1), 1, nt_k - 1);
      BAR8; WAIT_L(0); MMA8(0, 0, At, B0); BAR8;
      LDB8(B1, 0, 1); BAR8; WAIT_L(0); MMA8(0, 1, At, B1); BAR8;
      LDA8(At, 0, 1); WAIT_V(4); BAR8; WAIT_L(0); MMA8(1, 0, At, B0); MMA8(1, 1, At, B1); BAR8; }
    { LDB8(B0, 1, 0); LDA8(At, 1, 0); WAIT_V(2); BAR8; WAIT_L(0); MMA8(0, 0, At, B0); BAR8;
      LDB8(B1, 1, 1); WAIT_V(0); BAR8; WAIT_L(0); MMA8(0, 1, At, B1); BAR8;
      LDA8(At, 1, 1); BAR8; WAIT_L(0); MMA8(1, 0, At, B0); MMA8(1, 1, At, B1); BAR8; }
    if (wr == 0) BAR8;
    __syncthreads();
    int tid_e = tid; asm volatile("" : "+v"(tid_e));
    const int e_wid = tid_e >> 6, e_lane = tid_e & 63, e_wr = e_wid >> 2, e_wc = e_wid & 3, e_fr = e_lane & 15, e_fq = e_lane >> 4;
    if (!ACT) {
#pragma unroll
      for (int ai = 0; ai < 2; ++ai)
#pragma unroll
        for (int m = 0; m < 4; ++m) {
          const int ml = ai * 128 + e_wr * 64 + m * 16 + e_fr;
          const float sc = epi.rs ? epi.rs[m0 + ml] : 1.f;
#pragma unroll
          for (int bj = 0; bj < 2; ++bj)
#pragma unroll
            for (int n = 0; n < 2; ++n) {
              const f32x4 v = acc[ai][bj][m][n] * sc;
              u32x2 w2; w2.x = pk_bf16(v[0], v[1]); w2.y = pk_bf16(v[2], v[3]);
              *(u32x2*)(lds + ml * 520 + (bj * 128 + e_wc * 32 + n * 16 + e_fq * 4) * 2) = w2;
            }
        }
      __syncthreads();
#pragma unroll 2
      for (int k = 0; k < 16; ++k) {
        const int id = tid_e + 512 * k, row = id >> 5, ch = id & 31;
        const u32x2 lo = *(const u32x2*)(lds + row * 520 + ch * 16), hi = *(const u32x2*)(lds + row * 520 + ch * 16 + 8);
        *(u32x4*)(epi.out0 + (size_t)(m0 + row) * epi.ldc + n0 + ch * 8) = (u32x4){lo.x, lo.y, hi.x, hi.y};
      }
    } else {
      float* G = (float*)lds;
#pragma unroll
      for (int ai = 0; ai < 2; ++ai)
#pragma unroll
        for (int m = 0; m < 4; ++m) {
          const int ml = ai * 128 + e_wr * 64 + m * 16 + e_fr;
          const float sc = epi.rs[min(max(m0 + ml, seq0), seq0 + S_ - 1)];
#pragma unroll
          for (int n = 0; n < 2; ++n) {
            acc[ai][0][m][n] = acc[ai][0][m][n] * sc; acc[ai][1][m][n] = acc[ai][1][m][n] * sc;
#pragma unroll
            for (int j = 0; j < 4; ++j) G[(e_wc * 32 + n * 16 + e_fq * 4 + j) * 256 + ml] = acc[ai][0][m][n][j];
          }
        }
      __syncthreads();
#pragma unroll
      for (int n = 0; n < 2; ++n) {
        const int chl = e_wc * 32 + n * 16 + e_fq * 4, c = nt * 128 + chl;
        const f32x4 w0 = *(const f32x4*)(epi.cw + c), w1 = *(const f32x4*)(epi.cw + FF + c), w2 = *(const f32x4*)(epi.cw + 2 * FF + c);
#pragma unroll
        for (int ai = 0; ai < 2; ++ai)
#pragma unroll
          for (int m = 0; m < 4; ++m) {
            const int ml = ai * 128 + e_wr * 64 + m * 16 + e_fr, t = m0 + ml, sq = t - seq0;
            const int m1 = max(ml - 1, 0), m2 = max(ml - 2, 0);
            float o[4];
#pragma unroll
            for (int j = 0; j < 4; ++j) {
              const float g0 = acc[ai][0][m][n][j];
              const float g1 = (sq >= 1) ? G[(chl + j) * 256 + m1] : 0.f;
              const float g2 = (sq >= 2) ? G[(chl + j) * 256 + m2] : 0.f;
              const float cv = w0[j] * g2 + w1[j] * g1 + w2[j] * g0;
              o[j] = gelu_tanh(cv) * acc[ai][1][m][n][j];
            }
            if (ml >= 2 && sq < S_) {
              u32x2 wv2; wv2.x = pk_bf16(o[0], o[1]); wv2.y = pk_bf16(o[2], o[3]);
              *(u32x2*)(epi.out0 + (size_t)t * FF + c) = wv2;
            }
          }
      }
    }
  }
  __syncthreads();
}

DI void ffn_act_phase(const bf16* __restrict__ gate, bf16* __restrict__ up, const float* __restrict__ cw, int tid) {
  constexpr int CG = FF / 8;
  const int total = (T_ / 16) * CG;
  for (int it = blockIdx.x * 256 + tid; it < total; it += gridDim.x * 256) {
    const int tb = it / CG, cgp = it % CG, t0 = tb * 16, c0 = cgp * 8;
    float w0[8], w1[8], w2[8], g1[8], g2[8];
#pragma unroll
    for (int i = 0; i < 8; ++i) { w0[i] = cw[c0 + i]; w1[i] = cw[FF + c0 + i]; w2[i] = cw[2 * FF + c0 + i]; g1[i] = 0.f; g2[i] = 0.f; }
    if ((t0 & (S_ - 1)) != 0) {
      u32x4 a = *(const u32x4*)(gate + (size_t)(t0 - 2) * FF + c0), b = *(const u32x4*)(gate + (size_t)(t0 - 1) * FF + c0);
#pragma unroll
      for (int i = 0; i < 4; ++i) { g2[2 * i] = bflo(a[i]); g2[2 * i + 1] = bfhi(a[i]); g1[2 * i] = bflo(b[i]); g1[2 * i + 1] = bfhi(b[i]); }
    }
#pragma unroll 4
    for (int t = t0; t < t0 + 16; ++t) {
      u32x4 a = *(const u32x4*)(gate + (size_t)t * FF + c0), u = *(const u32x4*)(up + (size_t)t * FF + c0);
      float g0[8], uu[8], o[8];
#pragma unroll
      for (int i = 0; i < 4; ++i) { g0[2 * i] = bflo(a[i]); g0[2 * i + 1] = bfhi(a[i]); uu[2 * i] = bflo(u[i]); uu[2 * i + 1] = bfhi(u[i]); }
#pragma unroll
      for (int i = 0; i < 8; ++i) { const float c = w0[i] * g2[i] + w1[i] * g1[i] + w2[i] * g0[i]; o[i] = gelu_tanh(c) * uu[i]; g2[i] = g1[i]; g1[i] = g0[i]; }
      u32x4 w; w.x = pk_bf16(o[0], o[1]); w.y = pk_bf16(o[2], o[3]); w.z = pk_bf16(o[4], o[5]); w.w = pk_bf16(o[6], o[7]);
      *(u32x4*)(up + (size_t)t * FF + c0) = w;
    }
  }
}

template <int DK, bool ISA>
DI float gla_lb(const Params& p, int l, int h, int d) {
  if (!ISA || l == 0) return 0.f;
  const float l0 = p.hgrn_lb[h * 64 + d], l1 = p.hgrn_lb[256 + h * 64 + d];
  return 1.f / (1.f + __expf(l0 - l1));
}
template <int DK, bool ISA>
DI void gla_bc(const Params& p, int l, const bf16* __restrict__ z, int t0, int h, float* bcl, int tid) {
  constexpr int NP = 256 / DK, TPP = 64 / NP;
  const int d = tid % DK, part = tid / DK;
  float run = 0.f;
  if (ISA) {
    const float lbv = gla_lb<DK, ISA>(p, l, h, d);
#pragma unroll
    for (int jj = 0; jj < TPP; ++jj) {
      const int j = part * TPP + jj;
      const float zf = bf2f(z[(size_t)(t0 + j) * ZLD + ZA_F + h * 64 + d]);
      const float f = lbv + (1.f - lbv) * sigmoidf_(zf);
      run += __logf(fmaxf(f, 1e-30f));
      bcl[j * DK + d] = run;
    }
  } else {
    float w[16];
#pragma unroll
    for (int rr = 0; rr < 16; ++rr) w[rr] = p.gla_w2[(size_t)l * 16 * 128 + rr * 128 + h * 32 + d];
    const float bias = p.gla_b[l * 128 + h * 32 + d];
#pragma unroll
    for (int jj = 0; jj < TPP; ++jj) {
      const int j = part * TPP + jj;
      const u32x4* cp = (const u32x4*)(z + (size_t)(t0 + j) * ZLD + ZB_CODE);
      u32x4 c0 = cp[0], c1 = cp[1];
      float u = bias;
#pragma unroll
      for (int i = 0; i < 4; ++i) { u += bflo(c0[i]) * w[2 * i] + bfhi(c0[i]) * w[2 * i + 1]; u += bflo(c1[i]) * w[8 + 2 * i] + bfhi(c1[i]) * w[8 + 2 * i + 1]; }
      run += -softplusf_(-u) * (1.f / 16.f);
      bcl[j * DK + d] = run;
    }
  }
  __syncthreads();
  float off = 0.f;
  for (int pp = 0; pp < part; ++pp) off += bcl[(pp * TPP + TPP - 1) * DK + d];
  __syncthreads();
#pragma unroll
  for (int jj = 0; jj < TPP; ++jj) bcl[(part * TPP + jj) * DK + d] += off;
  __syncthreads();
}
template <int DK, bool ISA>
DI float gla_kval(const bf16* __restrict__ z, int t, int h, int d, float lbv) {
  if (ISA) { const float zf = bf2f(z[(size_t)t * ZLD + ZA_F + h * 64 + d]); return (1.f - lbv) * sigmoidf_(-zf); }
  return bf2f(z[(size_t)t * ZLD + ZB_K + h * 32 + d]);
}
template <int DK, bool ISA>
DI float gla_qval(const bf16* __restrict__ z, int t, int h, int d) {
  if (ISA) { const float zq = bf2f(z[(size_t)t * ZLD + ZA_Q + h * 64 + d]); return siluf_(zq) * 0.125f; }
  return bf2f(z[(size_t)t * ZLD + ZB_Q + h * 32 + d]) * 0.17677669529663687f;
}

template <int DK, bool ISA>
DI void gla_local_item(const Params& p, int l, int ci, unsigned char* lds, int tid) {
  const bf16* z = (const bf16*)(p.ws + OFF_AR + AR_Z);
  bf16* UT = (bf16*)(p.ws + OFF_AR + (ISA ? AR_UTA : AR_UTB));
  float* G = (float*)(p.ws + (ISA ? OFF_GA : OFF_GB));
  const int h = ci & 3, t0 = (ci >> 2) * 64;
  float* bcl = (float*)lds;
  bf16* kT = (bf16*)(lds + 16384);
  bf16* vT = (bf16*)(lds + 16384 + 9216);
  bf16 vpre[16];
  {
    const int e = tid & 63, p4 = tid >> 6;
    const int vcol = (ISA ? ZA_I : ZB_V) + h * 64 + e;
#pragma unroll
    for (int jj = 0; jj < 16; ++jj) vpre[jj] = z[(size_t)(t0 + p4 * 16 + jj) * ZLD + vcol];
  }
  constexpr int NPk = 256 / DK, TPPk = 64 / NPk;
  bf16 kpre[TPPk];
  {
    const int d = tid % DK, part = tid / DK;
#pragma unroll
    for (int jj = 0; jj < TPPk; ++jj) kpre[jj] = z[(size_t)(t0 + part * TPPk + jj) * ZLD + (ISA ? ZA_F + h * 64 : ZB_K + h * 32) + d];
  }
  gla_bc<DK, ISA>(p, l, z, t0, h, bcl, tid);
  {
    float* bcg = (float*)((unsigned char*)p.out + BC_OFF + (ISA ? 0 : BC_B_OFF)) + (size_t)ci * 64 * DK;
#pragma unroll
    for (int k = 0; k < (64 * DK) / 1024; ++k) *(f32x4*)(bcg + (tid + 256 * k) * 4) = *(const f32x4*)(bcl + (tid + 256 * k) * 4);
  }
  constexpr int NP = 256 / DK, TPP = 64 / NP;
  {
    const int d = tid % DK, part = tid / DK;
    const float lbv = gla_lb<DK, ISA>(p, l, h, d);
    const float bl = bcl[63 * DK + d];
#pragma unroll
    for (int jj = 0; jj < TPP; ++jj) {
      const int j = part * TPP + jj;
      const float kv = ISA ? (1.f - lbv) * sigmoidf_(-bf2f(kpre[jj])) : bf2f(kpre[jj]);
      kT[d * 72 + j] = f2bf(kv * __expf(bl - bcl[j * DK + d]));
    }
    if (part == 0) G[(size_t)ci * DK + d] = __expf(bl);
    const int e = tid & 63, p4 = tid >> 6;
#pragma unroll
    for (int jj = 0; jj < 16; ++jj) { const int j = p4 * 16 + jj; vT[e * 72 + j] = vpre[jj]; }
  }
  __syncthreads();
  const int lane = tid & 63, wv = tid >> 6, wm = wv & 1, wn = wv >> 1, r = lane & 31, hh = lane >> 5;
  if (wm * 32 < DK) {
    f32x16 acc = mm32((const unsigned char*)(kT + wm * 32 * 72), 144, (const unsigned char*)(vT + wn * 32 * 72), 144, 4, zero16(), r, hh);
    const int e = wn * 32 + r;
#pragma unroll
    for (int g = 0; g < 4; ++g) {
      const int d = wm * 32 + 8 * g + 4 * hh;
      u32x2 w; w.x = pk_bf16(acc[4 * g], acc[4 * g + 1]); w.y = pk_bf16(acc[4 * g + 2], acc[4 * g + 3]);
      *(u32x2*)(UT + ((size_t)ci * 64 + e) * DK + d) = w;
    }
  }
  __syncthreads();
}

template <int DK>
DI void gla_scan_item(bf16* __restrict__ UT, const float* __restrict__ G, int b, int h, int slice, int tid) {
  constexpr int GPR = DK / 4, RPS = 256 / GPR;
  const int e = slice * RPS + tid / GPR, d4 = (tid % GPR) * 4;
  f32x4 st = (f32x4){0.f, 0.f, 0.f, 0.f};
  for (int c0 = 0; c0 < 128; c0 += 8) {
    u32x2 u[8]; f32x4 gg[8];
#pragma unroll
    for (int i = 0; i < 8; ++i) {
      const size_t ci = ((size_t)(b * 128 + c0 + i) * 4 + h);
      u[i] = *(const u32x2*)(UT + (ci * 64 + e) * DK + d4);
      gg[i] = *(const f32x4*)(G + ci * DK + d4);
    }
#pragma unroll
    for (int i = 0; i < 8; ++i) {
      const size_t ci = ((size_t)(b * 128 + c0 + i) * 4 + h);
      u32x2 w; w.x = pk_bf16(st.x, st.y); w.y = pk_bf16(st.z, st.w);
      *(u32x2*)(UT + (ci * 64 + e) * DK + d4) = w;
      st = gg[i] * st + (f32x4){bflo(u[i].x), bfhi(u[i].x), bflo(u[i].y), bfhi(u[i].y)};
    }
  }
}

template <bool SIG>
DI void norm_gate_store(const float* obuf, bool has_add, u32x4 a0, u32x4 a1, const f32x4 (&ngv)[4], u32x4 g0, u32x4 g1, bf16* __restrict__ mixo, int tid) {
  const int i = tid >> 2, e0 = (tid & 3) * 16;
  float o[16]; float ss = 0.f;
#pragma unroll
  for (int k = 0; k < 16; ++k) o[k] = obuf[i * 68 + e0 + k];
  if (has_add) {
#pragma unroll
    for (int k = 0; k < 4; ++k) { o[2 * k] += bflo(a0[k]); o[2 * k + 1] += bfhi(a0[k]); o[8 + 2 * k] += bflo(a1[k]); o[8 + 2 * k + 1] += bfhi(a1[k]); }
  }
#pragma unroll
  for (int k = 0; k < 16; ++k) ss += o[k] * o[k];
  ss += __shfl_xor(ss, 1); ss += __shfl_xor(ss, 2);
  const float rsv = rsqrtf(ss * (1.f / 64.f) + EPS);
  float gt[16];
#pragma unroll
  for (int k = 0; k < 4; ++k) { gt[2 * k] = bflo(g0[k]); gt[2 * k + 1] = bfhi(g0[k]); gt[8 + 2 * k] = bflo(g1[k]); gt[8 + 2 * k + 1] = bfhi(g1[k]); }
  unsigned w[8];
#pragma unroll
  for (int k = 0; k < 8; ++k) {
    float a = o[2 * k] * rsv * ngv[(2 * k) >> 2][(2 * k) & 3], b = o[2 * k + 1] * rsv * ngv[(2 * k + 1) >> 2][(2 * k + 1) & 3];
    a *= SIG ? sigmoidf_(gt[2 * k]) : siluf_(gt[2 * k]);
    b *= SIG ? sigmoidf_(gt[2 * k + 1]) : siluf_(gt[2 * k + 1]);
    w[k] = pk_bf16(a, b);
  }
  u32x4* op = (u32x4*)(mixo + (size_t)i * 1024 + e0);
  op[0] = (u32x4){w[0], w[1], w[2], w[3]}; op[1] = (u32x4){w[4], w[5], w[6], w[7]};
}

template <int DK, bool ISA>
DI void gla_out_item(const Params& p, int l, int ci, unsigned char* lds, int tid) {
  const bf16* z = (const bf16*)(p.ws + OFF_AR + AR_Z);
  const bf16* ST = (const bf16*)(p.ws + OFF_AR + (ISA ? AR_UTA : AR_UTB));
  bf16* mix = (bf16*)(p.ws + OFF_AR + AR_MIX);
  const int h = ci & 3, t0 = (ci >> 2) * 64;
  constexpr int LDK = (DK + 8) * 2;
  float* bcl = (float*)lds;
  float* obuf = (float*)lds;
  unsigned char* qh = lds + 17408;
  unsigned char* kt = qh + 9216;
  unsigned char* qc = kt + 9216;
  unsigned char* vT = qc + 9216;
  unsigned char* stl = vT + 9216;
  unsigned char* attn = stl + 9216;
  const u32x4* gpre = (const u32x4*)(z + (size_t)(t0 + (tid >> 2)) * ZLD + (ISA ? ZA_G : ZB_G) + h * 64 + (tid & 3) * 16);
  const u32x4 gq0 = gpre[0], gq1 = gpre[1];
  f32x4 ngv[4];
#pragma unroll
  for (int k = 0; k < 4; ++k) ngv[k] = *(const f32x4*)((ISA ? p.hgrn_ng : p.gla_ng) + l * 64 + (tid & 3) * 16 + 4 * k);
  bf16 vpre[16];
  {
    const int e = tid & 63, p4 = tid >> 6;
    const int vcol = (ISA ? ZA_I : ZB_V) + h * 64 + e;
#pragma unroll
    for (int jj = 0; jj < 16; ++jj) vpre[jj] = z[(size_t)(t0 + p4 * 16 + jj) * ZLD + vcol];
  }
  constexpr int NPq = 256 / DK, TPPq = 64 / NPq;
  bf16 qpre[TPPq], kpre[TPPq];
  {
    const int d = tid % DK, part = tid / DK;
#pragma unroll
    for (int jj = 0; jj < TPPq; ++jj) {
      const size_t t = (size_t)(t0 + part * TPPq + jj);
      qpre[jj] = z[t * ZLD + (ISA ? ZA_Q + h * 64 : ZB_Q + h * 32) + d];
      kpre[jj] = ISA ? z[t * ZLD + ZA_F + h * 64 + d] : z[t * ZLD + ZB_K + h * 32 + d];
    }
  }
  constexpr int CPR0 = DK / 8, NST = (64 * CPR0) / 256;
  u32x4 stpre[NST];
#pragma unroll
  for (int k = 0; k < NST; ++k) { const int id = tid + 256 * k; stpre[k] = *(const u32x4*)(ST + ((size_t)ci * 64 + id / CPR0) * DK + (id % CPR0) * 8); }
  {
    const float* bcg = (const float*)((const unsigned char*)p.out + BC_OFF + (ISA ? 0 : BC_B_OFF)) + (size_t)ci * 64 * DK;
#pragma unroll
    for (int k = 0; k < (64 * DK) / 1024; ++k) *(f32x4*)(bcl + (tid + 256 * k) * 4) = *(const f32x4*)(bcg + (tid + 256 * k) * 4);
    __syncthreads();
  }
  constexpr int NP = 256 / DK, TPP = 64 / NP;
  {
    const int d = tid % DK, part = tid / DK;
    const float lbv = gla_lb<DK, ISA>(p, l, h, d);
    const float bref = bcl[31 * DK + d];
#pragma unroll
    for (int jj = 0; jj < TPP; ++jj) {
      const int j = part * TPP + jj;
      const float kv = ISA ? (1.f - lbv) * sigmoidf_(-bf2f(kpre[jj])) : bf2f(kpre[jj]);
      const float qv = ISA ? siluf_(bf2f(qpre[jj])) * 0.125f : bf2f(qpre[jj]) * 0.17677669529663687f;
      const float bc = bcl[j * DK + d];
      const float dq = fminf(fmaxf(bc - bref, -80.f), 80.f);
      ((bf16*)qh)[j * (DK + 8) + d] = f2bf(qv * __expf(dq));
      ((bf16*)kt)[j * (DK + 8) + d] = f2bf(kv * __expf(-dq));
      ((bf16*)qc)[j * (DK + 8) + d] = f2bf(qv * __expf(bc));
    }
    const int e = tid & 63, p4 = tid >> 6;
#pragma unroll
    for (int jj = 0; jj < 16; ++jj) { const int j = p4 * 16 + jj; ((bf16*)vT)[e * 72 + j] = vpre[jj]; }
#pragma unroll
    for (int k = 0; k < NST; ++k) { const int id = tid + 256 * k; *(u32x4*)(stl + (id / CPR0) * LDK + (id % CPR0) * 16) = stpre[k]; }
  }
  __syncthreads();
  const int lane = tid & 63, wv = tid >> 6, wm = wv & 1, wn = wv >> 1, r = lane & 31, hh = lane >> 5;
  {
    f32x16 acc = mm32(qh + wm * 32 * LDK, LDK, kt + wn * 32 * LDK, LDK, DK / 16, zero16(), r, hh);
    const int jc = wn * 32 + r;
#pragma unroll
    for (int g = 0; g < 4; ++g)
#pragma unroll
      for (int k = 0; k < 4; ++k) {
        const int i = wm * 32 + 8 * g + 4 * hh + k;
        const float v = (jc <= i) ? acc[4 * g + k] : 0.f;
        ((bf16*)attn)[i * 72 + jc] = f2bf(v);
      }
  }
  __syncthreads();
  {
    f32x16 acc = mm32(attn + wm * 32 * 144, 144, vT + wn * 32 * 144, 144, 4, zero16(), r, hh);
    acc = mm32(qc + wm * 32 * LDK, LDK, stl + wn * 32 * LDK, LDK, DK / 16, acc, r, hh);
    const int e = wn * 32 + r;
#pragma unroll
    for (int g = 0; g < 4; ++g)
#pragma unroll
      for (int k = 0; k < 4; ++k) obuf[(wm * 32 + 8 * g + 4 * hh + k) * 68 + e] = acc[4 * g + k];
  }
  __syncthreads();
  norm_gate_store<ISA>(obuf, false, gq0, gq0, ngv, gq0, gq1, mix + (size_t)t0 * 1024 + (ISA ? 0 : 256) + h * 64, tid);
  __syncthreads();
}

DI void gdn_local_item(const Params& p, int l, int ci, unsigned char* lds, int tid) {
  const bf16* z = (const bf16*)(p.ws + OFF_AR + AR_Z);
  float* Ac = (float*)(p.ws + OFF_AR + AR_ACD) + (size_t)ci * 4096;
  bf16* BT = (bf16*)(p.ws + OFF_AR + AR_BTD) + (size_t)ci * 4096;
  bf16* Qeff = (bf16*)(p.ws + OFF_AR + AR_QEFF) + (size_t)ci * 4096;
  bf16* Oloc = (bf16*)(p.ws + OFF_AR + AR_OLOC) + (size_t)ci * 4096;
  const int h = ci & 3, t0 = (ci >> 2) * 64, s0 = t0 & (S_ - 1);
  float* Mf = (float*)lds;
  bf16* WT = (bf16*)lds;
  bf16* UT = (bf16*)(lds + 9216);
  float* X = (float*)(lds + 16384);
  bf16* qn = (bf16*)(lds + 16384);
  bf16* kn = qn + 64 * 72;
  bf16* vb = kn + 64 * 72;
  bf16* kbm = (bf16*)(lds + 49152);
  bf16* aqk = kbm;
  bf16* KtT = kbm + 64 * 72;
  float* sm = (float*)(lds + 49152 + 2 * 9216);
  float* betas = sm; float* bcum = sm + 64;
  const int lane = tid & 63, wv = tid >> 6;
  const bf16 zbeta_raw = z[(size_t)(t0 + lane) * ZLD + ZD_BETA + h], za_raw = z[(size_t)(t0 + lane) * ZLD + ZD_A + h];
  {
    const int d = lane, j0 = wv * 16;
    const float* cw = p.gdn_conv + (size_t)l * 4 * 768;
    float qv[16], kv[16];
#pragma unroll
    for (int which = 0; which < 3; ++which) {
      const int cc = which * 256 + h * 64 + d;
      const int zc = (which == 0 ? ZD_Q : (which == 1 ? ZD_K : ZD_V)) + h * 64 + d;
      const float c0 = cw[cc], c1 = cw[768 + cc], c2 = cw[2 * 768 + cc], c3 = cw[3 * 768 + cc];
      float x0 = 0.f, x1 = 0.f, x2 = 0.f;
      if (s0 + j0 >= 3) { x0 = bf2f(z[(size_t)(t0 + j0 - 3) * ZLD + zc]); x1 = bf2f(z[(size_t)(t0 + j0 - 2) * ZLD + zc]); x2 = bf2f(z[(size_t)(t0 + j0 - 1) * ZLD + zc]); }
#pragma unroll
      for (int jj = 0; jj < 16; ++jj) {
        const float x3 = bf2f(z[(size_t)(t0 + j0 + jj) * ZLD + zc]);
        const float o = siluf_(c0 * x0 + c1 * x1 + c2 * x2 + c3 * x3);
        x0 = x1; x1 = x2; x2 = x3;
        if (which == 0) qv[jj] = o; else if (which == 1) kv[jj] = o; else vb[(j0 + jj) * 72 + d] = f2bf(o);
      }
    }
    if (wv == 0) {
      const float be = sigmoidf_(bf2f(zbeta_raw));
      float lg = -__expf(p.gdn_alog[l * 4 + h]) * softplusf_(bf2f(za_raw) + p.gdn_dtb[l * 4 + h]);
#pragma unroll
      for (int o = 1; o < 64; o <<= 1) { const float n = __shfl_up(lg, o); if (lane >= o) lg += n; }
      betas[lane] = be; bcum[lane] = lg;
    }
    __syncthreads();
    const float bl = bcum[63];
#pragma unroll
    for (int jj = 0; jj < 16; ++jj) {
      const int j = j0 + jj;
      const float rq = rsqrtf(wave_sum(qv[jj] * qv[jj]) + EPS) * 0.125f;
      const float rk = rsqrtf(wave_sum(kv[jj] * kv[jj]) + EPS);
      const float qq = qv[jj] * rq, kk = kv[jj] * rk;
      qn[j * 72 + d] = f2bf(qq); kn[j * 72 + d] = f2bf(kk); kbm[j * 72 + d] = f2bf(kk * betas[j]);
      Qeff[j * 64 + d] = f2bf(qq * __expf(bcum[j]));
      KtT[d * 72 + j] = f2bf(kk * __expf(bl - bcum[j]));
    }
  }
  __syncthreads();
  const int wm = wv & 1, wn = wv >> 1, r = lane & 31, hh = lane >> 5;
  {
    f32x16 acc = mm32((const unsigned char*)(kbm + wm * 32 * 72), 144, (const unsigned char*)(kn + wn * 32 * 72), 144, 4, zero16(), r, hh);
    f32x16 acc2 = mm32((const unsigned char*)(qn + wm * 32 * 72), 144, (const unsigned char*)(kn + wn * 32 * 72), 144, 4, zero16(), r, hh);
    const int jc = wn * 32 + r; const float bj = bcum[jc];
    __syncthreads();
#pragma unroll
    for (int g = 0; g < 4; ++g)
#pragma unroll
      for (int k = 0; k < 4; ++k) {
        const int i = wm * 32 + 8 * g + 4 * hh + k;
        const float dec = (jc <= i) ? __expf(bcum[i] - bj) : 0.f;
        Mf[i * 64 + jc] = (jc < i) ? acc[4 * g + k] * dec : 0.f;
        aqk[i * 72 + jc] = f2bf(acc2[4 * g + k] * dec);
      }
  }
  __syncthreads();
  {
    const int c = tid & 127, j0 = (tid >> 7) * 32;
    const bf16* srcp = (c < 64) ? vb : kn;
    float xr[32];
#pragma unroll
    for (int j = 0; j < 32; ++j) { const float f = (c < 64) ? betas[j0 + j] : betas[j0 + j] * __expf(bcum[j0 + j]); xr[j] = bf2f(srcp[(j0 + j) * 72 + (c & 63)]) * f; }
    __syncthreads();
#pragma unroll
    for (int j = 0; j < 32; ++j) X[(j0 + j) * 128 + c] = xr[j];
  }
  __syncthreads();
  {
    const int g4 = lane >> 4, c16 = lane & 15;
#pragma unroll
    for (int I = 0; I < 4; ++I) {
      if (I > 0) {
        f32x4 acc0 = (f32x4){0.f, 0.f, 0.f, 0.f}, acc1 = acc0;
#pragma unroll
        for (int J = 0; J < I; ++J) {
#pragma unroll
          for (int kk = 0; kk < 4; ++kk) {
            const float av = Mf[(16 * I + c16) * 64 + 16 * J + 4 * kk + g4];
            const float b0 = X[(16 * J + 4 * kk + g4) * 128 + (2 * wv) * 16 + c16];
            const float b1 = X[(16 * J + 4 * kk + g4) * 128 + (2 * wv + 1) * 16 + c16];
            acc0 = __builtin_amdgcn_mfma_f32_16x16x4f32(av, b0, acc0, 0, 0, 0);
            acc1 = __builtin_amdgcn_mfma_f32_16x16x4f32(av, b1, acc1, 0, 0, 0);
          }
        }
#pragma unroll
        for (int r4 = 0; r4 < 4; ++r4) {
          X[(16 * I + 4 * g4 + r4) * 128 + (2 * wv) * 16 + c16] -= acc0[r4];
          X[(16 * I + 4 * g4 + r4) * 128 + (2 * wv + 1) * 16 + c16] -= acc1[r4];
        }
        __syncthreads();
      }
      if (tid < 128) {
        float x[16];
#pragma unroll
        for (int r4 = 0; r4 < 16; ++r4) x[r4] = X[(16 * I + r4) * 128 + tid];
#pragma unroll
        for (int r4 = 1; r4 < 16; ++r4) {
          const float* mr = Mf + (16 * I + r4) * 64 + 16 * I;
          float a0 = x[r4];
#pragma unroll
          for (int qb = 0; qb < (r4 + 3) / 4; ++qb) {
            const f32x4 m4 = *(const f32x4*)(mr + 4 * qb);
#pragma unroll
            for (int qq = 0; qq < 4; ++qq) if (4 * qb + qq < r4) a0 -= m4[qq] * x[4 * qb + qq];
          }
          x[r4] = a0;
        }
#pragma unroll
        for (int r4 = 0; r4 < 16; ++r4) X[(16 * I + r4) * 128 + tid] = x[r4];
      }
      __syncthreads();
    }
  }
  {
    float xr[64];
    const int c = tid & 127;
    if (tid < 128) {
#pragma unroll
      for (int j = 0; j < 64; ++j) xr[j] = X[j * 128 + c];
    }
    __syncthreads();
    if (tid < 128) {
      bf16* dst = (tid < 64 ? UT : WT) + (tid & 63) * 72;
#pragma unroll
      for (int j = 0; j < 64; j += 8) {
        u32x4 w; w.x = pk_bf16(xr[j], xr[j + 1]); w.y = pk_bf16(xr[j + 2], xr[j + 3]); w.z = pk_bf16(xr[j + 4], xr[j + 5]); w.w = pk_bf16(xr[j + 6], xr[j + 7]);
        *(u32x4*)(dst + j) = w;
      }
    }
  }
  __syncthreads();
  {
    const float bl = bcum[63];
    u32x2 qpre[4];
#pragma unroll
    for (int g = 0; g < 4; ++g) qpre[g] = *(const u32x2*)(Qeff + (wn * 32 + r) * 64 + wm * 32 + 8 * g + 4 * hh);
    f32x16 a1 = mm32((const unsigned char*)(WT + wm * 32 * 72), 144, (const unsigned char*)(aqk + wn * 32 * 72), 144, 4, zero16(), r, hh);
    f32x16 a2 = mm32((const unsigned char*)(UT + wm * 32 * 72), 144, (const unsigned char*)(aqk + wn * 32 * 72), 144, 4, zero16(), r, hh);
    f32x16 a3 = mm32((const unsigned char*)(WT + wm * 32 * 72), 144, (const unsigned char*)(KtT + wn * 32 * 72), 144, 4, zero16(), r, hh);
    f32x16 a4 = mm32((const unsigned char*)(KtT + wm * 32 * 72), 144, (const unsigned char*)(UT + wn * 32 * 72), 144, 4, zero16(), r, hh);
    const int cidx = wn * 32 + r;
    const float ebl = __expf(bl);
#pragma unroll
    for (int g = 0; g < 4; ++g) {
      const int rb = wm * 32 + 8 * g + 4 * hh;
      const u32x2 qraw = qpre[g];
      u32x2 w;
      w.x = pk_bf16(bflo(qraw.x) - a1[4 * g], bfhi(qraw.x) - a1[4 * g + 1]);
      w.y = pk_bf16(bflo(qraw.y) - a1[4 * g + 2], bfhi(qraw.y) - a1[4 * g + 3]);
      *(u32x2*)(Qeff + cidx * 64 + rb) = w;
      w.x = pk_bf16(a2[4 * g], a2[4 * g + 1]); w.y = pk_bf16(a2[4 * g + 2], a2[4 * g + 3]);
      *(u32x2*)(Oloc + cidx * 64 + rb) = w;
      f32x4 av;
#pragma unroll
      for (int k = 0; k < 4; ++k) av[k] = ((rb + k) == cidx ? ebl : 0.f) - a3[4 * g + k];
      *(f32x4*)(Ac + cidx * 64 + rb) = av;
      w.x = pk_bf16(a4[4 * g], a4[4 * g + 1]); w.y = pk_bf16(a4[4 * g + 2], a4[4 * g + 3]);
      *(u32x2*)(BT + cidx * 64 + rb) = w;
    }
  }
  __syncthreads();
}

DI void gdn_scan_item(const Params& p, int b, int h, int es, unsigned char* lds, int tid) {
  const float* AcB = (const float*)(p.ws + OFF_AR + AR_ACD);
  bf16* BTB = (bf16*)(p.ws + OFF_AR + AR_BTD);
  const int lane = tid & 63, w = tid >> 6, g = lane >> 4, c16 = lane & 15;
  float* stl = (float*)lds;
  for (int i = tid; i < 2 * 16 * 68; i += 256) stl[i] = 0.f;
  __syncthreads();
  f32x4 cur = (f32x4){0.f, 0.f, 0.f, 0.f};
  f32x4 bq[4][4]; bf16 bt[4][4];
  const size_t ci0 = ((size_t)(b * 128) * 4 + h);
  const float* apb = AcB + ci0 * 4096 + (16 * w + c16) * 64 + 16 * g;
  bf16* btb = BTB + ci0 * 4096 + (es * 16 + 4 * g) * 64 + 16 * w + c16;
#pragma unroll
  for (int s4 = 0; s4 < 4; ++s4) {
#pragma unroll
    for (int k = 0; k < 4; ++k) bq[s4][k] = *(const f32x4*)(apb + (size_t)s4 * 4 * 4096 + 4 * k);
#pragma unroll
    for (int k = 0; k < 4; ++k) bt[s4][k] = btb[(size_t)s4 * 4 * 4096 + k * 64];
  }
  for (int c0 = 0; c0 < 128; c0 += 4) {
    const bool pf = (c0 + 4 < 128);
#pragma unroll
    for (int s4 = 0; s4 < 4; ++s4) {
      const int c = c0 + s4;
      const size_t co = (size_t)c * 4 * 4096;
#pragma unroll
      for (int k = 0; k < 4; ++k) btb[co + k * 64] = f2bf(cur[k]);
      const float* sc = stl + (s4 & 1) * 16 * 68;
      f32x4 aq[4];
#pragma unroll
      for (int k = 0; k < 4; ++k) aq[k] = *(const f32x4*)(sc + c16 * 68 + 16 * g + 4 * k);
      f32x4 acc[4];
      acc[0] = (f32x4){bf2f(bt[s4][0]), bf2f(bt[s4][1]), bf2f(bt[s4][2]), bf2f(bt[s4][3])};
      acc[1] = (f32x4){0.f, 0.f, 0.f, 0.f}; acc[2] = acc[1]; acc[3] = acc[1];
#pragma unroll
      for (int q = 0; q < 4; ++q)
#pragma unroll
        for (int k = 0; k < 4; ++k) acc[k] = __builtin_amdgcn_mfma_f32_16x16x4f32(aq[k][q], bq[s4][k][q], acc[k], 0, 0, 0);
      cur = (acc[0] + acc[1]) + (acc[2] + acc[3]);
      if (pf) {
#pragma unroll
        for (int k = 0; k < 4; ++k) bq[s4][k] = *(const f32x4*)(apb + co + (size_t)4 * 4 * 4096 + 4 * k);
#pragma unroll
        for (int k = 0; k < 4; ++k) bt[s4][k] = btb[co + (size_t)4 * 4 * 4096 + k * 64];
      }
      float* sn = stl + ((s4 + 1) & 1) * 16 * 68;
#pragma unroll
      for (int k = 0; k < 4; ++k) sn[(4 * g + k) * 68 + 16 * w + c16] = cur[k];
      __syncthreads();
    }
  }
}

DI void gdn_out_item(const Params& p, int l, int ci, unsigned char* lds, int tid) {
  const bf16* z = (const bf16*)(p.ws + OFF_AR + AR_Z);
  const bf16* ST = (const bf16*)(p.ws + OFF_AR + AR_BTD) + (size_t)ci * 4096;
  const bf16* Qeff = (const bf16*)(p.ws + OFF_AR + AR_QEFF) + (size_t)ci * 4096;
  const bf16* Oloc = (const bf16*)(p.ws + OFF_AR + AR_OLOC) + (size_t)ci * 4096;
  bf16* mix = (bf16*)(p.ws + OFF_AR + AR_MIX);
  const int h = ci & 3, t0 = (ci >> 2) * 64;
  float* obuf = (float*)lds;
  unsigned char* ql = lds + 17408;
  unsigned char* sl = ql + 9216;
  const u32x4* gpre = (const u32x4*)(z + (size_t)(t0 + (tid >> 2)) * ZLD + ZD_Z + h * 64 + (tid & 3) * 16);
  const u32x4 gq0 = gpre[0], gq1 = gpre[1];
  const u32x4* apre = (const u32x4*)(Oloc + (tid >> 2) * 64 + (tid & 3) * 16);
  const u32x4 aq0 = apre[0], aq1 = apre[1];
  f32x4 ngv[4];
#pragma unroll
  for (int k = 0; k < 4; ++k) ngv[k] = *(const f32x4*)(p.gdn_ng + l * 64 + (tid & 3) * 16 + 4 * k);
#pragma unroll
  for (int id = tid; id < 512; id += 256) {
    const int rr = id >> 3, ch = id & 7;
    *(u32x4*)(ql + rr * 144 + ch * 16) = *(const u32x4*)(Qeff + rr * 64 + ch * 8);
    *(u32x4*)(sl + rr * 144 + ch * 16) = *(const u32x4*)(ST + rr * 64 + ch * 8);
  }
  __syncthreads();
  const int lane = tid & 63, wv = tid >> 6, wm = wv & 1, wn = wv >> 1, r = lane & 31, hh = lane >> 5;
  {
    f32x16 acc = mm32(ql + wm * 32 * 144, 144, sl + wn * 32 * 144, 144, 4, zero16(), r, hh);
    const int e = wn * 32 + r;
#pragma unroll
    for (int g = 0; g < 4; ++g)
#pragma unroll
      for (int k = 0; k < 4; ++k) obuf[(wm * 32 + 8 * g + 4 * hh + k) * 68 + e] = acc[4 * g + k];
  }
  __syncthreads();
  norm_gate_store<false>(obuf, true, aq0, aq1, ngv, gq0, gq1, mix + (size_t)t0 * 1024 + 768 + h * 64, tid);
  __syncthreads();
}

DI void mla_proj_item(const Params& p, int l, int tile, unsigned char* lds, int tid) {
  const bf16* z = (const bf16*)(p.ws + OFF_AR + AR_Z);
  const bf16* Wl = (const bf16*)(p.ws + OFF_W) + (size_t)l * WL_E;
  const bf16* Wuq = Wl + WO_UQ;
  const bf16* Wukv = Wl + WO_UKV;
  bf16* Qg = (bf16*)(p.ws + OFF_AR + AR_Q);
  bf16* Kg = (bf16*)(p.ws + OFF_AR + AR_K);
  bf16* Vt = (bf16*)(p.ws + OFF_AR + AR_VT);
  const int t0 = tile * 64, b = t0 / S_, s0 = t0 % S_;
  unsigned char* Aq = lds;
  unsigned char* Akv = lds + 33792;
  float* rsq = (float*)(lds + 33792 + 17408);
  float* rskv = rsq + 64;
#pragma unroll
  for (int id = tid; id < 64 * 32; id += 256) { const int rr = id >> 5, ch = id & 31; *(u32x4*)(Aq + rr * 528 + ch * 16) = *(const u32x4*)(z + (size_t)(t0 + rr) * ZLD + ZC_Q + ch * 8); }
#pragma unroll
  for (int id = tid; id < 64 * 16; id += 256) { const int rr = id >> 4, ch = id & 15; *(u32x4*)(Akv + rr * 272 + ch * 16) = *(const u32x4*)(z + (size_t)(t0 + rr) * ZLD + ZC_KV + ch * 8); }
  bf16 kr1[4], kr2[4];
#pragma unroll
  for (int k = 0; k < 4; ++k) { const int id = tid + 256 * k, m = id >> 4, i2 = id & 15; kr1[k] = z[(size_t)(t0 + m) * ZLD + ZC_KR + i2]; kr2[k] = z[(size_t)(t0 + m) * ZLD + ZC_KR + 16 + i2]; }
  __syncthreads();
  {
    const int rr = tid >> 2, qd = tid & 3;
    float s1 = 0.f, s2 = 0.f;
#pragma unroll
    for (int k = 0; k < 8; ++k) { const u32x4 u = *(const u32x4*)(Aq + rr * 528 + qd * 128 + k * 16);
#pragma unroll
      for (int i = 0; i < 4; ++i) { const float a = bflo(u[i]), b = bfhi(u[i]); s1 += a * a + b * b; } }
#pragma unroll
    for (int k = 0; k < 4; ++k) { const u32x4 u = *(const u32x4*)(Akv + rr * 272 + qd * 64 + k * 16);
#pragma unroll
      for (int i = 0; i < 4; ++i) { const float a = bflo(u[i]), b = bfhi(u[i]); s2 += a * a + b * b; } }
    s1 += __shfl_xor(s1, 1); s1 += __shfl_xor(s1, 2); s2 += __shfl_xor(s2, 1); s2 += __shfl_xor(s2, 2);
    if (qd == 0) { rsq[rr] = rsqrtf(s1 * (1.f / 256.f) + EPS); rskv[rr] = rsqrtf(s2 * (1.f / 128.f) + EPS); }
#pragma unroll
    for (int id = tid; id < 1024; id += 256) {
      const int m = id >> 4, i = id & 15;
      const float inv = __builtin_amdgcn_exp2f(-(float)i * (13.287712379549449f / 16.f));
      const float ang = (float)(s0 + m) * inv;
      const double rev = (double)ang * 0.15915494309189535;
      const float fr = (float)(rev - floor(rev));
      const float sn = __builtin_amdgcn_sinf(fr), cs = __builtin_amdgcn_cosf(fr);
      const float x1 = bf2f(kr1[id >> 8]), x2 = bf2f(kr2[id >> 8]);
      const bf16 o1 = f2bf(x1 * cs - x2 * sn), o2 = f2bf(x2 * cs + x1 * sn);
      { bf16* krl = (bf16*)(lds + 51712); krl[m * 32 + i] = o1; krl[m * 32 + 16 + i] = o2; }
    }
  }
  __syncthreads();
  const int lane = tid & 63, hd = tid >> 6, r = lane & 31, hh = lane >> 5;
  const float QS = 0.10206207261596575f * 1.4426950408889634f;
  {
    f32x16 acc[3][2];
#pragma unroll
    for (int i = 0; i < 3; ++i) { acc[i][0] = zero16(); acc[i][1] = zero16(); }
#pragma unroll 8
    for (int kk = 0; kk < 16; ++kk) {
      bf16x8 af[2], bw[3];
#pragma unroll
      for (int mi = 0; mi < 2; ++mi) af[mi] = *(const bf16x8*)(Aq + (mi * 32 + r) * 528 + kk * 32 + hh * 16);
#pragma unroll
      for (int ni = 0; ni < 3; ++ni) bw[ni] = *(const bf16x8*)(Wuq + ((size_t)(((hd * 16 + kk) * 3 + ni) * 64 + lane)) * 8);
#pragma unroll
      for (int ni = 0; ni < 3; ++ni)
#pragma unroll
        for (int mi = 0; mi < 2; ++mi) acc[ni][mi] = MFMA32(bw[ni], af[mi], acc[ni][mi]);
    }
    __syncthreads();
    unsigned char* wbuf = lds + hd * 6400;
#pragma unroll
    for (int mi = 0; mi < 2; ++mi) {
      const int m = mi * 32 + r;
      const float sc = rsq[m] * QS;
      bf16* qp = (bf16*)(wbuf + r * 200);
#pragma unroll
      for (int ni = 0; ni < 2; ++ni)
#pragma unroll
        for (int g = 0; g < 4; ++g) {
          u32x2 w; w.x = pk_bf16(acc[ni][mi][4 * g] * sc, acc[ni][mi][4 * g + 1] * sc); w.y = pk_bf16(acc[ni][mi][4 * g + 2] * sc, acc[ni][mi][4 * g + 3] * sc);
          *(u32x2*)(qp + ni * 32 + 8 * g + 4 * hh) = w;
        }
#pragma unroll
      for (int g = 0; g < 2; ++g) {
        float o1[4], o2[4];
#pragma unroll
        for (int k = 0; k < 4; ++k) {
          const int i = 8 * g + 4 * hh + k;
          const float inv = __builtin_amdgcn_exp2f(-(float)i * (13.287712379549449f / 16.f));
          const float ang = (float)(s0 + m) * inv;
          const double rev = (double)ang * 0.15915494309189535;
          const float fr = (float)(rev - floor(rev));
          const float sn = __builtin_amdgcn_sinf(fr), cs = __builtin_amdgcn_cosf(fr);
          const float x1 = acc[2][mi][4 * g + k] * sc, x2 = acc[2][mi][4 * (g + 2) + k] * sc;
          o1[k] = x1 * cs - x2 * sn; o2[k] = x2 * cs + x1 * sn;
        }
        u32x2 w; w.x = pk_bf16(o1[0], o1[1]); w.y = pk_bf16(o1[2], o1[3]);
        *(u32x2*)(qp + 64 + 8 * g + 4 * hh) = w;
        w.x = pk_bf16(o2[0], o2[1]); w.y = pk_bf16(o2[2], o2[3]);
        *(u32x2*)(qp + 80 + 8 * g + 4 * hh) = w;
      }
#pragma unroll
      for (int k = 0; k < 6; ++k) {
        const int id = lane + 64 * k, row = id / 12, ch = id % 12;
        const u32x2 lo = *(const u32x2*)(wbuf + row * 200 + ch * 16), hi = *(const u32x2*)(wbuf + row * 200 + ch * 16 + 8);
        *(u32x4*)(Qg + ((size_t)(b * 4 + hd) * S_ + s0 + mi * 32 + row) * 96 + ch * 8) = (u32x4){lo.x, lo.y, hi.x, hi.y};
      }
    }
  }
  {
    f32x16 acc[2][2];
#pragma unroll
    for (int i = 0; i < 2; ++i) { acc[i][0] = zero16(); acc[i][1] = zero16(); }
#pragma unroll
    for (int kk = 0; kk < 8; ++kk) {
      bf16x8 af[2], bw[2];
#pragma unroll
      for (int mi = 0; mi < 2; ++mi) af[mi] = *(const bf16x8*)(Akv + (mi * 32 + r) * 272 + kk * 32 + hh * 16);
#pragma unroll
      for (int ni = 0; ni < 2; ++ni) bw[ni] = *(const bf16x8*)(Wukv + ((size_t)((((hd * 2 + 0) * 8 + kk) * 2 + ni) * 64 + lane)) * 8);
#pragma unroll
      for (int ni = 0; ni < 2; ++ni)
#pragma unroll
        for (int mi = 0; mi < 2; ++mi) acc[ni][mi] = MFMA32(bw[ni], af[mi], acc[ni][mi]);
    }
    unsigned char* wbuf = lds + hd * 6400;
    const unsigned char* krl = lds + 51712;
#pragma unroll
    for (int mi = 0; mi < 2; ++mi) {
      const int m = mi * 32 + r;
      const float sc = rskv[m];
      bf16* kp = (bf16*)(wbuf + r * 200);
#pragma unroll
      for (int ni = 0; ni < 2; ++ni)
#pragma unroll
        for (int g = 0; g < 4; ++g) {
          u32x2 w; w.x = pk_bf16(acc[ni][mi][4 * g] * sc, acc[ni][mi][4 * g + 1] * sc); w.y = pk_bf16(acc[ni][mi][4 * g + 2] * sc, acc[ni][mi][4 * g + 3] * sc);
          *(u32x2*)(kp + ni * 32 + 8 * g + 4 * hh) = w;
        }
#pragma unroll
      for (int k = 0; k < 6; ++k) {
        const int id = lane + 64 * k, row = id / 12, ch = id % 12;
        const unsigned char* src = (ch < 8) ? (wbuf + row * 200 + ch * 16) : (krl + (mi * 32 + row) * 64 + (ch - 8) * 16);
        const u32x2 lo = *(const u32x2*)src, hi = *(const u32x2*)(src + 8);
        *(u32x4*)(Kg + ((size_t)(b * 4 + hd) * S_ + s0 + mi * 32 + row) * 96 + ch * 8) = (u32x4){lo.x, lo.y, hi.x, hi.y};
      }
    }
  }
  {
    f32x16 acc[2][2];
#pragma unroll
    for (int i = 0; i < 2; ++i) { acc[i][0] = zero16(); acc[i][1] = zero16(); }
#pragma unroll
    for (int kk = 0; kk < 8; ++kk) {
      bf16x8 af[2], bw[2];
#pragma unroll
      for (int mi = 0; mi < 2; ++mi) af[mi] = *(const bf16x8*)(Akv + (mi * 32 + r) * 272 + kk * 32 + hh * 16);
#pragma unroll
      for (int ni = 0; ni < 2; ++ni) bw[ni] = *(const bf16x8*)(Wukv + ((size_t)((((hd * 2 + 1) * 8 + kk) * 2 + ni) * 64 + lane)) * 8);
#pragma unroll
      for (int mi = 0; mi < 2; ++mi)
#pragma unroll
        for (int ni = 0; ni < 2; ++ni) acc[mi][ni] = MFMA32(af[mi], bw[ni], acc[mi][ni]);
    }
#pragma unroll
    for (int ni = 0; ni < 2; ++ni) {
      unsigned char* wbuf = lds + hd * 6400;
      bf16* vp = (bf16*)(wbuf + r * 136);
#pragma unroll
      for (int mi = 0; mi < 2; ++mi)
#pragma unroll
        for (int g = 0; g < 4; ++g) {
          const int m = mi * 32 + 8 * g + 4 * hh;
          u32x2 w; w.x = pk_bf16(acc[mi][ni][4 * g] * rskv[m], acc[mi][ni][4 * g + 1] * rskv[m + 1]); w.y = pk_bf16(acc[mi][ni][4 * g + 2] * rskv[m + 2], acc[mi][ni][4 * g + 3] * rskv[m + 3]);
          *(u32x2*)(vp + m) = w;
        }
#pragma unroll
      for (int k = 0; k < 4; ++k) {
        const int id = lane + 64 * k, row = id >> 3, ch = id & 7;
        const u32x2 lo = *(const u32x2*)(wbuf + row * 136 + ch * 16), hi = *(const u32x2*)(wbuf + row * 136 + ch * 16 + 8);
        *(u32x4*)(Vt + ((size_t)(b * 4 + hd) * 64 + ni * 32 + row) * S_ + s0 + ch * 8) = (u32x4){lo.x, lo.y, hi.x, hi.y};
      }
    }
  }
  __syncthreads();
}

DI void attn_item(const Params& p, int bh, int qb, unsigned char* lds, int tid) {
  const bf16* Qg = (const bf16*)(p.ws + OFF_AR + AR_Q) + (size_t)bh * S_ * 96;
  const bf16* Kg = (const bf16*)(p.ws + OFF_AR + AR_K) + (size_t)bh * S_ * 96;
  const bf16* Vt = (const bf16*)(p.ws + OFF_AR + AR_VT) + (size_t)bh * 64 * S_;
  bf16* mix = (bf16*)(p.ws + OFF_AR + AR_MIX);
  const int lane = tid & 63, w = tid >> 6, r = lane & 31, hh = lane >> 5;
  const int q0 = qb * 128, qrow = q0 + 32 * w + r;
  const int ntiles = 2 * qb + 2;
  constexpr int STG = 64 * 208 + 64 * 144;
  bf16x8 qf[6];
#pragma unroll
  for (int kk = 0; kk < 6; ++kk) qf[kk] = *(const bf16x8*)(Qg + (size_t)qrow * 96 + kk * 16 + hh * 8);
  f32x16 ot[2] = {zero16(), zero16()};
  float mrun = -1e30f, lrun = 0.f;
  u32x4 rk[3], rv[2];
  int krow[3], kch[3];
#pragma unroll
  for (int i = 0; i < 3; ++i) { const int id = tid + 256 * i; krow[i] = id / 12; kch[i] = id % 12; }
  const int vrow0 = tid >> 3, vch = tid & 7;
#pragma unroll
  for (int i = 0; i < 3; ++i) rk[i] = *(const u32x4*)(Kg + (size_t)krow[i] * 96 + kch[i] * 8);
#pragma unroll
  for (int i = 0; i < 2; ++i) rv[i] = *(const u32x4*)(Vt + (size_t)(vrow0 + 32 * i) * S_ + vch * 8);
  __syncthreads();
#pragma unroll
  for (int i = 0; i < 3; ++i) *(u32x4*)(lds + krow[i] * 208 + kch[i] * 16) = rk[i];
#pragma unroll
  for (int i = 0; i < 2; ++i) *(u32x4*)(lds + 13312 + (vrow0 + 32 * i) * 144 + vch * 16) = rv[i];
  __syncthreads();
  for (int kt = 0; kt < ntiles; ++kt) {
    const unsigned char* Ks = lds + (kt & 1) * STG;
    const unsigned char* Vs = Ks + 13312;
    if (kt + 1 < ntiles) {
#pragma unroll
      for (int i = 0; i < 3; ++i) rk[i] = *(const u32x4*)(Kg + (size_t)((kt + 1) * 64 + krow[i]) * 96 + kch[i] * 8);
#pragma unroll
      for (int i = 0; i < 2; ++i) rv[i] = *(const u32x4*)(Vt + (size_t)(vrow0 + 32 * i) * S_ + (kt + 1) * 64 + vch * 8);
    }
    if (kt * 64 <= q0 + 32 * w + 31) {
      f32x16 st[2];
#pragma unroll
      for (int k2 = 0; k2 < 2; ++k2) {
        st[k2] = zero16();
#pragma unroll
        for (int kk = 0; kk < 6; ++kk) {
          bf16x8 kf = *(const bf16x8*)(Ks + (k2 * 32 + r) * 208 + kk * 32 + hh * 16);
          st[k2] = MFMA32(kf, qf[kk], st[k2]);
        }
      }
      if (kt * 64 + 63 > q0 + 32 * w) {
#pragma unroll
        for (int k2 = 0; k2 < 2; ++k2)
#pragma unroll
          for (int g = 0; g < 4; ++g)
#pragma unroll
            for (int k = 0; k < 4; ++k) {
              const int key = kt * 64 + k2 * 32 + 8 * g + 4 * hh + k;
              if (key > qrow) st[k2][4 * g + k] = -1e30f;
            }
      }
      float mt = st[0][0];
#pragma unroll
      for (int k2 = 0; k2 < 2; ++k2)
#pragma unroll
        for (int i = 0; i < 16; ++i) mt = fmaxf(mt, st[k2][i]);
      mt = fmaxf(mt, __shfl_xor(mt, 32));
      const float mnew = fmaxf(mrun, mt);
      const float alpha = __builtin_amdgcn_exp2f(mrun - mnew);
      mrun = mnew;
      float ls = 0.f;
#pragma unroll
      for (int k2 = 0; k2 < 2; ++k2)
#pragma unroll
        for (int i = 0; i < 16; ++i) { const float pv = __builtin_amdgcn_exp2f(st[k2][i] - mnew); st[k2][i] = pv; ls += pv; }
      lrun = lrun * alpha + ls;
      if (__any(alpha != 1.f)) {
#pragma unroll
        for (int dt = 0; dt < 2; ++dt)
#pragma unroll
          for (int i = 0; i < 16; ++i) ot[dt][i] *= alpha;
      }
#pragma unroll
      for (int k2 = 0; k2 < 2; ++k2)
#pragma unroll
        for (int s = 0; s < 2; ++s) {
          u32x4 pw;
          pw.x = pk_bf16(st[k2][8 * s], st[k2][8 * s + 1]); pw.y = pk_bf16(st[k2][8 * s + 2], st[k2][8 * s + 3]);
          pw.z = pk_bf16(st[k2][8 * s + 4], st[k2][8 * s + 5]); pw.w = pk_bf16(st[k2][8 * s + 6], st[k2][8 * s + 7]);
          const bf16x8 pf = __builtin_bit_cast(bf16x8, pw);
#pragma unroll
          for (int dt = 0; dt < 2; ++dt) {
            const unsigned char* vp = Vs + (dt * 32 + r) * 144 + (k2 * 32 + s * 16 + 4 * hh) * 2;
            u32x2 v0 = *(const u32x2*)vp, v1 = *(const u32x2*)(vp + 16);
            u32x4 vw = (u32x4){v0.x, v0.y, v1.x, v1.y};
            ot[dt] = MFMA32(__builtin_bit_cast(bf16x8, vw), pf, ot[dt]);
          }
        }
    }
    if (kt + 1 < ntiles) {
      unsigned char* Kw = lds + ((kt + 1) & 1) * STG;
#pragma unroll
      for (int i = 0; i < 3; ++i) *(u32x4*)(Kw + krow[i] * 208 + kch[i] * 16) = rk[i];
#pragma unroll
      for (int i = 0; i < 2; ++i) *(u32x4*)(Kw + 13312 + (vrow0 + 32 * i) * 144 + vch * 16) = rv[i];
    }
    __syncthreads();
  }
  const float lt = lrun + __shfl_xor(lrun, 32);
  const float inv = 1.f / lt;
  const int b = bh >> 2, hd = bh & 3;
  bf16* op = mix + ((size_t)b * S_ + qrow) * 1024 + 512 + hd * 64;
#pragma unroll
  for (int dt = 0; dt < 2; ++dt)
#pragma unroll
    for (int g = 0; g < 4; ++g) {
      u32x2 wv; wv.x = pk_bf16(ot[dt][4 * g] * inv, ot[dt][4 * g + 1] * inv); wv.y = pk_bf16(ot[dt][4 * g + 2] * inv, ot[dt][4 * g + 3] * inv);
      *(u32x2*)(op + dt * 32 + 8 * g + 4 * hh) = wv;
    }
}

DI void grid_bar(unsigned* flags, unsigned k) {
  asm volatile("s_waitcnt vmcnt(0) lgkmcnt(0)" ::: "memory");
  __syncthreads();
  if (threadIdx.x == 0) { __threadfence(); __hip_atomic_store(flags + blockIdx.x, k, __ATOMIC_RELAXED, __HIP_MEMORY_SCOPE_AGENT); }
  const unsigned nb = gridDim.x;
  for (;;) {
    int ok = 1;
    for (unsigned i = threadIdx.x; i < nb; i += blockDim.x) ok &= (__hip_atomic_load(flags + i, __ATOMIC_RELAXED, __HIP_MEMORY_SCOPE_AGENT) >= k) ? 1 : 0;
    if (__syncthreads_and(ok)) break;
    __builtin_amdgcn_s_sleep(1);
  }
  if (threadIdx.x == 0) __threadfence();
  __syncthreads();
}
__global__ void __launch_bounds__(512, 2) fwd_megakernel(Params p0) {
  extern __shared__ __attribute__((aligned(16))) unsigned char lds_all[];
  __shared__ int s_item;
  cg::grid_group grid = cg::this_grid();
  unsigned nbar = 0;
  const int nvb = gridDim.x * 2;
#define GBAR() do { nbar += 1; grid_bar((unsigned*)(p0.ws + OFF_CTL) + 256, nbar); } while (0)
#define PH_BEGIN() Params q = p0; { unsigned long long w_ = (unsigned long long)q.ws; asm volatile("" : "+s"(w_)); q.ws = (unsigned char*)w_; } int tid5 = threadIdx.x; asm volatile("" : "+v"(tid5)); const int tid = tid5 & 255, half = tid5 >> 8, vb = blockIdx.x * 2 + half; unsigned char* lds = lds_all + half * LDS_HALF; (void)vb; (void)lds; \
  unsigned char* ws = q.ws; bf16* W = (bf16*)(ws + OFF_W); float* rs = (float*)(ws + OFF_RS); bf16* zb = (bf16*)(ws + OFF_AR + AR_Z); bf16* yb = (bf16*)(ws + OFF_AR + AR_Y); \
  bf16* up = (bf16*)(ws + OFF_AR + AR_UP); bf16* mix = (bf16*)(ws + OFF_AR + AR_MIX); bf16* xb = mix; unsigned* ctl = (unsigned*)(ws + OFF_CTL); \
  const bf16* Wl = W + (size_t)l * WL_E; (void)rs; (void)zb; (void)yb; (void)up; (void)mix; (void)xb; (void)ctl; (void)Wl; (void)tid; (void)tid5;
  { const int l = 0; PH_BEGIN(); phase0(q, lds, tid, half); }
  { const int l = 0; PH_BEGIN(); resid_phase(q.x, nullptr, nullptr, nullptr, nullptr, xb, rs, tid, vb, nvb); }
  if (p0.ws == nullptr) grid.sync();
  GBAR();

  for (int l = 0; l < 2; ++l) {
    { PH_BEGIN(); EpiStore e{zb, zb, 1 << 30, ZLD, rs, nullptr}; gemm_phase<false>(l == 0 ? xb : (const bf16*)q.out, 1024, Wl + WO_IN, 1024, 1024, 128, 13, e, lds_all, tid5); }
    GBAR();
    for (int pi = blockIdx.x; pi < (2048 * 3 + 512) / 2; pi += gridDim.x) {
      PH_BEGIN();
      const int it = 2 * pi + half;
      if (it < 2048) gdn_local_item(q, l, it, lds, tid);
      else if (it < 4096) gla_local_item<64, true>(q, l, it - 2048, lds, tid);
      else if (it < 6144) gla_local_item<32, false>(q, l, it - 4096, lds, tid);
      else mla_proj_item(q, l, it - 6144, lds, tid);
    }
    GBAR();
    for (;;) {
      PH_BEGIN();
      if (tid5 == 0) s_item = (int)atomicAdd(&ctl[l], 1u);
      __syncthreads();
      const int pit = s_item;
      __syncthreads();
      if (pit >= 80 + 512) break;
      if (pit < 32) { const int it = 2 * pit + half; gdn_scan_item(q, it >> 4, (it >> 2) & 3, it & 3, lds, tid); }
      else if (pit < 64) { const int j = 2 * (pit - 32) + half; gla_scan_item<64>((bf16*)(ws + OFF_AR + AR_UTA), (const float*)(ws + OFF_GA), j >> 4, (j >> 2) & 3, j & 3, tid); }
      else if (pit < 80) { const int j = 2 * (pit - 64) + half; gla_scan_item<32>((bf16*)(ws + OFF_AR + AR_UTB), (const float*)(ws + OFF_GB), j >> 3, (j >> 1) & 3, j & 1, tid); }
      else { const int a = pit - 80; attn_item(q, 2 * (a & 7) + half, 63 - (a >> 3), lds, tid); }
    }
    GBAR();
    for (int pi = blockIdx.x; pi < 2048 * 3 / 2; pi += gridDim.x) {
      PH_BEGIN();
      const int it = 2 * pi + half;
      if (it < 2048) gdn_out_item(q, l, it, lds, tid);
      else if (it < 4096) gla_out_item<64, true>(q, l, it - 2048, lds, tid);
      else gla_out_item<32, false>(q, l, it - 4096, lds, tid);
    }
    GBAR();
    { PH_BEGIN(); EpiStore e{yb, yb, 1 << 30, 1024, nullptr, nullptr}; gemm_phase<false>(mix, 1024, Wl + WO_OUT, 1024, 1024, 128, 4, e, lds_all, tid5); }
    GBAR();
    { PH_BEGIN(); resid_phase(l == 0 ? q.x : nullptr, (const bf16*)q.out, yb, q.post_mix_g + l * 1024, nullptr, xb, rs, tid, vb, nvb); }
    GBAR();
    { PH_BEGIN(); EpiStore e{up, up, 1 << 30, FF, rs, q.ffn_conv + (size_t)l * 3 * FF}; gemm_phase<true>(xb, 1024, Wl + WO_GU, 1024, 1024, 136, 22, e, lds_all, tid5); }
    GBAR();
    { PH_BEGIN(); EpiStore e{yb, yb, 1 << 30, 1024, nullptr, nullptr}; gemm_phase<false>(up, FF, Wl + WO_DN, FF, FF, 128, 4, e, lds_all, tid5); }
    GBAR();
    { PH_BEGIN(); resid_phase(nullptr, xb, yb, q.post_ffn_g + l * 1024, l == 1 ? q.out : nullptr, l == 1 ? nullptr : (bf16*)q.out, rs, tid, vb, nvb); }
    GBAR();
  }
}

extern "C" void kernel_launch(void* const* d_in, const int* in_sizes, int n_in, void* d_out, int out_size, void* d_ws, size_t ws_size, hipStream_t stream) {
  static int grid_blocks = 0;
  if (!grid_blocks) {
    int dev = 0, cus = 0, per_cu = 0;
    hipGetDevice(&dev);
    hipDeviceGetAttribute(&cus, hipDeviceAttributeMultiprocessorCount, dev);
    hipFuncSetAttribute((const void*)fwd_megakernel, hipFuncAttributeMaxDynamicSharedMemorySize, LDS_BYTES);
    hipOccupancyMaxActiveBlocksPerMultiprocessor(&per_cu, (const void*)fwd_megakernel, 512, LDS_BYTES);
    if (per_cu < 1) per_cu = 1;
    if (per_cu > 1) per_cu = 1;
    grid_blocks = cus * per_cu;
    if (ws_size < WS_END) fprintf(stderr, "kernel_launch: workspace too small: %zu < %zu\n", ws_size, (size_t)WS_END);
  }
  Params p{};
  const float** pp = (const float**)&p;
  for (int i = 0; i < 24; ++i) pp[i] = (const float*)d_in[i];
  p.out = (float*)d_out; p.ws = (unsigned char*)d_ws;
  hipMemsetAsync((unsigned char*)d_ws + OFF_CTL, 0, 8192, stream);
  void* args[] = {&p};
  hipError_t e = hipLaunchCooperativeKernel((const void*)fwd_megakernel, dim3(grid_blocks), dim3(512), args, LDS_BYTES, stream);
  if (e != hipSuccess) fprintf(stderr, "cooperative launch failed: %s (grid %d)\n", hipGetErrorString(e), grid_blocks);
}
```

```cpp
#include <hip/hip_runtime.h>
#include <hip/hip_cooperative_groups.h>
#include <cstdio>
#include <cstdint>
namespace cg = cooperative_groups;

#define DI __device__ __forceinline__
typedef unsigned short bf16;
typedef __attribute__((ext_vector_type(8))) short bf16x8;
typedef __attribute__((ext_vector_type(4))) short bf16x4;
typedef __attribute__((ext_vector_type(16))) float f32x16;
typedef __attribute__((ext_vector_type(4))) float f32x4;
typedef __attribute__((ext_vector_type(4))) unsigned u32x4;
typedef __attribute__((ext_vector_type(2))) unsigned u32x2;

constexpr int T_ = 32768, S_ = 8192, D_ = 1024, ZLD = 3328, FF = 2816, DIN = 3256;
constexpr float EPS = 1e-6f;
constexpr int ZA_Q = 0, ZA_F = 256, ZA_I = 512, ZA_G = 768, ZB_Q = 1024, ZB_K = 1152, ZB_V = 1280, ZB_G = 1536, ZC_Q = 1792, ZC_KV = 2048,
              ZD_Q = 2176, ZD_K = 2432, ZD_V = 2688, ZD_Z = 2944, ZC_KR = 3200, ZB_CODE = 3232, ZD_BETA = 3248, ZD_A = 3252;
constexpr size_t WIN_E = (size_t)ZLD * 1024, WOUT_E = 1024 * 1024, WGU_E = (size_t)2 * FF * 1024, WDN_E = (size_t)1024 * FF, WUQ_E = 384 * 256, WUKV_E = 512 * 128;
constexpr size_t WO_IN = 0, WO_OUT = WO_IN + WIN_E, WO_GU = WO_OUT + WOUT_E, WO_DN = WO_GU + WGU_E, WO_UQ = WO_DN + WDN_E, WO_UKV = WO_UQ + WUQ_E, WL_E = WO_UKV + WUKV_E;
constexpr size_t OFF_W = 0;
constexpr size_t OFF_CTL = OFF_W + 2 * WL_E * 2;
constexpr size_t OFF_RS = OFF_CTL + 8192;
constexpr size_t OFF_GA = OFF_RS + (size_t)T_ * 4;
constexpr size_t OFF_GB = OFF_GA + (size_t)2048 * 64 * 4;
constexpr size_t OFF_AR = OFF_GB + (size_t)2048 * 32 * 4;
constexpr size_t AR_Z = 0, AR_Y = 0, AR_GATE = 0, AR_UP = (size_t)T_ * FF * 2;
constexpr size_t AR_SCAN = (size_t)T_ * ZLD * 2;
constexpr size_t AR_UTA = AR_SCAN, AR_UTB = AR_UTA + (size_t)2048 * 64 * 64 * 2, AR_ACD = AR_UTB + (size_t)2048 * 64 * 32 * 2, AR_BTD = AR_ACD + (size_t)2048 * 4096 * 4,
                 AR_QEFF = AR_BTD + (size_t)2048 * 4096 * 2, AR_OLOC = AR_QEFF + (size_t)2048 * 4096 * 2, AR_MLA = AR_OLOC + (size_t)2048 * 4096 * 2;
constexpr size_t AR_Q = AR_MLA, AR_K = AR_Q + (size_t)T_ * 4 * 96 * 2, AR_VT = AR_K + (size_t)T_ * 4 * 96 * 2, AR_MIX = AR_VT + (size_t)T_ * 4 * 64 * 2;
constexpr size_t AR_END = AR_MIX + (size_t)T_ * 1024 * 2;
constexpr size_t WS_END = OFF_AR + AR_END;
static_assert(WS_END <= (size_t)512 * 1024 * 1024, "workspace too large");
static_assert(AR_UP + (size_t)T_ * FF * 2 <= AR_MIX, "gate/up overlaps xb");

constexpr size_t BC_OFF = (size_t)T_ * 1024 * 2, BC_B_OFF = (size_t)2048 * 64 * 64 * 4;
static_assert(BC_OFF + BC_B_OFF + (size_t)2048 * 64 * 32 * 4 <= (size_t)T_ * 1024 * 4, "decay tables exceed the output buffer");
constexpr int LDS_HALF = 73728, LDS_BYTES = 2 * LDS_HALF;
#ifndef PROBE_DUP
#define PROBE_DUP 0
#endif

struct Params {
  const float* x; const float* w_in; const float* w_out; const float* pre_mix_g; const float* post_mix_g; const float* pre_ffn_g; const float* post_ffn_g;
  const float* hgrn_lb; const float* hgrn_ng; const float* gla_w2; const float* gla_b; const float* gla_ng;
  const float* mla_qg; const float* mla_wuq; const float* mla_kvg; const float* mla_wukv;
  const float* gdn_conv; const float* gdn_alog; const float* gdn_dtb; const float* gdn_ng;
  const float* ffn_wg; const float* ffn_wu; const float* ffn_conv; const float* ffn_wd;
  float* out; unsigned char* ws;
};

typedef __bf16 bf16v2_t __attribute__((ext_vector_type(2)));
typedef float f32v2_t __attribute__((ext_vector_type(2)));
DI unsigned pk_bf16(float lo, float hi) { f32v2_t v = {lo, hi}; bf16v2_t b = __builtin_convertvector(v, bf16v2_t); return __builtin_bit_cast(unsigned, b); }
DI float bf2f(bf16 v) { return __uint_as_float(((unsigned)v) << 16); }
DI bf16 f2bf(float x) { return (bf16)(pk_bf16(x, 0.f) & 0xffffu); }
DI float bflo(unsigned u) { return __uint_as_float(u << 16); }
DI float bfhi(unsigned u) { return __uint_as_float(u & 0xffff0000u); }
DI float sigmoidf_(float x) { return 1.f / (1.f + __expf(-x)); }
DI float siluf_(float x) { return x * sigmoidf_(x); }
DI float softplusf_(float x) { return fmaxf(x, 0.f) + __logf(1.f + __expf(-fabsf(x))); }
DI float wave_sum(float v) {
#pragma unroll
  for (int o = 1; o < 64; o <<= 1) v += __shfl_xor(v, o);
  return v;
}
#define MFMA32(a, b, c) __builtin_amdgcn_mfma_f32_32x32x16_bf16((a), (b), (c), 0, 0, 0)

DI f32x16 mm32(const unsigned char* A, int lda, const unsigned char* B, int ldb, int ks, f32x16 acc, int r, int h) {
  const unsigned char* pa = A + r * lda + h * 16;
  const unsigned char* pb = B + r * ldb + h * 16;
  for (int kk = 0; kk < ks; ++kk) {
    bf16x8 a = *(const bf16x8*)(pa + kk * 32);
    bf16x8 b = *(const bf16x8*)(pb + kk * 32);
    acc = MFMA32(a, b, acc);
  }
  return acc;
}
DI f32x16 zero16() { f32x16 z; for (int i = 0; i < 16; ++i) z[i] = 0.f; return z; }

DI int win_srccol(int n) {
  if (n < 1536) return n;
  if (n < 1792) return 1552 + (n - 1536);
  if (n < 2048) return 1808 + (n - 1792);
  if (n < 2176) return 2064 + (n - 2048);
  if (n < 2432) return 2224 + (n - 2176);
  if (n < 2688) return 2480 + (n - 2432);
  if (n < 2944) return 2736 + (n - 2688);
  if (n < 3200) return 3000 + (n - 2944);
  if (n < 3232) return 2192 + (n - 3200);
  if (n < 3248) return 1536 + (n - 3232);
  if (n < 3252) return 2992 + (n - 3248);
  if (n < 3256) return 2996 + (n - 3252);
  return -1;
}
DI int gu_rowmap(int c, int mode) { return mode == 0 ? c : ((c >> 7) * 256 + (c & 127) + (mode == 2 ? 128 : 0)); }
DI void transpose_tile(const float* __restrict__ src, int ldsrc, int K, bool perm, const float* __restrict__ gain, bf16* __restrict__ dst, int n0, int k0, unsigned char* lds, int tid, int rowmode = 0) {
  bf16* t = (bf16*)lds;
  const int nl = tid & 63, kq = tid >> 6;
  const int sc = perm ? win_srccol(n0 + nl) : (n0 + nl);
  float tv[16];
#pragma unroll
  for (int i = 0; i < 16; ++i) {
    const int k = k0 + kq + 4 * i;
    float v = 0.f;
    if (sc >= 0) { v = src[(size_t)k * ldsrc + sc]; if (gain) v *= gain[k]; }
    tv[i] = v;
  }
#pragma unroll
  for (int i = 0; i < 16; ++i) t[nl * 72 + kq + 4 * i] = f2bf(tv[i]);
  __syncthreads();
  const int r = tid >> 2, c = (tid & 3) * 16;
  u32x4 a = *(const u32x4*)(t + r * 72 + c), b = *(const u32x4*)(t + r * 72 + c + 8);
  bf16* o = dst + (size_t)gu_rowmap(n0 + r, rowmode) * K + k0 + c;
  *(u32x4*)o = a; *(u32x4*)(o + 8) = b;
  __syncthreads();
}

DI void frag_tile(const float* __restrict__ src, int ldsrc, bool isq, const float* __restrict__ gain, bf16* __restrict__ dst, int n0, int k0, int tid) {
  const int n = n0 + (tid & 63), kq = tid >> 6;
#pragma unroll
  for (int gi = 0; gi < 2; ++gi) {
    const int kg = k0 + (kq * 2 + gi) * 8;
    float v[8];
#pragma unroll
    for (int j = 0; j < 8; ++j) v[j] = src[(size_t)(kg + j) * ldsrc + n] * gain[kg + j];
    const int kk = kg >> 4, hh = (kg >> 3) & 1, r = n & 31;
    size_t off;
    if (isq) { const int hd = n / 96, nl = n % 96; off = ((size_t)(((hd * 16 + kk) * 3 + (nl >> 5)) * 64 + hh * 32 + r)) * 8; }
    else { const int hd = n >> 7, nl = n & 127; off = ((size_t)((((hd * 2 + (nl >> 6)) * 8 + kk) * 2 + ((nl >> 5) & 1)) * 64 + hh * 32 + r)) * 8; }
    u32x4 w; w.x = pk_bf16(v[0], v[1]); w.y = pk_bf16(v[2], v[3]); w.z = pk_bf16(v[4], v[5]); w.w = pk_bf16(v[6], v[7]);
    *(u32x4*)(dst + off) = w;
  }
  __syncthreads();
  __syncthreads();
}
DI void phase0(const Params& p, unsigned char* lds, int tid, int half) {
  bf16* W = (bf16*)(p.ws + OFF_W);
  constexpr int NT_L = 832 + 256 + 704 + 704 + 704 + 24 + 16;
  for (int pi = blockIdx.x; pi < NT_L; pi += gridDim.x) {
    const int it = 2 * pi + half;
    const int l = it / NT_L; int r = it % NT_L;
    bf16* Wl = W + (size_t)l * WL_E;
    if (r < 832) { transpose_tile(p.w_in + (size_t)l * 1024 * DIN, DIN, 1024, true, p.pre_mix_g + l * 1024, Wl + WO_IN, (r / 16) * 64, (r % 16) * 64, lds, tid); continue; } r -= 832;
    if (r < 256) { transpose_tile(p.w_out + (size_t)l * 1024 * 1024, 1024, 1024, false, nullptr, Wl + WO_OUT, (r / 16) * 64, (r % 16) * 64, lds, tid); continue; } r -= 256;
    if (r < 704) { transpose_tile(p.ffn_wg + (size_t)l * 1024 * FF, FF, 1024, false, p.pre_ffn_g + l * 1024, Wl + WO_GU, (r / 16) * 64, (r % 16) * 64, lds, tid, 1); continue; } r -= 704;
    if (r < 704) { transpose_tile(p.ffn_wu + (size_t)l * 1024 * FF, FF, 1024, false, p.pre_ffn_g + l * 1024, Wl + WO_GU, (r / 16) * 64, (r % 16) * 64, lds, tid, 2); continue; } r -= 704;
    if (r < 704) { transpose_tile(p.ffn_wd + (size_t)l * FF * 1024, 1024, FF, false, nullptr, Wl + WO_DN, (r / 44) * 64, (r % 44) * 64, lds, tid); continue; } r -= 704;
    if (r < 24) { frag_tile(p.mla_wuq + (size_t)l * 256 * 384, 384, true, p.mla_qg + l * 256, Wl + WO_UQ, (r / 4) * 64, (r % 4) * 64, tid); continue; } r -= 24;
    frag_tile(p.mla_wukv + (size_t)l * 128 * 512, 512, false, p.mla_kvg + l * 128, Wl + WO_UKV, (r / 2) * 64, (r % 2) * 64, tid);
  }
}

DI void resid_phase(const float* __restrict__ xin, const bf16* __restrict__ xinb, const bf16* __restrict__ y, const float* __restrict__ g, float* __restrict__ xout, bf16* __restrict__ xb, float* __restrict__ rs, int tid, int vb, int nvb) {
  const int lane = tid & 63, wv = tid >> 6;
  const int stride = nvb * 4;
  for (int row0 = vb * 4 + wv; row0 < T_; row0 += 2 * stride) {
    f32x4 v[2][4]; u32x2 yu[2][4];
#pragma unroll
    for (int q = 0; q < 2; ++q) {
      const int row = min(row0 + q * stride, T_ - 1);
      if (xin) {
#pragma unroll
        for (int j = 0; j < 4; ++j) v[q][j] = *(const f32x4*)(xin + (size_t)row * 1024 + lane * 4 + 256 * j);
      } else {
#pragma unroll
        for (int j = 0; j < 4; ++j) { const u32x2 u = *(const u32x2*)(xinb + (size_t)row * 1024 + lane * 4 + 256 * j); v[q][j] = (f32x4){bflo(u.x), bfhi(u.x), bflo(u.y), bfhi(u.y)}; }
      }
      if (y) {
#pragma unroll
        for (int j = 0; j < 4; ++j) yu[q][j] = *(const u32x2*)(y + (size_t)row * 1024 + lane * 4 + 256 * j);
      }
    }
#pragma unroll
    for (int q = 0; q < 2; ++q) {
      const int row = row0 + q * stride;
      if (y) {
        f32x4 yv[4]; float ss = 0.f;
#pragma unroll
        for (int j = 0; j < 4; ++j) {
          yv[j] = (f32x4){bflo(yu[q][j].x), bfhi(yu[q][j].x), bflo(yu[q][j].y), bfhi(yu[q][j].y)};
          ss += yv[j].x * yv[j].x + yv[j].y * yv[j].y + yv[j].z * yv[j].z + yv[j].w * yv[j].w;
        }
        const float ry = rsqrtf(wave_sum(ss) * (1.f / 1024.f) + EPS);
#pragma unroll
        for (int j = 0; j < 4; ++j) { f32x4 gg = *(const f32x4*)(g + lane * 4 + 256 * j); v[q][j] = v[q][j] + yv[j] * ry * gg; }
      }
      float sx = 0.f;
#pragma unroll
      for (int j = 0; j < 4; ++j) sx += v[q][j].x * v[q][j].x + v[q][j].y * v[q][j].y + v[q][j].z * v[q][j].z + v[q][j].w * v[q][j].w;
      sx = wave_sum(sx);
      if (row < T_) {
#pragma unroll
        for (int j = 0; j < 4; ++j) {
          if (xout) *(f32x4*)(xout + (size_t)row * 1024 + lane * 4 + 256 * j) = v[q][j];
          if (xb) {
            u32x2 o; o.x = pk_bf16(v[q][j].x, v[q][j].y); o.y = pk_bf16(v[q][j].z, v[q][j].w);
            *(u32x2*)(xb + (size_t)row * 1024 + lane * 4 + 256 * j) = o;
          }
        }
        if (xb && lane == 0) rs[row] = rsqrtf(sx * (1.f / 1024.f) + EPS);
      }
    }
  }
}

DI float gelu_tanh(float x) {
  const float u = 0.7978845608028654f * (x + 0.044715f * x * x * x);
  const float e = __expf(2.f * u);
  const float th = 1.f - 2.f / (e + 1.f);
  return 0.5f * x * (1.f + th);
}
struct EpiStore {
  bf16* out0; bf16* out1; int split; int ldc; const float* rs; const float* cw;
  DI void store4(int m, int n, f32x4 v) const {
    bf16* o = out0; if (n >= split) { o = out1; n -= split; }
    u32x2 w; w.x = pk_bf16(v.x, v.y); w.y = pk_bf16(v.z, v.w);
    *(u32x2*)(o + (size_t)m * ldc + n) = w;
  }
};

#define GL_LAS __attribute__((address_space(3)))
DI int g8_lds_byte(int r, int c) { const int st = (r >> 4) * 2 + (c >> 5), rr = r & 15, cc = c & 31, ob = rr * 64 + cc * 2; return st * 1024 + (ob ^ (((ob >> 9) & 1) << 5)); }
DI void g8_stage_rc(int b, int& R, int& C) { const int st = b / 1024, sb = b % 1024, swz = sb ^ (((sb >> 9) & 1) << 5); R = (st >> 1) * 16 + swz / 64; C = (st & 1) * 32 + (swz % 64) / 2; }
template <bool ACT>
DI void gemm_phase(const bf16* __restrict__ A, int lda, const bf16* __restrict__ Bt, int ldb, int K, int MT, int NT, const EpiStore& epi, unsigned char* lds, int tid) {
  constexpr int HTB = 128 * 64 * 2;
  const int nt_k = K / 64;
  const int xcd = blockIdx.x & 7, jb = blockIdx.x >> 3, nbx = (gridDim.x + 7 - xcd) >> 3;
  const int band = MT / 8, per_x = band * NT;
  for (int lt = jb; lt < per_x; lt += nbx) {
    const int mg = lt / (8 * NT), rem = lt % (8 * NT), gs = min(8, band - 8 * mg);
    const int mt = xcd * band + mg * 8 + rem % gs, nt = rem / gs, n0 = nt * 256;
    int m0 = mt * 256, seq0 = 0;
    if (ACT) { const int bs = mt / 34, ti = mt % 34; if (ti == 33) continue; seq0 = bs * S_; m0 = seq0 + 254 * ti - 2; }
    __syncthreads();
    asm volatile("" : "+v"(tid));
    const int wid = tid >> 6, lane = tid & 63, wr = wid >> 2, wc = wid & 3, fr = lane & 15, fq = lane >> 4;
    const int obs = (fr * 64 + fq * 16) ^ ((((fr * 64 + fq * 16) >> 9) & 1) << 5);
    const int a_rd = obs + wr * 8192, b_rd = obs + wc * 4096;
#define SA8(b, h) (lds + ((b) * 2 + (h)) * HTB)
#define SB8(b, h) (lds + (4 + (b) * 2 + (h)) * HTB)
    unsigned aofs[2][2], bofs[2];
#pragma unroll
    for (int i = 0; i < 2; ++i) {
      int sr_, sc_; g8_stage_rc(tid * 16 + i * 8192, sr_, sc_);
      bofs[i] = ((unsigned)(n0 + sr_) * (unsigned)ldb + (unsigned)sc_) * 2u;
#pragma unroll
      for (int hf = 0; hf < 2; ++hf) {
        int row = m0 + sr_ + (ACT ? hf * 128 : 0); if (ACT) row = min(max(row, seq0), seq0 + S_ - 1);
        aofs[hf][i] = ((unsigned)row * (unsigned)lda + (unsigned)sc_) * 2u;
      }
    }
#define STAGE_A(P, half_, kt) do { const unsigned char* ub_ = (const unsigned char*)A + (size_t)(kt) * 128 + (ACT ? (size_t)0 : (size_t)(half_) * 256 * (size_t)lda); _Pragma("unroll") for (int _i = 0; _i < 2; ++_i) \
      __builtin_amdgcn_global_load_lds((const unsigned*)(ub_ + aofs[half_][_i]), (GL_LAS unsigned*)((P) + tid * 16 + _i * 8192), 16, 0, 0); } while (0)
#define STAGE_B(P, half_, kt) do { const unsigned char* ub_ = (const unsigned char*)Bt + (size_t)(kt) * 128 + (size_t)(half_) * 256 * (size_t)ldb; _Pragma("unroll") for (int _i = 0; _i < 2; ++_i) \
      __builtin_amdgcn_global_load_lds((const unsigned*)(ub_ + bofs[_i]), (GL_LAS unsigned*)((P) + tid * 16 + _i * 8192), 16, 0, 0); } while (0)
#define LDA8(dst, b, h) _Pragma("unroll") for (int m = 0; m < 4; ++m) _Pragma("unroll") for (int k = 0; k < 2; ++k) \
      dst[m][k] = *(const bf16x8*)(SA8(b, h) + a_rd + m * 2048 + k * 1024)
#define LDB8(dst, b, h) _Pragma("unroll") for (int n = 0; n < 2; ++n) _Pragma("unroll") for (int k = 0; k < 2; ++k) \
      dst[n][k] = *(const bf16x8*)(SB8(b, h) + b_rd + n * 2048 + k * 1024)
#define MMA8(ai, bj, At_, Bt_) do { __builtin_amdgcn_s_setprio(1); \
      _Pragma("unroll") for (int m = 0; m < 4; ++m) _Pragma("unroll") for (int n = 0; n < 2; ++n) _Pragma("unroll") for (int k = 0; k < 2; ++k) \
        acc[ai][bj][m][n] = __builtin_amdgcn_mfma_f32_16x16x32_bf16(Bt_[n][k], At_[m][k], acc[ai][bj][m][n], 0, 0, 0); \
      __builtin_amdgcn_s_setprio(0); } while (0)
#define WAIT_V(n) asm volatile("s_waitcnt vmcnt(" #n ")" ::: "memory")
#define WAIT_L(n) asm volatile("s_waitcnt lgkmcnt(" #n ")" ::: "memory")
#define BAR8 __builtin_amdgcn_s_barrier()
#define SCHED8 __builtin_amdgcn_sched_barrier(0)
    f32x4 acc[2][2][4][2];
#pragma unroll
    for (int i0 = 0; i0 < 2; ++i0)
#pragma unroll
      for (int i1 = 0; i1 < 2; ++i1)
#pragma unroll
        for (int i2 = 0; i2 < 4; ++i2)
#pragma unroll
          for (int i3 = 0; i3 < 2; ++i3) acc[i0][i1][i2][i3] = (f32x4){0.f, 0.f, 0.f, 0.f};
    bf16x8 At[4][2], B0[2][2], B1[2][2];
    STAGE_B(SB8(0, 0), 0, 0); STAGE_A(SA8(0, 0), 0, 0);
    STAGE_B(SB8(0, 1), 1, 0); STAGE_A(SA8(0, 1), 1, 0);
    if (wr == 1) BAR8;
    WAIT_V(4); BAR8;
    STAGE_B(SB8(1, 0), 0, 1); STAGE_A(SA8(1, 0), 0, 1); STAGE_B(SB8(1, 1), 1, 1);
    WAIT_V(6); BAR8;
    for (int t = 0; t < nt_k - 2; t += 2) {
      LDB8(B0, 0, 0); SCHED8; LDA8(At, 0, 0); STAGE_A(SA8(1, 1), 1, t + 1);
      WAIT_L(8); BAR8; WAIT_L(0); MMA8(0, 0, At, B0); BAR8; SCHED8;
      LDB8(B1, 0, 1); STAGE_B(SB8(0, 0), 0, t + 2);
      BAR8; WAIT_L(0); MMA8(0, 1, At, B1); BAR8;
      LDA8(At, 0, 1); STAGE_A(SA8(0, 0), 0, t + 2);
      BAR8; WAIT_L(0); MMA8(1, 0, At, B0); BAR8; SCHED8;
      STAGE_B(SB8(0, 1), 1, t + 2);
      WAIT_V(6); BAR8; MMA8(1, 1, At, B1); BAR8;
      LDB8(B0, 1, 0); SCHED8; LDA8(At, 1, 0); STAGE_A(SA8(0, 1), 1, t + 2);
      WAIT_L(8); BAR8; WAIT_L(0); MMA8(0, 0, At, B0); BAR8; SCHED8;
      LDB8(B1, 1, 1); STAGE_B(SB8(1, 0), 0, t + 3);
      BAR8; WAIT_L(0); MMA8(0, 1, At, B1); BAR8;
      LDA8(At, 1, 1); STAGE_A(SA8(1, 0), 0, t + 3);
      BAR8; WAIT_L(0); MMA8(1, 0, At, B0); BAR8; SCHED8;
      STAGE_B(SB8(1, 1), 1, t + 3);
      WAIT_V(6); BAR8; MMA8(1, 1, At, B1); BAR8;
    }
    { LDB8(B0, 0, 0); LDA8(At, 0, 0); STAGE_A(SA8(1, 1), 1, nt_k - 1);
      BAR8; WAIT_L(0); MMA8(0, 0, At, B0); BAR8;
      LDB8(B1, 0, 1); BAR8; WAIT_L(0); MMA8(0, 1, At, B1); BAR8;
      LDA8(At, 0, 1); WAIT_V(4); BAR8; WAIT_L(0); MMA8(1, 0, At, B0); MMA8(1, 1, At, B1); BAR8; }
    { LDB8(B0, 1, 0); LDA8(At, 1, 0); WAIT_V(2); BAR8; WAIT_L(0); MMA8(0, 0, At, B0); BAR8;
      LDB8(B1, 1, 1); WAIT_V(0); BAR8; WAIT_L(0); MMA8(0, 1, At, B1); BAR8;
      LDA8(At, 1, 1); BAR8; WAIT_L(0); MMA8(1, 0, At, B0); MMA8(1, 1, At, B1); BAR8; }
    if (wr == 0) BAR8;
    __syncthreads();
    int tid_e = tid; asm volatile("" : "+v"(tid_e));
    const int e_wid = tid_e >> 6, e_lane = tid_e & 63, e_wr = e_wid >> 2, e_wc = e_wid & 3, e_fr = e_lane & 15, e_fq = e_lane >> 4;
    if (!ACT) {
#pragma unroll
      for (int ai = 0; ai < 2; ++ai)
#pragma unroll
        for (int m = 0; m < 4; ++m) {
          const int ml = ai * 128 + e_wr * 64 + m * 16 + e_fr;
          const float sc = epi.rs ? epi.rs[m0 + ml] : 1.f;
#pragma unroll
          for (int bj = 0; bj < 2; ++bj)
#pragma unroll
            for (int n = 0; n < 2; ++n) {
              const f32x4 v = acc[ai][bj][m][n] * sc;
              u32x2 w2; w2.x = pk_bf16(v[0], v[1]); w2.y = pk_bf16(v[2], v[3]);
              *(u32x2*)(lds + ml * 520 + (bj * 128 + e_wc * 32 + n * 16 + e_fq * 4) * 2) = w2;
            }
        }
      __syncthreads();
#pragma unroll 2
      for (int k = 0; k < 16; ++k) {
        const int id = tid_e + 512 * k, row = id >> 5, ch = id & 31;
        const u32x2 lo = *(const u32x2*)(lds + row * 520 + ch * 16), hi = *(const u32x2*)(lds + row * 520 + ch * 16 + 8);
        *(u32x4*)(epi.out0 + (size_t)(m0 + row) * epi.ldc + n0 + ch * 8) = (u32x4){lo.x, lo.y, hi.x, hi.y};
      }
    } else {
      float* G = (float*)lds;
#pragma unroll
      for (int ai = 0; ai < 2; ++ai)
#pragma unroll
        for (int m = 0; m < 4; ++m) {
          const int ml = ai * 128 + e_wr * 64 + m * 16 + e_fr;
          const float sc = epi.rs[min(max(m0 + ml, seq0), seq0 + S_ - 1)];
#pragma unroll
          for (int n = 0; n < 2; ++n) {
            acc[ai][0][m][n] = acc[ai][0][m][n] * sc; acc[ai][1][m][n] = acc[ai][1][m][n] * sc;
#pragma unroll
            for (int j = 0; j < 4; ++j) G[(e_wc * 32 + n * 16 + e_fq * 4 + j) * 256 + ml] = acc[ai][0][m][n][j];
          }
        }
      __syncthreads();
#pragma unroll
      for (int n = 0; n < 2; ++n) {
        const int chl = e_wc * 32 + n * 16 + e_fq * 4, c = nt * 128 + chl;
        const f32x4 w0 = *(const f32x4*)(epi.cw + c), w1 = *(const f32x4*)(epi.cw + FF + c), w2 = *(const f32x4*)(epi.cw + 2 * FF + c);
#pragma unroll
        for (int ai = 0; ai < 2; ++ai)
#pragma unroll
          for (int m = 0; m < 4; ++m) {
            const int ml = ai * 128 + e_wr * 64 + m * 16 + e_fr, t = m0 + ml, sq = t - seq0;
            const int m1 = max(ml - 1, 0), m2 = max(ml - 2, 0);
            float o[4];
#pragma unroll
            for (int j = 0; j < 4; ++j) {
              const float g0 = acc[ai][0][m][n][j];
              const float g1 = (sq >= 1) ? G[(chl + j) * 256 + m1] : 0.f;
              const float g2 = (sq >= 2) ? G[(chl + j) * 256 + m2] : 0.f;
              const float cv = w0[j] * g2 + w1[j] * g1 + w2[j] * g0;
              o[j] = gelu_tanh(cv) * acc[ai][1][m][n][j];
            }
            if (ml >= 2 && sq < S_) {
              u32x2 wv2; wv2.x = pk_bf16(o[0], o[1]); wv2.y = pk_bf16(o[2], o[3]);
              *(u32x2*)(epi.out0 + (size_t)t * FF + c) = wv2;
            }
          }
      }
    }
  }
  __syncthreads();
}

DI void ffn_act_phase(const bf16* __restrict__ gate, bf16* __restrict__ up, const float* __restrict__ cw, int tid) {
  constexpr int CG = FF / 8;
  const int total = (T_ / 16) * CG;
  for (int it = blockIdx.x * 256 + tid; it < total; it += gridDim.x * 256) {
    const int tb = it / CG, cgp = it % CG, t0 = tb * 16, c0 = cgp * 8;
    float w0[8], w1[8], w2[8], g1[8], g2[8];
#pragma unroll
    for (int i = 0; i < 8; ++i) { w0[i] = cw[c0 + i]; w1[i] = cw[FF + c0 + i]; w2[i] = cw[2 * FF + c0 + i]; g1[i] = 0.f; g2[i] = 0.f; }
    if ((t0 & (S_ - 1)) != 0) {
      u32x4 a = *(const u32x4*)(gate + (size_t)(t0 - 2) * FF + c0), b = *(const u32x4*)(gate + (size_t)(t0 - 1) * FF + c0);
#pragma unroll
      for (int i = 0; i < 4; ++i) { g2[2 * i] = bflo(a[i]); g2[2 * i + 1] = bfhi(a[i]); g1[2 * i] = bflo(b[i]); g1[2 * i + 1] = bfhi(b[i]); }
    }
#pragma unroll 4
    for (int t = t0; t < t0 + 16; ++t) {
      u32x4 a = *(const u32x4*)(gate + (size_t)t * FF + c0), u = *(const u32x4*)(up + (size_t)t * FF + c0);
      float g0[8], uu[8], o[8];
#pragma unroll
      for (int i = 0; i < 4; ++i) { g0[2 * i] = bflo(a[i]); g0[2 * i + 1] = bfhi(a[i]); uu[2 * i] = bflo(u[i]); uu[2 * i + 1] = bfhi(u[i]); }
#pragma unroll
      for (int i = 0; i < 8; ++i) { const float c = w0[i] * g2[i] + w1[i] * g1[i] + w2[i] * g0[i]; o[i] = gelu_tanh(c) * uu[i]; g2[i] = g1[i]; g1[i] = g0[i]; }
      u32x4 w; w.x = pk_bf16(o[0], o[1]); w.y = pk_bf16(o[2], o[3]); w.z = pk_bf16(o[4], o[5]); w.w = pk_bf16(o[6], o[7]);
      *(u32x4*)(up + (size_t)t * FF + c0) = w;
    }
  }
}

template <int DK, bool ISA>
DI float gla_lb(const Params& p, int l, int h, int d) {
  if (!ISA || l == 0) return 0.f;
  const float l0 = p.hgrn_lb[h * 64 + d], l1 = p.hgrn_lb[256 + h * 64 + d];
  return 1.f / (1.f + __expf(l0 - l1));
}
template <int DK, bool ISA>
DI void gla_bc(const Params& p, int l, const bf16* __restrict__ z, int t0, int h, float* bcl, int tid) {
  constexpr int NP = 256 / DK, TPP = 64 / NP;
  const int d = tid % DK, part = tid / DK;
  float run = 0.f;
  if (ISA) {
    const float lbv = gla_lb<DK, ISA>(p, l, h, d);
#pragma unroll
    for (int jj = 0; jj < TPP; ++jj) {
      const int j = part * TPP + jj;
      const float zf = bf2f(z[(size_t)(t0 + j) * ZLD + ZA_F + h * 64 + d]);
      const float f = lbv + (1.f - lbv) * sigmoidf_(zf);
      run += __logf(fmaxf(f, 1e-30f));
      bcl[j * DK + d] = run;
    }
  } else {
    float w[16];
#pragma unroll
    for (int rr = 0; rr < 16; ++rr) w[rr] = p.gla_w2[(size_t)l * 16 * 128 + rr * 128 + h * 32 + d];
    const float bias = p.gla_b[l * 128 + h * 32 + d];
#pragma unroll
    for (int jj = 0; jj < TPP; ++jj) {
      const int j = part * TPP + jj;
      const u32x4* cp = (const u32x4*)(z + (size_t)(t0 + j) * ZLD + ZB_CODE);
      u32x4 c0 = cp[0], c1 = cp[1];
      float u = bias;
#pragma unroll
      for (int i = 0; i < 4; ++i) { u += bflo(c0[i]) * w[2 * i] + bfhi(c0[i]) * w[2 * i + 1]; u += bflo(c1[i]) * w[8 + 2 * i] + bfhi(c1[i]) * w[8 + 2 * i + 1]; }
      run += -softplusf_(-u) * (1.f / 16.f);
      bcl[j * DK + d] = run;
    }
  }
  __syncthreads();
  float off = 0.f;
  for (int pp = 0; pp < part; ++pp) off += bcl[(pp * TPP + TPP - 1) * DK + d];
  __syncthreads();
#pragma unroll
  for (int jj = 0; jj < TPP; ++jj) bcl[(part * TPP + jj) * DK + d] += off;
  __syncthreads();
}
template <int DK, bool ISA>
DI float gla_kval(const bf16* __restrict__ z, int t, int h, int d, float lbv) {
  if (ISA) { const float zf = bf2f(z[(size_t)t * ZLD + ZA_F + h * 64 + d]); return (1.f - lbv) * sigmoidf_(-zf); }
  return bf2f(z[(size_t)t * ZLD + ZB_K + h * 32 + d]);
}
template <int DK, bool ISA>
DI float gla_qval(const bf16* __restrict__ z, int t, int h, int d) {
  if (ISA) { const float zq = bf2f(z[(size_t)t * ZLD + ZA_Q + h * 64 + d]); return siluf_(zq) * 0.125f; }
  return bf2f(z[(size_t)t * ZLD + ZB_Q + h * 32 + d]) * 0.17677669529663687f;
}

template <int DK, bool ISA>
DI void gla_local_item(const Params& p, int l, int ci, unsigned char* lds, int tid) {
  const bf16* z = (const bf16*)(p.ws + OFF_AR + AR_Z);
  bf16* UT = (bf16*)(p.ws + OFF_AR + (ISA ? AR_UTA : AR_UTB));
  float* G = (float*)(p.ws + (ISA ? OFF_GA : OFF_GB));
  const int h = ci & 3, t0 = (ci >> 2) * 64;
  float* bcl = (float*)lds;
  bf16* kT = (bf16*)(lds + 16384);
  bf16* vT = (bf16*)(lds + 16384 + 9216);
  bf16 vpre[16];
  {
    const int e = tid & 63, p4 = tid >> 6;
    const int vcol = (ISA ? ZA_I : ZB_V) + h * 64 + e;
#pragma unroll
    for (int jj = 0; jj < 16; ++jj) vpre[jj] = z[(size_t)(t0 + p4 * 16 + jj) * ZLD + vcol];
  }
  constexpr int NPk = 256 / DK, TPPk = 64 / NPk;
  const float lbv_pre = gla_lb<DK, ISA>(p, l, h, tid % DK);
  bf16 kpre[TPPk];
  {
    const int d = tid % DK, part = tid / DK;
#pragma unroll
    for (int jj = 0; jj < TPPk; ++jj) kpre[jj] = z[(size_t)(t0 + part * TPPk + jj) * ZLD + (ISA ? ZA_F + h * 64 : ZB_K + h * 32) + d];
  }
  gla_bc<DK, ISA>(p, l, z, t0, h, bcl, tid);
  {
    float* bcg = (float*)((unsigned char*)p.out + BC_OFF + (ISA ? 0 : BC_B_OFF)) + (size_t)ci * 64 * DK;
#pragma unroll
    for (int k = 0; k < (64 * DK) / 1024; ++k) *(f32x4*)(bcg + (tid + 256 * k) * 4) = *(const f32x4*)(bcl + (tid + 256 * k) * 4);
  }
  constexpr int NP = 256 / DK, TPP = 64 / NP;
  {
    const int d = tid % DK, part = tid / DK;
    const float lbv = lbv_pre;
    const float bl = bcl[63 * DK + d];
#pragma unroll
    for (int jj = 0; jj < TPP; ++jj) {
      const int j = part * TPP + jj;
      const float kv = ISA ? (1.f - lbv) * sigmoidf_(-bf2f(kpre[jj])) : bf2f(kpre[jj]);
      kT[d * 72 + j] = f2bf(kv * __expf(bl - bcl[j * DK + d]));
    }
    if (part == 0) G[(size_t)ci * DK + d] = __expf(bl);
    const int e = tid & 63, p4 = tid >> 6;
#pragma unroll
    for (int jj = 0; jj < 16; ++jj) { const int j = p4 * 16 + jj; vT[e * 72 + j] = vpre[jj]; }
  }
  __syncthreads();
  const int lane = tid & 63, wv = tid >> 6, wm = wv & 1, wn = wv >> 1, r = lane & 31, hh = lane >> 5;
  if (wm * 32 < DK) {
    f32x16 acc = mm32((const unsigned char*)(kT + wm * 32 * 72), 144, (const unsigned char*)(vT + wn * 32 * 72), 144, 4, zero16(), r, hh);
    const int e = wn * 32 + r;
#pragma unroll
    for (int g = 0; g < 4; ++g) {
      const int d = wm * 32 + 8 * g + 4 * hh;
      u32x2 w; w.x = pk_bf16(acc[4 * g], acc[4 * g + 1]); w.y = pk_bf16(acc[4 * g + 2], acc[4 * g + 3]);
      *(u32x2*)(UT + ((size_t)ci * 64 + e) * DK + d) = w;
    }
  }
  __syncthreads();
}

template <int DK>
DI void gla_scan_item(bf16* __restrict__ UT, const float* __restrict__ G, int b, int h, int slice, int tid) {
  constexpr int GPR = DK / 4, RPS = 256 / GPR;
  const int e = slice * RPS + tid / GPR, d4 = (tid % GPR) * 4;
  f32x4 st = (f32x4){0.f, 0.f, 0.f, 0.f};
  for (int c0 = 0; c0 < 128; c0 += 8) {
    u32x2 u[8]; f32x4 gg[8];
#pragma unroll
    for (int i = 0; i < 8; ++i) {
      const size_t ci = ((size_t)(b * 128 + c0 + i) * 4 + h);
      u[i] = *(const u32x2*)(UT + (ci * 64 + e) * DK + d4);
      gg[i] = *(const f32x4*)(G + ci * DK + d4);
    }
#pragma unroll
    for (int i = 0; i < 8; ++i) {
      const size_t ci = ((size_t)(b * 128 + c0 + i) * 4 + h);
      u32x2 w; w.x = pk_bf16(st.x, st.y); w.y = pk_bf16(st.z, st.w);
      *(u32x2*)(UT + (ci * 64 + e) * DK + d4) = w;
      st = gg[i] * st + (f32x4){bflo(u[i].x), bfhi(u[i].x), bflo(u[i].y), bfhi(u[i].y)};
    }
  }
}

template <bool SIG>
DI void norm_gate_store(const float* obuf, bool has_add, u32x4 a0, u32x4 a1, const f32x4 (&ngv)[4], u32x4 g0, u32x4 g1, bf16* __restrict__ mixo, int tid) {
  const int i = tid >> 2, e0 = (tid & 3) * 16;
  float o[16]; float ss = 0.f;
#pragma unroll
  for (int k = 0; k < 16; ++k) o[k] = obuf[i * 68 + e0 + k];
  if (has_add) {
#pragma unroll
    for (int k = 0; k < 4; ++k) { o[2 * k] += bflo(a0[k]); o[2 * k + 1] += bfhi(a0[k]); o[8 + 2 * k] += bflo(a1[k]); o[8 + 2 * k + 1] += bfhi(a1[k]); }
  }
#pragma unroll
  for (int k = 0; k < 16; ++k) ss += o[k] * o[k];
  ss += __shfl_xor(ss, 1); ss += __shfl_xor(ss, 2);
  const float rsv = rsqrtf(ss * (1.f / 64.f) + EPS);
  float gt[16];
#pragma unroll
  for (int k = 0; k < 4; ++k) { gt[2 * k] = bflo(g0[k]); gt[2 * k + 1] = bfhi(g0[k]); gt[8 + 2 * k] = bflo(g1[k]); gt[8 + 2 * k + 1] = bfhi(g1[k]); }
  unsigned w[8];
#pragma unroll
  for (int k = 0; k < 8; ++k) {
    float a = o[2 * k] * rsv * ngv[(2 * k) >> 2][(2 * k) & 3], b = o[2 * k + 1] * rsv * ngv[(2 * k + 1) >> 2][(2 * k + 1) & 3];
    a *= SIG ? sigmoidf_(gt[2 * k]) : siluf_(gt[2 * k]);
    b *= SIG ? sigmoidf_(gt[2 * k + 1]) : siluf_(gt[2 * k + 1]);
    w[k] = pk_bf16(a, b);
  }
  u32x4* op = (u32x4*)(mixo + (size_t)i * 1024 + e0);
  op[0] = (u32x4){w[0], w[1], w[2], w[3]}; op[1] = (u32x4){w[4], w[5], w[6], w[7]};
}

template <int DK, bool ISA>
DI void gla_out_item(const Params& p, int l, int ci, unsigned char* lds, int tid) {
  const bf16* z = (const bf16*)(p.ws + OFF_AR + AR_Z);
  const bf16* ST = (const bf16*)(p.ws + OFF_AR + (ISA ? AR_UTA : AR_UTB));
  bf16* mix = (bf16*)(p.ws + OFF_AR + AR_MIX);
  const int h = ci & 3, t0 = (ci >> 2) * 64;
  constexpr int LDK = (DK + 8) * 2;
  float* bcl = (float*)lds;
  float* obuf = (float*)lds;
  unsigned char* qh = lds + 17408;
  unsigned char* kt = qh + 9216;
  unsigned char* qc = kt + 9216;
  unsigned char* vT = qc + 9216;
  unsigned char* stl = vT + 9216;
  unsigned char* attn = stl + 9216;
  const u32x4* gpre = (const u32x4*)(z + (size_t)(t0 + (tid >> 2)) * ZLD + (ISA ? ZA_G : ZB_G) + h * 64 + (tid & 3) * 16);
  const u32x4 gq0 = gpre[0], gq1 = gpre[1];
  f32x4 ngv[4];
#pragma unroll
  for (int k = 0; k < 4; ++k) ngv[k] = *(const f32x4*)((ISA ? p.hgrn_ng : p.gla_ng) + l * 64 + (tid & 3) * 16 + 4 * k);
  bf16 vpre[16];
  {
    const int e = tid & 63, p4 = tid >> 6;
    const int vcol = (ISA ? ZA_I : ZB_V) + h * 64 + e;
#pragma unroll
    for (int jj = 0; jj < 16; ++jj) vpre[jj] = z[(size_t)(t0 + p4 * 16 + jj) * ZLD + vcol];
  }
  constexpr int NPq = 256 / DK, TPPq = 64 / NPq;
  const float lbv_pre = gla_lb<DK, ISA>(p, l, h, tid % DK);
  bf16 qpre[TPPq], kpre[TPPq];
  {
    const int d = tid % DK, part = tid / DK;
#pragma unroll
    for (int jj = 0; jj < TPPq; ++jj) {
      const size_t t = (size_t)(t0 + part * TPPq + jj);
      qpre[jj] = z[t * ZLD + (ISA ? ZA_Q + h * 64 : ZB_Q + h * 32) + d];
      kpre[jj] = ISA ? z[t * ZLD + ZA_F + h * 64 + d] : z[t * ZLD + ZB_K + h * 32 + d];
    }
  }
  constexpr int CPR0 = DK / 8, NST = (64 * CPR0) / 256;
  u32x4 stpre[NST];
#pragma unroll
  for (int k = 0; k < NST; ++k) { const int id = tid + 256 * k; stpre[k] = *(const u32x4*)(ST + ((size_t)ci * 64 + id / CPR0) * DK + (id % CPR0) * 8); }
  {
    const float* bcg = (const float*)((const unsigned char*)p.out + BC_OFF + (ISA ? 0 : BC_B_OFF)) + (size_t)ci * 64 * DK;
#pragma unroll
    for (int k = 0; k < (64 * DK) / 1024; ++k) *(f32x4*)(bcl + (tid + 256 * k) * 4) = *(const f32x4*)(bcg + (tid + 256 * k) * 4);
    __syncthreads();
  }
  constexpr int NP = 256 / DK, TPP = 64 / NP;
  {
    const int d = tid % DK, part = tid / DK;
    const float lbv = lbv_pre;
    const float bref = bcl[31 * DK + d];
#pragma unroll
    for (int jj = 0; jj < TPP; ++jj) {
      const int j = part * TPP + jj;
      const float kv = ISA ? (1.f - lbv) * sigmoidf_(-bf2f(kpre[jj])) : bf2f(kpre[jj]);
      const float qv = ISA ? siluf_(bf2f(qpre[jj])) * 0.125f : bf2f(qpre[jj]) * 0.17677669529663687f;
      const float bc = bcl[j * DK + d];
      const float dq = fminf(fmaxf(bc - bref, -80.f), 80.f);
      ((bf16*)qh)[j * (DK + 8) + d] = f2bf(qv * __expf(dq));
      ((bf16*)kt)[j * (DK + 8) + d] = f2bf(kv * __expf(-dq));
      ((bf16*)qc)[j * (DK + 8) + d] = f2bf(qv * __expf(bc));
    }
    const int e = tid & 63, p4 = tid >> 6;
#pragma unroll
    for (int jj = 0; jj < 16; ++jj) { const int j = p4 * 16 + jj; ((bf16*)vT)[e * 72 + j] = vpre[jj]; }
#pragma unroll
    for (int k = 0; k < NST; ++k) { const int id = tid + 256 * k; *(u32x4*)(stl + (id / CPR0) * LDK + (id % CPR0) * 16) = stpre[k]; }
  }
  __syncthreads();
  const int lane = tid & 63, wv = tid >> 6, wm = wv & 1, wn = wv >> 1, r = lane & 31, hh = lane >> 5;
  {
    f32x16 acc = mm32(qh + wm * 32 * LDK, LDK, kt + wn * 32 * LDK, LDK, DK / 16, zero16(), r, hh);
    const int jc = wn * 32 + r;
#pragma unroll
    for (int g = 0; g < 4; ++g)
#pragma unroll
      for (int k = 0; k < 4; ++k) {
        const int i = wm * 32 + 8 * g + 4 * hh + k;
        const float v = (jc <= i) ? acc[4 * g + k] : 0.f;
        ((bf16*)attn)[i * 72 + jc] = f2bf(v);
      }
  }
  __syncthreads();
  {
    f32x16 acc = mm32(attn + wm * 32 * 144, 144, vT + wn * 32 * 144, 144, 4, zero16(), r, hh);
    acc = mm32(qc + wm * 32 * LDK, LDK, stl + wn * 32 * LDK, LDK, DK / 16, acc, r, hh);
    const int e = wn * 32 + r;
#pragma unroll
    for (int g = 0; g < 4; ++g)
#pragma unroll
      for (int k = 0; k < 4; ++k) obuf[(wm * 32 + 8 * g + 4 * hh + k) * 68 + e] = acc[4 * g + k];
  }
  __syncthreads();
  norm_gate_store<ISA>(obuf, false, gq0, gq0, ngv, gq0, gq1, mix + (size_t)t0 * 1024 + (ISA ? 0 : 256) + h * 64, tid);
  __syncthreads();
}

DI void gdn_local_item(const Params& p, int l, int ci, unsigned char* lds, int tid) {
  const bf16* z = (const bf16*)(p.ws + OFF_AR + AR_Z);
  float* Ac = (float*)(p.ws + OFF_AR + AR_ACD) + (size_t)ci * 4096;
  bf16* BT = (bf16*)(p.ws + OFF_AR + AR_BTD) + (size_t)ci * 4096;
  bf16* Qeff = (bf16*)(p.ws + OFF_AR + AR_QEFF) + (size_t)ci * 4096;
  bf16* Oloc = (bf16*)(p.ws + OFF_AR + AR_OLOC) + (size_t)ci * 4096;
  const int h = ci & 3, t0 = (ci >> 2) * 64, s0 = t0 & (S_ - 1);
  float* Mf = (float*)lds;
  bf16* WT = (bf16*)lds;
  bf16* UT = (bf16*)(lds + 9216);
  float* X = (float*)(lds + 16384);
  bf16* qn = (bf16*)(lds + 16384);
  bf16* kn = qn + 64 * 72;
  bf16* vb = kn + 64 * 72;
  bf16* kbm = (bf16*)(lds + 49152);
  bf16* aqk = kbm;
  bf16* KtT = kbm + 64 * 72;
  float* sm = (float*)(lds + 49152 + 2 * 9216);
  float* betas = sm; float* bcum = sm + 64;
  const int lane = tid & 63, wv = tid >> 6;
  const bf16 zbeta_raw = z[(size_t)(t0 + lane) * ZLD + ZD_BETA + h], za_raw = z[(size_t)(t0 + lane) * ZLD + ZD_A + h];
  const float alog_pre = p.gdn_alog[l * 4 + h], dtb_pre = p.gdn_dtb[l * 4 + h];
  {
    const int d = lane, j0 = wv * 16;
    const float* cw = p.gdn_conv + (size_t)l * 4 * 768;
    float qv[16], kv[16];
#pragma unroll
    for (int which = 0; which < 3; ++which) {
      const int cc = which * 256 + h * 64 + d;
      const int zc = (which == 0 ? ZD_Q : (which == 1 ? ZD_K : ZD_V)) + h * 64 + d;
      const float c0 = cw[cc], c1 = cw[768 + cc], c2 = cw[2 * 768 + cc], c3 = cw[3 * 768 + cc];
      float x0 = 0.f, x1 = 0.f, x2 = 0.f;
      if (s0 + j0 >= 3) { x0 = bf2f(z[(size_t)(t0 + j0 - 3) * ZLD + zc]); x1 = bf2f(z[(size_t)(t0 + j0 - 2) * ZLD + zc]); x2 = bf2f(z[(size_t)(t0 + j0 - 1) * ZLD + zc]); }
#pragma unroll
      for (int jj = 0; jj < 16; ++jj) {
        const float x3 = bf2f(z[(size_t)(t0 + j0 + jj) * ZLD + zc]);
        const float o = siluf_(c0 * x0 + c1 * x1 + c2 * x2 + c3 * x3);
        x0 = x1; x1 = x2; x2 = x3;
        if (which == 0) qv[jj] = o; else if (which == 1) kv[jj] = o; else vb[(j0 + jj) * 72 + d] = f2bf(o);
      }
    }
    if (wv == 0) {
      const float be = sigmoidf_(bf2f(zbeta_raw));
      float lg = -__expf(alog_pre) * softplusf_(bf2f(za_raw) + dtb_pre);
#pragma unroll
      for (int o = 1; o < 64; o <<= 1) { const float n = __shfl_up(lg, o); if (lane >= o) lg += n; }
      betas[lane] = be; bcum[lane] = lg;
    }
    __syncthreads();
    const float bl = bcum[63];
#pragma unroll
    for (int jj = 0; jj < 16; ++jj) {
      const int j = j0 + jj;
      const float rq = rsqrtf(wave_sum(qv[jj] * qv[jj]) + EPS) * 0.125f;
      const float rk = rsqrtf(wave_sum(kv[jj] * kv[jj]) + EPS);
      const float qq = qv[jj] * rq, kk = kv[jj] * rk;
      qn[j * 72 + d] = f2bf(qq); kn[j * 72 + d] = f2bf(kk); kbm[j * 72 + d] = f2bf(kk * betas[j]);
      Qeff[j * 64 + d] = f2bf(qq * __expf(bcum[j]));
      KtT[d * 72 + j] = f2bf(kk * __expf(bl - bcum[j]));
    }
  }
  __syncthreads();
  const int wm = wv & 1, wn = wv >> 1, r = lane & 31, hh = lane >> 5;
  {
    f32x16 acc = mm32((const unsigned char*)(kbm + wm * 32 * 72), 144, (const unsigned char*)(kn + wn * 32 * 72), 144, 4, zero16(), r, hh);
    f32x16 acc2 = mm32((const unsigned char*)(qn + wm * 32 * 72), 144, (const unsigned char*)(kn + wn * 32 * 72), 144, 4, zero16(), r, hh);
    const int jc = wn * 32 + r; const float bj = bcum[jc];
    __syncthreads();
#pragma unroll
    for (int g = 0; g < 4; ++g)
#pragma unroll
      for (int k = 0; k < 4; ++k) {
        const int i = wm * 32 + 8 * g + 4 * hh + k;
        const float dec = (jc <= i) ? __expf(bcum[i] - bj) : 0.f;
        Mf[i * 64 + jc] = (jc < i) ? acc[4 * g + k] * dec : 0.f;
        aqk[i * 72 + jc] = f2bf(acc2[4 * g + k] * dec);
      }
  }
  __syncthreads();
  {
    const int c = tid & 127, j0 = (tid >> 7) * 32;
    const bf16* srcp = (c < 64) ? vb : kn;
    float xr[32];
#pragma unroll
    for (int j = 0; j < 32; ++j) { const float f = (c < 64) ? betas[j0 + j] : betas[j0 + j] * __expf(bcum[j0 + j]); xr[j] = bf2f(srcp[(j0 + j) * 72 + (c & 63)]) * f; }
    __syncthreads();
#pragma unroll
    for (int j = 0; j < 32; ++j) X[(j0 + j) * 128 + c] = xr[j];
  }
  __syncthreads();
  {
    const int g4 = lane >> 4, c16 = lane & 15;
#pragma unroll
    for (int I = 0; I < 4; ++I) {
      if (I > 0) {
        f32x4 acc0 = (f32x4){0.f, 0.f, 0.f, 0.f}, acc1 = acc0;
#pragma unroll
        for (int J = 0; J < I; ++J) {
#pragma unroll
          for (int kk = 0; kk < 4; ++kk) {
            const float av = Mf[(16 * I + c16) * 64 + 16 * J + 4 * kk + g4];
            const float b0 = X[(16 * J + 4 * kk + g4) * 128 + (2 * wv) * 16 + c16];
            const float b1 = X[(16 * J + 4 * kk + g4) * 128 + (2 * wv + 1) * 16 + c16];
            acc0 = __builtin_amdgcn_mfma_f32_16x16x4f32(av, b0, acc0, 0, 0, 0);
            acc1 = __builtin_amdgcn_mfma_f32_16x16x4f32(av, b1, acc1, 0, 0, 0);
          }
        }
#pragma unroll
        for (int r4 = 0; r4 < 4; ++r4) {
          X[(16 * I + 4 * g4 + r4) * 128 + (2 * wv) * 16 + c16] -= acc0[r4];
          X[(16 * I + 4 * g4 + r4) * 128 + (2 * wv + 1) * 16 + c16] -= acc1[r4];
        }
        __syncthreads();
      }
      if (tid < 128) {
        float x[16];
#pragma unroll
        for (int r4 = 0; r4 < 16; ++r4) x[r4] = X[(16 * I + r4) * 128 + tid];
#pragma unroll
        for (int r4 = 1; r4 < 16; ++r4) {
          const float* mr = Mf + (16 * I + r4) * 64 + 16 * I;
          float a0 = x[r4];
#pragma unroll
          for (int qb = 0; qb < (r4 + 3) / 4; ++qb) {
            const f32x4 m4 = *(const f32x4*)(mr + 4 * qb);
#pragma unroll
            for (int qq = 0; qq < 4; ++qq) if (4 * qb + qq < r4) a0 -= m4[qq] * x[4 * qb + qq];
          }
          x[r4] = a0;
        }
#pragma unroll
        for (int r4 = 0; r4 < 16; ++r4) X[(16 * I + r4) * 128 + tid] = x[r4];
      }
      __syncthreads();
    }
  }
  {
    float xr[64];
    const int c = tid & 127;
    if (tid < 128) {
#pragma unroll
      for (int j = 0; j < 64; ++j) xr[j] = X[j * 128 + c];
    }
    __syncthreads();
    if (tid < 128) {
      bf16* dst = (tid < 64 ? UT : WT) + (tid & 63) * 72;
#pragma unroll
      for (int j = 0; j < 64; j += 8) {
        u32x4 w; w.x = pk_bf16(xr[j], xr[j + 1]); w.y = pk_bf16(xr[j + 2], xr[j + 3]); w.z = pk_bf16(xr[j + 4], xr[j + 5]); w.w = pk_bf16(xr[j + 6], xr[j + 7]);
        *(u32x4*)(dst + j) = w;
      }
    }
  }
  __syncthreads();
  {
    const float bl = bcum[63];
    u32x2 qpre[4];
#pragma unroll
    for (int g = 0; g < 4; ++g) qpre[g] = *(const u32x2*)(Qeff + (wn * 32 + r) * 64 + wm * 32 + 8 * g + 4 * hh);
    f32x16 a1 = mm32((const unsigned char*)(WT + wm * 32 * 72), 144, (const unsigned char*)(aqk + wn * 32 * 72), 144, 4, zero16(), r, hh);
    f32x16 a2 = mm32((const unsigned char*)(UT + wm * 32 * 72), 144, (const unsigned char*)(aqk + wn * 32 * 72), 144, 4, zero16(), r, hh);
    f32x16 a3 = mm32((const unsigned char*)(WT + wm * 32 * 72), 144, (const unsigned char*)(KtT + wn * 32 * 72), 144, 4, zero16(), r, hh);
    f32x16 a4 = mm32((const unsigned char*)(KtT + wm * 32 * 72), 144, (const unsigned char*)(UT + wn * 32 * 72), 144, 4, zero16(), r, hh);
    const int cidx = wn * 32 + r;
    const float ebl = __expf(bl);
#pragma unroll
    for (int g = 0; g < 4; ++g) {
      const int rb = wm * 32 + 8 * g + 4 * hh;
      const u32x2 qraw = qpre[g];
      u32x2 w;
      w.x = pk_bf16(bflo(qraw.x) - a1[4 * g], bfhi(qraw.x) - a1[4 * g + 1]);
      w.y = pk_bf16(bflo(qraw.y) - a1[4 * g + 2], bfhi(qraw.y) - a1[4 * g + 3]);
      *(u32x2*)(Qeff + cidx * 64 + rb) = w;
      w.x = pk_bf16(a2[4 * g], a2[4 * g + 1]); w.y = pk_bf16(a2[4 * g + 2], a2[4 * g + 3]);
      *(u32x2*)(Oloc + cidx * 64 + rb) = w;
      f32x4 av;
#pragma unroll
      for (int k = 0; k < 4; ++k) av[k] = ((rb + k) == cidx ? ebl : 0.f) - a3[4 * g + k];
      *(f32x4*)(Ac + cidx * 64 + rb) = av;
      w.x = pk_bf16(a4[4 * g], a4[4 * g + 1]); w.y = pk_bf16(a4[4 * g + 2], a4[4 * g + 3]);
      *(u32x2*)(BT + cidx * 64 + rb) = w;
    }
  }
  __syncthreads();
}

DI void gdn_scan_item(const Params& p, int b, int h, int es, unsigned char* lds, int tid) {
  const float* AcB = (const float*)(p.ws + OFF_AR + AR_ACD);
  bf16* BTB = (bf16*)(p.ws + OFF_AR + AR_BTD);
  const int lane = tid & 63, w = tid >> 6, g = lane >> 4, c16 = lane & 15;
  float* stl = (float*)lds;
  for (int i = tid; i < 2 * 16 * 68; i += 256) stl[i] = 0.f;
  __syncthreads();
  f32x4 cur = (f32x4){0.f, 0.f, 0.f, 0.f};
  f32x4 bq[4][4]; bf16 bt[4][4];
  const size_t ci0 = ((size_t)(b * 128) * 4 + h);
  const float* apb = AcB + ci0 * 4096 + (16 * w + c16) * 64 + 16 * g;
  bf16* btb = BTB + ci0 * 4096 + (es * 16 + 4 * g) * 64 + 16 * w + c16;
#pragma unroll
  for (int s4 = 0; s4 < 4; ++s4) {
#pragma unroll
    for (int k = 0; k < 4; ++k) bq[s4][k] = *(const f32x4*)(apb + (size_t)s4 * 4 * 4096 + 4 * k);
#pragma unroll
    for (int k = 0; k < 4; ++k) bt[s4][k] = btb[(size_t)s4 * 4 * 4096 + k * 64];
  }
  for (int c0 = 0; c0 < 128; c0 += 4) {
    const bool pf = (c0 + 4 < 128);
#pragma unroll
    for (int s4 = 0; s4 < 4; ++s4) {
      const int c = c0 + s4;
      const size_t co = (size_t)c * 4 * 4096;
#pragma unroll
      for (int k = 0; k < 4; ++k) btb[co + k * 64] = f2bf(cur[k]);
      const float* sc = stl + (s4 & 1) * 16 * 68;
      f32x4 aq[4];
#pragma unroll
      for (int k = 0; k < 4; ++k) aq[k] = *(const f32x4*)(sc + c16 * 68 + 16 * g + 4 * k);
      f32x4 acc[4];
      acc[0] = (f32x4){bf2f(bt[s4][0]), bf2f(bt[s4][1]), bf2f(bt[s4][2]), bf2f(bt[s4][3])};
      acc[1] = (f32x4){0.f, 0.f, 0.f, 0.f}; acc[2] = acc[1]; acc[3] = acc[1];
#pragma unroll
      for (int q = 0; q < 4; ++q)
#pragma unroll
        for (int k = 0; k < 4; ++k) acc[k] = __builtin_amdgcn_mfma_f32_16x16x4f32(aq[k][q], bq[s4][k][q], acc[k], 0, 0, 0);
      cur = (acc[0] + acc[1]) + (acc[2] + acc[3]);
      if (pf) {
#pragma unroll
        for (int k = 0; k < 4; ++k) bq[s4][k] = *(const f32x4*)(apb + co + (size_t)4 * 4 * 4096 + 4 * k);
#pragma unroll
        for (int k = 0; k < 4; ++k) bt[s4][k] = btb[co + (size_t)4 * 4 * 4096 + k * 64];
      }
      float* sn = stl + ((s4 + 1) & 1) * 16 * 68;
#pragma unroll
      for (int k = 0; k < 4; ++k) sn[(4 * g + k) * 68 + 16 * w + c16] = cur[k];
      __syncthreads();
    }
  }
}

DI void gdn_out_item(const Params& p, int l, int ci, unsigned char* lds, int tid) {
  const bf16* z = (const bf16*)(p.ws + OFF_AR + AR_Z);
  const bf16* ST = (const bf16*)(p.ws + OFF_AR + AR_BTD) + (size_t)ci * 4096;
  const bf16* Qeff = (const bf16*)(p.ws + OFF_AR + AR_QEFF) + (size_t)ci * 4096;
  const bf16* Oloc = (const bf16*)(p.ws + OFF_AR + AR_OLOC) + (size_t)ci * 4096;
  bf16* mix = (bf16*)(p.ws + OFF_AR + AR_MIX);
  const int h = ci & 3, t0 = (ci >> 2) * 64;
  float* obuf = (float*)lds;
  unsigned char* ql = lds + 17408;
  unsigned char* sl = ql + 9216;
  const u32x4* gpre = (const u32x4*)(z + (size_t)(t0 + (tid >> 2)) * ZLD + ZD_Z + h * 64 + (tid & 3) * 16);
  const u32x4 gq0 = gpre[0], gq1 = gpre[1];
  const u32x4* apre = (const u32x4*)(Oloc + (tid >> 2) * 64 + (tid & 3) * 16);
  const u32x4 aq0 = apre[0], aq1 = apre[1];
  f32x4 ngv[4];
#pragma unroll
  for (int k = 0; k < 4; ++k) ngv[k] = *(const f32x4*)(p.gdn_ng + l * 64 + (tid & 3) * 16 + 4 * k);
#pragma unroll
  for (int id = tid; id < 512; id += 256) {
    const int rr = id >> 3, ch = id & 7;
    *(u32x4*)(ql + rr * 144 + ch * 16) = *(const u32x4*)(Qeff + rr * 64 + ch * 8);
    *(u32x4*)(sl + rr * 144 + ch * 16) = *(const u32x4*)(ST + rr * 64 + ch * 8);
  }
  __syncthreads();
  const int lane = tid & 63, wv = tid >> 6, wm = wv & 1, wn = wv >> 1, r = lane & 31, hh = lane >> 5;
  {
    f32x16 acc = mm32(ql + wm * 32 * 144, 144, sl + wn * 32 * 144, 144, 4, zero16(), r, hh);
    const int e = wn * 32 + r;
#pragma unroll
    for (int g = 0; g < 4; ++g)
#pragma unroll
      for (int k = 0; k < 4; ++k) obuf[(wm * 32 + 8 * g + 4 * hh + k) * 68 + e] = acc[4 * g + k];
  }
  __syncthreads();
  norm_gate_store<false>(obuf, true, aq0, aq1, ngv, gq0, gq1, mix + (size_t)t0 * 1024 + 768 + h * 64, tid);
  __syncthreads();
}

DI void mla_proj_item(const Params& p, int l, int tile, unsigned char* lds, int tid) {
  const bf16* z = (const bf16*)(p.ws + OFF_AR + AR_Z);
  const bf16* Wl = (const bf16*)(p.ws + OFF_W) + (size_t)l * WL_E;
  const bf16* Wuq = Wl + WO_UQ;
  const bf16* Wukv = Wl + WO_UKV;
  bf16* Qg = (bf16*)(p.ws + OFF_AR + AR_Q);
  bf16* Kg = (bf16*)(p.ws + OFF_AR + AR_K);
  bf16* Vt = (bf16*)(p.ws + OFF_AR + AR_VT);
  const int t0 = tile * 64, b = t0 / S_, s0 = t0 % S_;
  unsigned char* Aq = lds;
  unsigned char* Akv = lds + 33792;
  float* rsq = (float*)(lds + 33792 + 17408);
  float* rskv = rsq + 64;
#pragma unroll
  for (int id = tid; id < 64 * 32; id += 256) { const int rr = id >> 5, ch = id & 31; *(u32x4*)(Aq + rr * 528 + ch * 16) = *(const u32x4*)(z + (size_t)(t0 + rr) * ZLD + ZC_Q + ch * 8); }
#pragma unroll
  for (int id = tid; id < 64 * 16; id += 256) { const int rr = id >> 4, ch = id & 15; *(u32x4*)(Akv + rr * 272 + ch * 16) = *(const u32x4*)(z + (size_t)(t0 + rr) * ZLD + ZC_KV + ch * 8); }
  bf16 kr1[4], kr2[4];
#pragma unroll
  for (int k = 0; k < 4; ++k) { const int id = tid + 256 * k, m = id >> 4, i2 = id & 15; kr1[k] = z[(size_t)(t0 + m) * ZLD + ZC_KR + i2]; kr2[k] = z[(size_t)(t0 + m) * ZLD + ZC_KR + 16 + i2]; }
  __syncthreads();
  {
    const int rr = tid >> 2, qd = tid & 3;
    float s1 = 0.f, s2 = 0.f;
#pragma unroll
    for (int k = 0; k < 8; ++k) { const u32x4 u = *(const u32x4*)(Aq + rr * 528 + qd * 128 + k * 16);
#pragma unroll
      for (int i = 0; i < 4; ++i) { const float a = bflo(u[i]), b = bfhi(u[i]); s1 += a * a + b * b; } }
#pragma unroll
    for (int k = 0; k < 4; ++k) { const u32x4 u = *(const u32x4*)(Akv + rr * 272 + qd * 64 + k * 16);
#pragma unroll
      for (int i = 0; i < 4; ++i) { const float a = bflo(u[i]), b = bfhi(u[i]); s2 += a * a + b * b; } }
    s1 += __shfl_xor(s1, 1); s1 += __shfl_xor(s1, 2); s2 += __shfl_xor(s2, 1); s2 += __shfl_xor(s2, 2);
    if (qd == 0) { rsq[rr] = rsqrtf(s1 * (1.f / 256.f) + EPS); rskv[rr] = rsqrtf(s2 * (1.f / 128.f) + EPS); }
#pragma unroll
    for (int id = tid; id < 1024; id += 256) {
      const int m = id >> 4, i = id & 15;
      const float inv = __builtin_amdgcn_exp2f(-(float)i * (13.287712379549449f / 16.f));
      const float ang = (float)(s0 + m) * inv;
      const double rev = (double)ang * 0.15915494309189535;
      const float fr = (float)(rev - floor(rev));
      const float sn = __builtin_amdgcn_sinf(fr), cs = __builtin_amdgcn_cosf(fr);
      const float x1 = bf2f(kr1[id >> 8]), x2 = bf2f(kr2[id >> 8]);
      const bf16 o1 = f2bf(x1 * cs - x2 * sn), o2 = f2bf(x2 * cs + x1 * sn);
      { bf16* krl = (bf16*)(lds + 51712); krl[m * 32 + i] = o1; krl[m * 32 + 16 + i] = o2; }
    }
  }
  __syncthreads();
  const int lane = tid & 63, hd = tid >> 6, r = lane & 31, hh = lane >> 5;
  const float QS = 0.10206207261596575f * 1.4426950408889634f;
  {
    f32x16 acc[3][2];
#pragma unroll
    for (int i = 0; i < 3; ++i) { acc[i][0] = zero16(); acc[i][1] = zero16(); }
#pragma unroll 8
    for (int kk = 0; kk < 16; ++kk) {
      bf16x8 af[2], bw[3];
#pragma unroll
      for (int mi = 0; mi < 2; ++mi) af[mi] = *(const bf16x8*)(Aq + (mi * 32 + r) * 528 + kk * 32 + hh * 16);
#pragma unroll
      for (int ni = 0; ni < 3; ++ni) bw[ni] = *(const bf16x8*)(Wuq + ((size_t)(((hd * 16 + kk) * 3 + ni) * 64 + lane)) * 8);
#pragma unroll
      for (int ni = 0; ni < 3; ++ni)
#pragma unroll
        for (int mi = 0; mi < 2; ++mi) acc[ni][mi] = MFMA32(bw[ni], af[mi], acc[ni][mi]);
    }
    __syncthreads();
    unsigned char* wbuf = lds + hd * 6400;
#pragma unroll
    for (int mi = 0; mi < 2; ++mi) {
      const int m = mi * 32 + r;
      const float sc = rsq[m] * QS;
      bf16* qp = (bf16*)(wbuf + r * 200);
#pragma unroll
      for (int ni = 0; ni < 2; ++ni)
#pragma unroll
        for (int g = 0; g < 4; ++g) {
          u32x2 w; w.x = pk_bf16(acc[ni][mi][4 * g] * sc, acc[ni][mi][4 * g + 1] * sc); w.y = pk_bf16(acc[ni][mi][4 * g + 2] * sc, acc[ni][mi][4 * g + 3] * sc);
          *(u32x2*)(qp + ni * 32 + 8 * g + 4 * hh) = w;
        }
#pragma unroll
      for (int g = 0; g < 2; ++g) {
        float o1[4], o2[4];
#pragma unroll
        for (int k = 0; k < 4; ++k) {
          const int i = 8 * g + 4 * hh + k;
          const float inv = __builtin_amdgcn_exp2f(-(float)i * (13.287712379549449f / 16.f));
          const float ang = (float)(s0 + m) * inv;
          const double rev = (double)ang * 0.15915494309189535;
          const float fr = (float)(rev - floor(rev));
          const float sn = __builtin_amdgcn_sinf(fr), cs = __builtin_amdgcn_cosf(fr);
          const float x1 = acc[2][mi][4 * g + k] * sc, x2 = acc[2][mi][4 * (g + 2) + k] * sc;
          o1[k] = x1 * cs - x2 * sn; o2[k] = x2 * cs + x1 * sn;
        }
        u32x2 w; w.x = pk_bf16(o1[0], o1[1]); w.y = pk_bf16(o1[2], o1[3]);
        *(u32x2*)(qp + 64 + 8 * g + 4 * hh) = w;
        w.x = pk_bf16(o2[0], o2[1]); w.y = pk_bf16(o2[2], o2[3]);
        *(u32x2*)(qp + 80 + 8 * g + 4 * hh) = w;
      }
#pragma unroll
      for (int k = 0; k < 6; ++k) {
        const int id = lane + 64 * k, row = id / 12, ch = id % 12;
        const u32x2 lo = *(const u32x2*)(wbuf + row * 200 + ch * 16), hi = *(const u32x2*)(wbuf + row * 200 + ch * 16 + 8);
        *(u32x4*)(Qg + ((size_t)(b * 4 + hd) * S_ + s0 + mi * 32 + row) * 96 + ch * 8) = (u32x4){lo.x, lo.y, hi.x, hi.y};
      }
    }
  }
  {
    f32x16 acc[2][2];
#pragma unroll
    for (int i = 0; i < 2; ++i) { acc[i][0] = zero16(); acc[i][1] = zero16(); }
#pragma unroll
    for (int kk = 0; kk < 8; ++kk) {
      bf16x8 af[2], bw[2];
#pragma unroll
      for (int mi = 0; mi < 2; ++mi) af[mi] = *(const bf16x8*)(Akv + (mi * 32 + r) * 272 + kk * 32 + hh * 16);
#pragma unroll
      for (int ni = 0; ni < 2; ++ni) bw[ni] = *(const bf16x8*)(Wukv + ((size_t)((((hd * 2 + 0) * 8 + kk) * 2 + ni) * 64 + lane)) * 8);
#pragma unroll
      for (int ni = 0; ni < 2; ++ni)
#pragma unroll
        for (int mi = 0; mi < 2; ++mi) acc[ni][mi] = MFMA32(bw[ni], af[mi], acc[ni][mi]);
    }
    unsigned char* wbuf = lds + hd * 6400;
    const unsigned char* krl = lds + 51712;
#pragma unroll
    for (int mi = 0; mi < 2; ++mi) {
      const int m = mi * 32 + r;
      const float sc = rskv[m];
      bf16* kp = (bf16*)(wbuf + r * 200);
#pragma unroll
      for (int ni = 0; ni < 2; ++ni)
#pragma unroll
        for (int g = 0; g < 4; ++g) {
          u32x2 w; w.x = pk_bf16(acc[ni][mi][4 * g] * sc, acc[ni][mi][4 * g + 1] * sc); w.y = pk_bf16(acc[ni][mi][4 * g + 2] * sc, acc[ni][mi][4 * g + 3] * sc);
          *(u32x2*)(kp + ni * 32 + 8 * g + 4 * hh) = w;
        }
#pragma unroll
      for (int k = 0; k < 6; ++k) {
        const int id = lane + 64 * k, row = id / 12, ch = id % 12;
        const unsigned char* src = (ch < 8) ? (wbuf + row * 200 + ch * 16) : (krl + (mi * 32 + row) * 64 + (ch - 8) * 16);
        const u32x2 lo = *(const u32x2*)src, hi = *(const u32x2*)(src + 8);
        *(u32x4*)(Kg + ((size_t)(b * 4 + hd) * S_ + s0 + mi * 32 + row) * 96 + ch * 8) = (u32x4){lo.x, lo.y, hi.x, hi.y};
      }
    }
  }
  {
    f32x16 acc[2][2];
#pragma unroll
    for (int i = 0; i < 2; ++i) { acc[i][0] = zero16(); acc[i][1] = zero16(); }
#pragma unroll
    for (int kk = 0; kk < 8; ++kk) {
      bf16x8 af[2], bw[2];
#pragma unroll
      for (int mi = 0; mi < 2; ++mi) af[mi] = *(const bf16x8*)(Akv + (mi * 32 + r) * 272 + kk * 32 + hh * 16);
#pragma unroll
      for (int ni = 0; ni < 2; ++ni) bw[ni] = *(const bf16x8*)(Wukv + ((size_t)((((hd * 2 + 1) * 8 + kk) * 2 + ni) * 64 + lane)) * 8);
#pragma unroll
      for (int mi = 0; mi < 2; ++mi)
#pragma unroll
        for (int ni = 0; ni < 2; ++ni) acc[mi][ni] = MFMA32(af[mi], bw[ni], acc[mi][ni]);
    }
#pragma unroll
    for (int ni = 0; ni < 2; ++ni) {
      unsigned char* wbuf = lds + hd * 6400;
      bf16* vp = (bf16*)(wbuf + r * 136);
#pragma unroll
      for (int mi = 0; mi < 2; ++mi)
#pragma unroll
        for (int g = 0; g < 4; ++g) {
          const int m = mi * 32 + 8 * g + 4 * hh;
          u32x2 w; w.x = pk_bf16(acc[mi][ni][4 * g] * rskv[m], acc[mi][ni][4 * g + 1] * rskv[m + 1]); w.y = pk_bf16(acc[mi][ni][4 * g + 2] * rskv[m + 2], acc[mi][ni][4 * g + 3] * rskv[m + 3]);
          *(u32x2*)(vp + m) = w;
        }
#pragma unroll
      for (int k = 0; k < 4; ++k) {
        const int id = lane + 64 * k, row = id >> 3, ch = id & 7;
        const u32x2 lo = *(const u32x2*)(wbuf + row * 136 + ch * 16), hi = *(const u32x2*)(wbuf + row * 136 + ch * 16 + 8);
        *(u32x4*)(Vt + ((size_t)(b * 4 + hd) * 64 + ni * 32 + row) * S_ + s0 + ch * 8) = (u32x4){lo.x, lo.y, hi.x, hi.y};
      }
    }
  }
  __syncthreads();
}

DI void attn_item(const Params& p, int bh, int qb, unsigned char* lds, int tid) {
  const bf16* Qg = (const bf16*)(p.ws + OFF_AR + AR_Q) + (size_t)bh * S_ * 96;
  const bf16* Kg = (const bf16*)(p.ws + OFF_AR + AR_K) + (size_t)bh * S_ * 96;
  const bf16* Vt = (const bf16*)(p.ws + OFF_AR + AR_VT) + (size_t)bh * 64 * S_;
  bf16* mix = (bf16*)(p.ws + OFF_AR + AR_MIX);
  const int lane = tid & 63, w = tid >> 6, r = lane & 31, hh = lane >> 5;
  const int q0 = qb * 128, qrow = q0 + 32 * w + r;
  const int ntiles = 2 * qb + 2;
  constexpr int STG = 64 * 208 + 64 * 144;
  bf16x8 qf[6];
#pragma unroll
  for (int kk = 0; kk < 6; ++kk) qf[kk] = *(const bf16x8*)(Qg + (size_t)qrow * 96 + kk * 16 + hh * 8);
  f32x16 ot[2] = {zero16(), zero16()};
  float mrun = -1e30f, lrun = 0.f;
  u32x4 rk[3], rv[2];
  int krow[3], kch[3];
#pragma unroll
  for (int i = 0; i < 3; ++i) { const int id = tid + 256 * i; krow[i] = id / 12; kch[i] = id % 12; }
  const int vrow0 = tid >> 3, vch = tid & 7;
#pragma unroll
  for (int i = 0; i < 3; ++i) rk[i] = *(const u32x4*)(Kg + (size_t)krow[i] * 96 + kch[i] * 8);
#pragma unroll
  for (int i = 0; i < 2; ++i) rv[i] = *(const u32x4*)(Vt + (size_t)(vrow0 + 32 * i) * S_ + vch * 8);
  __syncthreads();
#pragma unroll
  for (int i = 0; i < 3; ++i) *(u32x4*)(lds + krow[i] * 208 + kch[i] * 16) = rk[i];
#pragma unroll
  for (int i = 0; i < 2; ++i) *(u32x4*)(lds + 13312 + (vrow0 + 32 * i) * 144 + vch * 16) = rv[i];
  __syncthreads();
  for (int kt = 0; kt < ntiles; ++kt) {
    const unsigned char* Ks = lds + (kt & 1) * STG;
    const unsigned char* Vs = Ks + 13312;
    if (kt + 1 < ntiles) {
#pragma unroll
      for (int i = 0; i < 3; ++i) rk[i] = *(const u32x4*)(Kg + (size_t)((kt + 1) * 64 + krow[i]) * 96 + kch[i] * 8);
#pragma unroll
      for (int i = 0; i < 2; ++i) rv[i] = *(const u32x4*)(Vt + (size_t)(vrow0 + 32 * i) * S_ + (kt + 1) * 64 + vch * 8);
    }
    if (kt * 64 <= q0 + 32 * w + 31) {
      f32x16 st[2];
#pragma unroll
      for (int k2 = 0; k2 < 2; ++k2) {
        st[k2] = zero16();
#pragma unroll
        for (int kk = 0; kk < 6; ++kk) {
          bf16x8 kf = *(const bf16x8*)(Ks + (k2 * 32 + r) * 208 + kk * 32 + hh * 16);
          st[k2] = MFMA32(kf, qf[kk], st[k2]);
        }
      }
      if (kt * 64 + 63 > q0 + 32 * w) {
#pragma unroll
        for (int k2 = 0; k2 < 2; ++k2)
#pragma unroll
          for (int g = 0; g < 4; ++g)
#pragma unroll
            for (int k = 0; k < 4; ++k) {
              const int key = kt * 64 + k2 * 32 + 8 * g + 4 * hh + k;
              if (key > qrow) st[k2][4 * g + k] = -1e30f;
            }
      }
      float mt = st[0][0];
#pragma unroll
      for (int k2 = 0; k2 < 2; ++k2)
#pragma unroll
        for (int i = 0; i < 16; ++i) mt = fmaxf(mt, st[k2][i]);
      mt = fmaxf(mt, __shfl_xor(mt, 32));
      const float mnew = fmaxf(mrun, mt);
      const float alpha = __builtin_amdgcn_exp2f(mrun - mnew);
      mrun = mnew;
      float ls = 0.f;
#pragma unroll
      for (int k2 = 0; k2 < 2; ++k2)
#pragma unroll
        for (int i = 0; i < 16; ++i) { const float pv = __builtin_amdgcn_exp2f(st[k2][i] - mnew); st[k2][i] = pv; ls += pv; }
      lrun = lrun * alpha + ls;
      if (__any(alpha != 1.f)) {
#pragma unroll
        for (int dt = 0; dt < 2; ++dt)
#pragma unroll
          for (int i = 0; i < 16; ++i) ot[dt][i] *= alpha;
      }
#pragma unroll
      for (int k2 = 0; k2 < 2; ++k2)
#pragma unroll
        for (int s = 0; s < 2; ++s) {
          u32x4 pw;
          pw.x = pk_bf16(st[k2][8 * s], st[k2][8 * s + 1]); pw.y = pk_bf16(st[k2][8 * s + 2], st[k2][8 * s + 3]);
          pw.z = pk_bf16(st[k2][8 * s + 4], st[k2][8 * s + 5]); pw.w = pk_bf16(st[k2][8 * s + 6], st[k2][8 * s + 7]);
          const bf16x8 pf = __builtin_bit_cast(bf16x8, pw);
#pragma unroll
          for (int dt = 0; dt < 2; ++dt) {
            const unsigned char* vp = Vs + (dt * 32 + r) * 144 + (k2 * 32 + s * 16 + 4 * hh) * 2;
            u32x2 v0 = *(const u32x2*)vp, v1 = *(const u32x2*)(vp + 16);
            u32x4 vw = (u32x4){v0.x, v0.y, v1.x, v1.y};
            ot[dt] = MFMA32(__builtin_bit_cast(bf16x8, vw), pf, ot[dt]);
          }
        }
    }
    if (kt + 1 < ntiles) {
      unsigned char* Kw = lds + ((kt + 1) & 1) * STG;
#pragma unroll
      for (int i = 0; i < 3; ++i) *(u32x4*)(Kw + krow[i] * 208 + kch[i] * 16) = rk[i];
#pragma unroll
      for (int i = 0; i < 2; ++i) *(u32x4*)(Kw + 13312 + (vrow0 + 32 * i) * 144 + vch * 16) = rv[i];
    }
    __syncthreads();
  }
  const float lt = lrun + __shfl_xor(lrun, 32);
  const float inv = 1.f / lt;
  const int b = bh >> 2, hd = bh & 3;
  bf16* op = mix + ((size_t)b * S_ + qrow) * 1024 + 512 + hd * 64;
#pragma unroll
  for (int dt = 0; dt < 2; ++dt)
#pragma unroll
    for (int g = 0; g < 4; ++g) {
      u32x2 wv; wv.x = pk_bf16(ot[dt][4 * g] * inv, ot[dt][4 * g + 1] * inv); wv.y = pk_bf16(ot[dt][4 * g + 2] * inv, ot[dt][4 * g + 3] * inv);
      *(u32x2*)(op + dt * 32 + 8 * g + 4 * hh) = wv;
    }
}

DI void grid_bar(unsigned* flags, unsigned k) {
  asm volatile("s_waitcnt vmcnt(0) lgkmcnt(0)" ::: "memory");
  __syncthreads();
  if (threadIdx.x == 0) { __threadfence(); __hip_atomic_store(flags + blockIdx.x, k, __ATOMIC_RELAXED, __HIP_MEMORY_SCOPE_AGENT); }
  const unsigned nb = gridDim.x;
  for (;;) {
    int ok = 1;
    for (unsigned i = threadIdx.x; i < nb; i += blockDim.x) ok &= (__hip_atomic_load(flags + i, __ATOMIC_RELAXED, __HIP_MEMORY_SCOPE_AGENT) >= k) ? 1 : 0;
    if (__syncthreads_and(ok)) break;
    __builtin_amdgcn_s_sleep(1);
  }
  if (threadIdx.x == 0) __threadfence();
  __syncthreads();
}
__global__ void __launch_bounds__(512, 2) fwd_megakernel(Params p0) {
  extern __shared__ __attribute__((aligned(16))) unsigned char lds_all[];
  __shared__ int s_item;
  cg::grid_group grid = cg::this_grid();
  unsigned nbar = 0;
  const int nvb = gridDim.x * 2;
#define GBAR() do { nbar += 1; grid_bar((unsigned*)(p0.ws + OFF_CTL) + 256, nbar); } while (0)
#define PH_BEGIN() Params q = p0; { unsigned long long w_ = (unsigned long long)q.ws; asm volatile("" : "+s"(w_)); q.ws = (unsigned char*)w_; } int tid5 = threadIdx.x; asm volatile("" : "+v"(tid5)); const int tid = tid5 & 255, half = tid5 >> 8, vb = blockIdx.x * 2 + half; unsigned char* lds = lds_all + half * LDS_HALF; (void)vb; (void)lds; \
  unsigned char* ws = q.ws; bf16* W = (bf16*)(ws + OFF_W); float* rs = (float*)(ws + OFF_RS); bf16* zb = (bf16*)(ws + OFF_AR + AR_Z); bf16* yb = (bf16*)(ws + OFF_AR + AR_Y); \
  bf16* up = (bf16*)(ws + OFF_AR + AR_UP); bf16* mix = (bf16*)(ws + OFF_AR + AR_MIX); bf16* xb = mix; unsigned* ctl = (unsigned*)(ws + OFF_CTL); \
  const bf16* Wl = W + (size_t)l * WL_E; (void)rs; (void)zb; (void)yb; (void)up; (void)mix; (void)xb; (void)ctl; (void)Wl; (void)tid; (void)tid5;
  { const int l = 0; PH_BEGIN(); phase0(q, lds, tid, half); }
  { const int l = 0; PH_BEGIN(); resid_phase(q.x, nullptr, nullptr, nullptr, nullptr, xb, rs, tid, vb, nvb); }
  if (p0.ws == nullptr) grid.sync();
  GBAR();

  for (int l = 0; l < 2; ++l) {
    { PH_BEGIN(); EpiStore e{zb, zb, 1 << 30, ZLD, rs, nullptr}; gemm_phase<false>(l == 0 ? xb : (const bf16*)q.out, 1024, Wl + WO_IN, 1024, 1024, 128, 13, e, lds_all, tid5); }
    GBAR();
    for (int pi = blockIdx.x; pi < (2048 * 3 + 512) / 2; pi += gridDim.x) {
      PH_BEGIN();
      const int it = 2 * pi + half;
      if (it < 2048) gdn_local_item(q, l, it, lds, tid);
      else if (it < 4096) gla_local_item<64, true>(q, l, it - 2048, lds, tid);
      else if (it < 6144) gla_local_item<32, false>(q, l, it - 4096, lds, tid);
      else mla_proj_item(q, l, it - 6144, lds, tid);
    }
    GBAR();
    for (;;) {
      PH_BEGIN();
      if (tid5 == 0) s_item = (int)atomicAdd(&ctl[l], 1u);
      __syncthreads();
      const int pit = s_item;
      __syncthreads();
      if (pit >= 80 + 512) break;
      if (pit < 32) { const int it = 2 * pit + half; gdn_scan_item(q, it >> 4, (it >> 2) & 3, it & 3, lds, tid); }
      else if (pit < 64) { const int j = 2 * (pit - 32) + half; gla_scan_item<64>((bf16*)(ws + OFF_AR + AR_UTA), (const float*)(ws + OFF_GA), j >> 4, (j >> 2) & 3, j & 3, tid); }
      else if (pit < 80) { const int j = 2 * (pit - 64) + half; gla_scan_item<32>((bf16*)(ws + OFF_AR + AR_UTB), (const float*)(ws + OFF_GB), j >> 3, (j >> 1) & 3, j & 1, tid); }
      else { const int a = pit - 80; attn_item(q, 2 * (a & 7) + half, 63 - (a >> 3), lds, tid); }
    }
    GBAR();
    for (int pi = blockIdx.x; pi < 2048 * 3 / 2; pi += gridDim.x) {
      PH_BEGIN();
      const int it = 2 * pi + half;
      if (it < 2048) gdn_out_item(q, l, it, lds, tid);
      else if (it < 4096) gla_out_item<64, true>(q, l, it - 2048, lds, tid);
      else gla_out_item<32, false>(q, l, it - 4096, lds, tid);
    }
    GBAR();
    { PH_BEGIN(); EpiStore e{yb, yb, 1 << 30, 1024, nullptr, nullptr}; gemm_phase<false>(mix, 1024, Wl + WO_OUT, 1024, 1024, 128, 4, e, lds_all, tid5); }
    GBAR();
    { PH_BEGIN(); resid_phase(l == 0 ? q.x : nullptr, (const bf16*)q.out, yb, q.post_mix_g + l * 1024, nullptr, xb, rs, tid, vb, nvb); }
    GBAR();
    { PH_BEGIN(); EpiStore e{up, up, 1 << 30, FF, rs, q.ffn_conv + (size_t)l * 3 * FF}; gemm_phase<true>(xb, 1024, Wl + WO_GU, 1024, 1024, 136, 22, e, lds_all, tid5); }
    GBAR();
    { PH_BEGIN(); EpiStore e{yb, yb, 1 << 30, 1024, nullptr, nullptr}; gemm_phase<false>(up, FF, Wl + WO_DN, FF, FF, 128, 4, e, lds_all, tid5); }
    GBAR();
    { PH_BEGIN(); resid_phase(nullptr, xb, yb, q.post_ffn_g + l * 1024, l == 1 ? q.out : nullptr, l == 1 ? nullptr : (bf16*)q.out, rs, tid, vb, nvb); }
    GBAR();
  }
}

extern "C" void kernel_launch(void* const* d_in, const int* in_sizes, int n_in, void* d_out, int out_size, void* d_ws, size_t ws_size, hipStream_t stream) {
  static int grid_blocks = 0;
  if (!grid_blocks) {
    int dev = 0, cus = 0, per_cu = 0;
    hipGetDevice(&dev);
    hipDeviceGetAttribute(&cus, hipDeviceAttributeMultiprocessorCount, dev);
    hipFuncSetAttribute((const void*)fwd_megakernel, hipFuncAttributeMaxDynamicSharedMemorySize, LDS_BYTES);
    hipOccupancyMaxActiveBlocksPerMultiprocessor(&per_cu, (const void*)fwd_megakernel, 512, LDS_BYTES);
    if (per_cu < 1) per_cu = 1;
    if (per_cu > 1) per_cu = 1;
    grid_blocks = cus * per_cu;
    if (ws_size < WS_END) fprintf(stderr, "kernel_launch: workspace too small: %zu < %zu\n", ws_size, (size_t)WS_END);
  }
  Params p{};
  const float** pp = (const float**)&p;
  for (int i = 0; i < 24; ++i) pp[i] = (const float*)d_in[i];
  p.out = (float*)d_out; p.ws = (unsigned char*)d_ws;
  hipMemsetAsync((unsigned char*)d_ws + OFF_CTL, 0, 8192, stream);
  void* args[] = {&p};
  hipError_t e = hipLaunchCooperativeKernel((const void*)fwd_megakernel, dim3(grid_blocks), dim3(512), args, LDS_BYTES, stream);
  if (e != hipSuccess) fprintf(stderr, "cooperative launch failed: %s (grid %d)\n", hipGetErrorString(e), grid_blocks);
}
```
